# Optimizing an MI355X kernel written in HIP

```python
import jax, jax.numpy as jnp
from jax import lax
import numpy as np

D_MODEL = 1024
BATCH = 2
SEQ = 8192
DEPTH = 2

N_BRANCH = 4
BRANCH_WIDTH = D_MODEL // 4
EPS = 1e-6
CONV_CH = BRANCH_WIDTH
CONV_K = 31
GLA_HEADS = 4
GLA_DV = BRANCH_WIDTH // GLA_HEADS
GLA_DK = GLA_DV // 2
GLA_RANK = 16
GLA_TAU = 16.0
GLA_CHUNK = 64
ATT_HEADS = 4
ATT_KV_HEADS = 2
ATT_HD = BRANCH_WIDTH // ATT_HEADS
ATT_GROUP = ATT_HEADS // ATT_KV_HEADS
WINDOW = 128
ATT_BLOCK = 128
ROPE_THETA = 500000.0
ROPE_DIM = ATT_HD // 4
POOL_WIDTHS = (2, 4, 8, 16)
POOL_GROUP = BRANCH_WIDTH // len(POOL_WIDTHS)
D_FF = 4 * D_MODEL

IN_SPLITS = (
    2 * CONV_CH,
    GLA_HEADS * GLA_DK,
    GLA_HEADS * GLA_DK,
    GLA_HEADS * GLA_DV,
    GLA_HEADS * GLA_DV,
    2 * GLA_RANK,
    ATT_HEADS * ATT_HD,
    ATT_KV_HEADS * ATT_HD,
    ATT_KV_HEADS * ATT_HD,
    len(POOL_WIDTHS) * POOL_GROUP,
    N_BRANCH * D_MODEL,
)
D_IN = int(sum(IN_SPLITS))
IN_OFFSETS = [int(o) for o in np.cumsum(IN_SPLITS)[:-1]]

kernel_name = "hybrid_gated_parallel_encoder"


def rms_norm(x, g):
    xf = x.astype(jnp.float32)
    y = xf * lax.rsqrt(jnp.mean(xf * xf, axis=-1, keepdims=True) + EPS)
    return (y * g.astype(jnp.float32)).astype(x.dtype)


def conv_module(glu, conv_w, conv_b, ln_g, ln_b):
    a, gate = jnp.split(glu, 2, axis=-1)
    u = a * jax.nn.sigmoid(gate)
    y = lax.conv_general_dilated(
        u, conv_w[:, None, :], window_strides=(1,),
        padding=[(CONV_K // 2, CONV_K // 2)],
        dimension_numbers=("NWC", "WIO", "NWC"),
        feature_group_count=CONV_CH) + conv_b
    yf = y.astype(jnp.float32)
    mu = jnp.mean(yf, axis=-1, keepdims=True)
    var = jnp.mean(jnp.square(yf - mu), axis=-1, keepdims=True)
    yf = (yf - mu) * lax.rsqrt(var + EPS) * ln_g.astype(jnp.float32) + ln_b.astype(jnp.float32)
    return jax.nn.silu(yf).astype(glu.dtype)


def gla_one_direction(q, k, v, logg):
    b_, t, h, dk = q.shape
    dv = v.shape[-1]
    n = t // GLA_CHUNK

    def chunks(a):
        return jnp.swapaxes(a.reshape(b_, n, GLA_CHUNK, h, a.shape[-1]), 0, 1)

    bcum = jnp.cumsum(logg.reshape(b_, n, GLA_CHUNK, h, dk), axis=2)
    bcum = jnp.swapaxes(bcum, 0, 1)
    mask = jnp.tril(jnp.ones((GLA_CHUNK, GLA_CHUNK), dtype=bool))[None, :, :, None, None]

    def step(state, inp):
        qc, kc, vc, bc = inp
        decay = jnp.exp(jnp.where(mask, bc[:, :, None] - bc[:, None, :], -jnp.inf))
        scores = jnp.einsum('bihd,bjhd,bijhd->bhij', qc, kc, decay)
        o = (jnp.einsum('bhij,bjhe->bihe', scores, vc)
             + jnp.einsum('bihd,bhde->bihe', qc * jnp.exp(bc), state))
        blast = bc[:, -1]
        state = (jnp.exp(blast)[..., None] * state
                 + jnp.einsum('bjhd,bjhe->bhde', kc * jnp.exp(blast[:, None] - bc), vc))
        return state, o

    s0 = jnp.zeros((b_, h, dk, dv), jnp.float32)
    _, o = lax.scan(step, s0, (chunks(q), chunks(k), chunks(v), bcum))
    return jnp.swapaxes(o, 0, 1).reshape(b_, t, h, dv)


def gla_branch(gq, gk, gv, gr, glr, w_up, b_up, norm_g):
    b_, t, _ = gq.shape
    f32 = jnp.float32
    q = gq.astype(f32).reshape(b_, t, GLA_HEADS, GLA_DK) * (GLA_DK ** -0.5)
    k = gk.astype(f32).reshape(b_, t, GLA_HEADS, GLA_DK)
    v = gv.astype(f32).reshape(b_, t, GLA_HEADS, GLA_DV)
    z = jnp.einsum('btsr,srk->btsk', glr.reshape(b_, t, 2, GLA_RANK), w_up) + b_up
    logg = (jax.nn.log_sigmoid(z.astype(f32)) / GLA_TAU).reshape(b_, t, 2, GLA_HEADS, GLA_DK)
    o_f = gla_one_direction(q, k, v, logg[:, :, 0])
    o_b = jnp.flip(gla_one_direction(jnp.flip(q, 1), jnp.flip(k, 1), jnp.flip(v, 1),
                                     jnp.flip(logg[:, :, 1], 1)), 1)
    o = o_f + o_b
    o = o * lax.rsqrt(jnp.mean(o * o, axis=-1, keepdims=True) + EPS)
    o = o * norm_g.astype(f32).reshape(GLA_HEADS, GLA_DV)
    o = o * jax.nn.silu(gr.astype(f32).reshape(b_, t, GLA_HEADS, GLA_DV))
    return o.reshape(b_, t, GLA_HEADS * GLA_DV).astype(gq.dtype)


def partial_rope(x, pos):
    half = ROPE_DIM // 2
    inv = 1.0 / (ROPE_THETA ** (jnp.arange(0, ROPE_DIM, 2, dtype=jnp.float32) / ROPE_DIM))
    ang = pos.astype(jnp.float32)[:, None] * inv[None, :]
    cos = jnp.cos(ang)[None, :, None, :]
    sin = jnp.sin(ang)[None, :, None, :]
    xf = x.astype(jnp.float32)
    x1, x2, rest = xf[..., :half], xf[..., half:ROPE_DIM], xf[..., ROPE_DIM:]
    return jnp.concatenate([x1 * cos - x2 * sin, x2 * cos + x1 * sin, rest], axis=-1)


def window_attention(q, k, v, sink):
    b_, t = q.shape[0], q.shape[1]
    n = t // ATT_BLOCK
    qb = q.reshape(b_, n, ATT_BLOCK, ATT_KV_HEADS, ATT_GROUP, ATT_HD)

    def key_windows(a):
        ap = jnp.pad(a, ((0, 0), (ATT_BLOCK, ATT_BLOCK), (0, 0), (0, 0)))
        ap = ap.reshape(b_, n + 2, ATT_BLOCK, ATT_KV_HEADS, ATT_HD)
        return jnp.concatenate([ap[:, :-2], ap[:, 1:-1], ap[:, 2:]], axis=2)

    kw = key_windows(k)
    vw = key_windows(v)
    s = jnp.einsum('bnqkgd,bnskd->bnkgqs', qb, kw) * (ATT_HD ** -0.5)
    qpos = jnp.arange(n)[:, None] * ATT_BLOCK + jnp.arange(ATT_BLOCK)[None, :]
    kpos = jnp.arange(n)[:, None] * ATT_BLOCK - ATT_BLOCK + jnp.arange(3 * ATT_BLOCK)[None, :]
    valid = ((kpos[:, None, :] >= 0) & (kpos[:, None, :] < t)
             & (jnp.abs(qpos[:, :, None] - kpos[:, None, :]) <= WINDOW))
    s = jnp.where(valid[None, :, None, None], s, -jnp.inf)
    sk = sink.astype(jnp.float32).reshape(1, 1, ATT_KV_HEADS, ATT_GROUP, 1, 1)
    m = jnp.maximum(jnp.max(s, axis=-1, keepdims=True), sk)
    p = jnp.exp(s - m)
    denom = jnp.sum(p, axis=-1, keepdims=True) + jnp.exp(sk - m)
    o = jnp.einsum('bnkgqs,bnskd->bnqkgd', p / denom, vw)
    return o.reshape(b_, t, ATT_HEADS * ATT_HD)


def attention_branch(aq, ak, av, sink):
    b_, t, _ = aq.shape
    pos = jnp.arange(t)
    q = partial_rope(aq.reshape(b_, t, ATT_HEADS, ATT_HD), pos)
    k = partial_rope(ak.reshape(b_, t, ATT_KV_HEADS, ATT_HD), pos)
    v = av.astype(jnp.float32).reshape(b_, t, ATT_KV_HEADS, ATT_HD)
    return window_attention(q, k, v, sink).astype(aq.dtype)


def pool_branch(u, pool_w, pool_scale):
    b_, t, c = u.shape
    uf = u.astype(jnp.float32)
    cs = jnp.concatenate([jnp.zeros((b_, 1, c), jnp.float32), jnp.cumsum(uf, axis=1)], axis=1)
    pos = jnp.arange(t)
    outs = []
    for g, w in enumerate(POOL_WIDTHS):
        sl = slice(g * POOL_GROUP, (g + 1) * POOL_GROUP)
        lo = jnp.clip(pos - w // 2, 0, t)
        hi = jnp.clip(pos + w // 2, 0, t)
        csg = cs[:, :, sl]
        mean = (jnp.take(csg, hi, axis=1) - jnp.take(csg, lo, axis=1)) / (hi - lo).astype(jnp.float32)[None, :, None]
        outs.append(mean - uf[:, :, sl])
    d = jnp.stack(outs, axis=2)
    y = jnp.einsum('btgc,gcd->btgd', d, pool_w.astype(jnp.float32)).reshape(b_, t, c)
    return (y * pool_scale.astype(jnp.float32)).astype(u.dtype)


def mixer(xn, w_in, conv_w, conv_b, conv_ln_g, conv_ln_b, gla_w_up, gla_b_up, gla_norm_g,
          attn_sink, pool_w, pool_scale, w_branch, w_out):
    b_, t, _ = xn.shape
    h = xn @ w_in
    glu, gq, gk, gv, gr, glr, aq, ak, av, pin, gate = jnp.split(h, IN_OFFSETS, axis=-1)
    ya = conv_module(glu, conv_w, conv_b, conv_ln_g, conv_ln_b)
    yb = gla_branch(gq, gk, gv, gr, glr, gla_w_up, gla_b_up, gla_norm_g)
    yc = attention_branch(aq, ak, av, attn_sink)
    yd = pool_branch(pin, pool_w, pool_scale)
    ys = jnp.stack([ya, yb, yc, yd], axis=2)
    proj = jnp.einsum('btnc,ncd->btnd', ys, w_branch)
    g = jax.nn.sigmoid(gate.reshape(b_, t, N_BRANCH, D_MODEL))
    merged = jnp.sum(g * proj, axis=2)
    return merged @ w_out


def setup_inputs(seed: int = 0) -> dict:
    key = jax.random.key(seed)
    ks = jax.random.split(key, 19)
    nrm = jax.random.normal
    f32 = jnp.float32
    L = DEPTH
    return {
        "x": nrm(ks[0], (BATCH, SEQ, D_MODEL), f32),
        "norm_mix_g": 1.0 + 0.02 * nrm(ks[1], (L, D_MODEL), f32),
        "w_in": nrm(ks[2], (L, D_MODEL, D_IN), f32) * D_MODEL ** -0.5,
        "conv_w": nrm(ks[3], (L, CONV_K, CONV_CH), f32) * CONV_K ** -0.5,
        "conv_b": 0.02 * nrm(ks[4], (L, CONV_CH), f32),
        "conv_ln_g": 1.0 + 0.02 * nrm(ks[5], (L, CONV_CH), f32),
        "conv_ln_b": 0.02 * nrm(ks[6], (L, CONV_CH), f32),
        "gla_w_up": nrm(ks[7], (L, 2, GLA_RANK, GLA_HEADS * GLA_DK), f32) * GLA_RANK ** -0.5,
        "gla_b_up": 0.01 * nrm(ks[8], (L, 2, GLA_HEADS * GLA_DK), f32),
        "gla_norm_g": 1.0 + 0.02 * nrm(ks[9], (L, GLA_HEADS * GLA_DV), f32),
        "attn_sink": 0.5 * nrm(ks[10], (L, ATT_HEADS), f32),
        "pool_w": nrm(ks[11], (L, len(POOL_WIDTHS), POOL_GROUP, POOL_GROUP), f32) * POOL_GROUP ** -0.5,
        "pool_scale": 1.0 + 0.02 * nrm(ks[12], (L, BRANCH_WIDTH), f32),
        "w_branch": nrm(ks[13], (L, N_BRANCH, BRANCH_WIDTH, D_MODEL), f32) * BRANCH_WIDTH ** -0.5,
        "w_out": nrm(ks[14], (L, D_MODEL, D_MODEL), f32) * D_MODEL ** -0.5,
        "norm_ffn_g": 1.0 + 0.02 * nrm(ks[15], (L, D_MODEL), f32),
        "w_ffn_up": nrm(ks[16], (L, D_MODEL, D_FF), f32) * D_MODEL ** -0.5,
        "w_ffn_down": nrm(ks[17], (L, D_FF, D_MODEL), f32) * D_FF ** -0.5,
        "final_norm_g": 1.0 + 0.02 * nrm(ks[18], (D_MODEL,), f32),
    }


def reference(x, norm_mix_g, w_in, conv_w, conv_b, conv_ln_g, conv_ln_b, gla_w_up, gla_b_up,
              gla_norm_g, attn_sink, pool_w, pool_scale, w_branch, w_out, norm_ffn_g,
              w_ffn_up, w_ffn_down, final_norm_g):
    for l in range(DEPTH):
        xn = rms_norm(x, norm_mix_g[l])
        x = x + mixer(xn, w_in[l], conv_w[l], conv_b[l], conv_ln_g[l], conv_ln_b[l],
                      gla_w_up[l], gla_b_up[l], gla_norm_g[l], attn_sink[l],
                      pool_w[l], pool_scale[l], w_branch[l], w_out[l])
        hn = rms_norm(x, norm_ffn_g[l])
        x = x + jnp.square(jax.nn.relu(hn @ w_ffn_up[l])) @ w_ffn_down[l]
    return rms_norm(x, final_norm_g)
```

```cpp
#ifndef CPU_EMU
#include <hip/hip_runtime.h>
#include <cstdio>
#include <cstdint>
#endif
#ifndef SEQ_T
#define SEQ_T 8192
#endif
#ifndef PH_MASK
#define PH_MASK 0xffff
#endif
#ifndef N_LAUNCH_MODE
#define N_LAUNCH_MODE 0
#endif

typedef unsigned short bf16_t;
typedef short bf16x8 __attribute__((ext_vector_type(8)));
typedef short s16x4 __attribute__((ext_vector_type(4)));
typedef float f32x4 __attribute__((ext_vector_type(4)));
typedef float f32x16 __attribute__((ext_vector_type(16)));
typedef unsigned u32x4 __attribute__((ext_vector_type(4)));
typedef unsigned u32x2 __attribute__((ext_vector_type(2)));
#ifdef CPU_EMU
#define DEVI static inline
#define DEVM inline
DEVI float ex2(float x) { return exp2f(x); }
DEVI float lg2(float x) { return log2f(x); }
DEVI float rcpf_(float x) { return 1.0f / x; }
DEVI float rsqf_(float x) { return 1.0f / sqrtf(x); }
DEVI f32x16 mfma32(bf16x8 a, bf16x8 b, f32x16 c) { return emu_mfma32(a, b, c); }
DEVI void wave_sync() { emu_wave->bar.wait(); }
DEVI int rfl(int x) { return x; }
#else
#define DEVI __device__ __forceinline__
#define DEVM __device__ __forceinline__
DEVI float ex2(float x) { return __builtin_amdgcn_exp2f(x); }
DEVI float lg2(float x) { return __builtin_amdgcn_logf(x); }
DEVI float rcpf_(float x) { return __builtin_amdgcn_rcpf(x); }
DEVI float rsqf_(float x) { return __builtin_amdgcn_rsqf(x); }
DEVI f32x16 mfma32(bf16x8 a, bf16x8 b, f32x16 c) { return __builtin_amdgcn_mfma_f32_32x32x16_bf16(a, b, c, 0, 0, 0); }
DEVI void wave_sync() { asm volatile("s_waitcnt lgkmcnt(0)" ::: "memory"); }
DEVI int rfl(int x) { return __builtin_amdgcn_readfirstlane(x); }
#endif
#ifdef CPU_EMU
DEVI int launder_tid() { return (int)threadIdx.x; }
#else
DEVI int launder_tid() { int t = threadIdx.x; asm volatile("" : "+v"(t)); return t; }
#endif
DEVI unsigned f2bf(float f) { unsigned u = __builtin_bit_cast(unsigned, f); return (u + 0x7fffu + ((u >> 16) & 1u)) >> 16; }
DEVI unsigned pk2(float lo, float hi) { return f2bf(lo) | (f2bf(hi) << 16); }
DEVI float bf2f(unsigned h) { return __builtin_bit_cast(float, h << 16); }
DEVI float bflo(unsigned w) { return __builtin_bit_cast(float, w << 16); }
DEVI float bfhi(unsigned w) { return __builtin_bit_cast(float, w & 0xffff0000u); }
constexpr float LOG2E = 1.4426950408889634f, LN2 = 0.6931471805599453f;
DEVI float sigmoidf_(float x) { return rcpf_(1.0f + ex2(-x * LOG2E)); }
DEVI float siluf_(float x) { return x * sigmoidf_(x); }
DEVI float logsigf_(float z) { const float a = fabsf(z); return fminf(z, 0.f) - LN2 * lg2(1.0f + ex2(-a * LOG2E)); }
DEVI float wave_sum(float v) {
#pragma unroll
    for (int o = 1; o < 64; o <<= 1) v += __shfl_xor(v, o);
    return v;
}

constexpr int BATCH = 2, SEQ = SEQ_T, M = BATCH * SEQ, D = 1024, DFF = 4096, NLAYER = 2;
constexpr int DIN_SRC = 6176;
constexpr int NHB = 2304, NGATE = 4096, NIN = NHB + NGATE;
constexpr int C_GLUA = 0, C_GLUG = 256, C_GQ = 512, C_GK = 640, C_GV = 768, C_GR = 1024, C_Z = 1280, C_AQ = 1536, C_AK = 1792, C_AV = 1920, C_PIN = 2048;
constexpr int SRC_GLR = 1280;
constexpr int NCH = SEQ / 64;
constexpr int NAB = SEQ / 128;
constexpr float EPS = 1e-6f;
constexpr int NTHREADS = 512, NWAVES = 8;
enum { I_X = 0, I_NMG, I_WIN, I_CW, I_CB, I_CLG, I_CLB, I_WUP, I_BUP, I_GNG, I_SINK, I_PW, I_PS, I_WBR, I_WOUT, I_NFG, I_WFU, I_WFD, I_FNG, N_INPUTS };
constexpr size_t al256(size_t x) { return (x + 255) & ~(size_t)255; }
constexpr size_t OFF_CTL = 0, CTL_BYTES = 1u << 20;
constexpr size_t SZ_WIN = (size_t)NIN * D * 2, SZ_WBR = (size_t)4 * D * 256 * 2, SZ_WOUT = (size_t)D * D * 2, SZ_WUP = (size_t)DFF * D * 2, SZ_WDN = (size_t)D * DFF * 2;
constexpr size_t OFF_WIN = OFF_CTL + CTL_BYTES, OFF_WBR = OFF_WIN + SZ_WIN, OFF_WOUT = OFF_WBR + SZ_WBR, OFF_WUP = OFF_WOUT + SZ_WOUT, OFF_WDN = OFF_WUP + SZ_WUP;
constexpr size_t OFF_ROPE = OFF_WDN + SZ_WDN, SZ_ROPE = al256((size_t)SEQ * 8 * 8);
constexpr size_t OFF_XN = OFF_ROPE + SZ_ROPE, SZ_ACT = al256((size_t)M * D * 2);
constexpr size_t OFF_Y = OFF_XN + SZ_ACT;
constexpr size_t OFF_BIG = OFF_Y + SZ_ACT;
constexpr size_t OFF_HB = OFF_BIG, SZ_HB = al256((size_t)M * NHB * 2);
constexpr size_t OFF_GU = OFF_HB + SZ_HB, SZ_GU = al256((size_t)BATCH * 4 * 2 * NCH * 2048 * 4);
constexpr size_t OFF_GD = OFF_GU + SZ_GU, SZ_GD = al256((size_t)BATCH * 4 * 2 * NCH * 32 * 4);
constexpr size_t OFF_G = OFF_BIG, SZ_G = al256((size_t)M * NGATE * 2);
constexpr size_t OFF_UP = OFF_BIG;
constexpr size_t WS_END = OFF_BIG + (SZ_G > SZ_HB + SZ_GU + SZ_GD ? SZ_G : SZ_HB + SZ_GU + SZ_GD);
static_assert(WS_END <= 268435456, "workspace map exceeds 256 MiB");

struct Args { const float* in[N_INPUTS]; float* out; unsigned char* ws; int ph_lo, ph_hi; };

enum { PH_WCONV = 0, PH_NORM1, PH_GEMM_IN, PH_MIX1, PH_MIX2, PH_MIX3, PH_GEMM_G, PH_GEMM_M, PH_GEMM_O, PH_NORM2, PH_GEMM_U, PH_GEMM_D, PH_PER_LAYER };
constexpr int PH_FINAL = NLAYER * PH_PER_LAYER, N_PHASES = PH_FINAL + 1;

DEVI void transpose_item(const float* W, int ldw, int K, bf16_t* WT, int k0, int src_n0, int dst_n0, float* scr, int lane) {
#pragma unroll 8
    for (int i = 0; i < 32; ++i) { const int kk = 2 * i + (lane >> 5); scr[kk * 33 + (lane & 31)] = W[(size_t)(k0 + kk) * ldw + src_n0 + (lane & 31)]; }
    wave_sync();
    const int c = lane & 7;
#pragma unroll
    for (int j = 0; j < 4; ++j) { const int n = (lane >> 3) + 8 * j; const float* s = scr + (8 * c) * 33 + n;
        u32x4 o; o.x = pk2(s[0 * 33], s[1 * 33]); o.y = pk2(s[2 * 33], s[3 * 33]); o.z = pk2(s[4 * 33], s[5 * 33]); o.w = pk2(s[6 * 33], s[7 * 33]);
        *(u32x4*)(WT + (size_t)(dst_n0 + n) * K + k0 + 8 * c) = o; }
    wave_sync();
}
DEVI void zfold_item(const float* Win, const float* wup, bf16_t* WT, int k0, int zc0  , float* scr, int lane) {
    const int s = zc0 >> 7, kc = (zc0 & 127) + (lane & 31);
    float wu[16];
#pragma unroll
    for (int r = 0; r < 16; ++r) wu[r] = wup[(s * 16 + r) * 128 + kc];
    for (int i = 0; i < 32; ++i) { const int kk = 2 * i + (lane >> 5); const float* g = Win + (size_t)(k0 + kk) * DIN_SRC + SRC_GLR + s * 16; float a = 0.f;
#pragma unroll
        for (int r = 0; r < 16; ++r) a += g[r] * wu[r];
        scr[kk * 33 + (lane & 31)] = a; }
    wave_sync();
    const int c = lane & 7;
#pragma unroll
    for (int j = 0; j < 4; ++j) { const int n = (lane >> 3) + 8 * j; const float* sp = scr + (8 * c) * 33 + n;
        u32x4 o; o.x = pk2(sp[0 * 33], sp[1 * 33]); o.y = pk2(sp[2 * 33], sp[3 * 33]); o.z = pk2(sp[4 * 33], sp[5 * 33]); o.w = pk2(sp[6 * 33], sp[7 * 33]);
        *(u32x4*)(WT + (size_t)(C_Z + zc0 + n) * D + k0 + 8 * c) = o; }
    wave_sync();
}
DEVI void rope_entry(int pos, int i, float& c, float& s) {
    const double inv[8] = {1.0, 0.19392274474868576, 0.03760603093086393, 0.007292664737217109, 0.001414213562373095, 0.0002742481756762073, 5.318295896944988e-05, 1.031338537721246e-05};
    double iv = inv[0];
#pragma unroll
    for (int k = 1; k < 8; ++k) iv = (i == k) ? inv[k] : iv;
    double rev = (double)pos * iv * 0.15915494309189535; rev -= __builtin_rint(rev);
    double q4 = rev * 4.0; const double qn = __builtin_rint(q4); const double t = (q4 - qn) * 1.5707963267948966;
    const double t2 = t * t;
    double sp = t * (1.0 + t2 * (-1.0 / 6 + t2 * (1.0 / 120 + t2 * (-1.0 / 5040 + t2 * (1.0 / 362880 + t2 * (-1.0 / 39916800 + t2 * (1.0 / 6227020800.0)))))));
    double cp = 1.0 + t2 * (-0.5 + t2 * (1.0 / 24 + t2 * (-1.0 / 720 + t2 * (1.0 / 40320 + t2 * (-1.0 / 3628800 + t2 * (1.0 / 479001600.0))))));
    const int qi = ((int)qn) & 3;
    const double cs = (qi == 0) ? cp : (qi == 1) ? -sp : (qi == 2) ? -cp : sp;
    const double sn = (qi == 0) ? sp : (qi == 1) ? cp : (qi == 2) ? -sp : -cp;
    c = (float)cs; s = (float)sn;
}
DEVI void phase_wconv(const Args& a, unsigned char* lds, int layer) {
    const int tid = launder_tid(), lane = tid & 63, wave = rfl(tid >> 6);
    float* scr = (float*)(lds + wave * 8448);
    const int gw = blockIdx.x * NWAVES + wave, NGW = gridDim.x * NWAVES;
    const float* Win = a.in[I_WIN] + (size_t)layer * D * DIN_SRC; const float* wup = a.in[I_WUP] + (size_t)layer * 2 * 16 * 128;
    const float* Wbr = a.in[I_WBR] + (size_t)layer * 4 * 256 * D; const float* Wout = a.in[I_WOUT] + (size_t)layer * D * D;
    const float* Wfu = a.in[I_WFU] + (size_t)layer * D * DFF; const float* Wfd = a.in[I_WFD] + (size_t)layer * DFF * D;
    bf16_t* WIN_T = (bf16_t*)(a.ws + OFF_WIN); bf16_t* WBR_T = (bf16_t*)(a.ws + OFF_WBR); bf16_t* WOUT_T = (bf16_t*)(a.ws + OFF_WOUT);
    bf16_t* WUP_T = (bf16_t*)(a.ws + OFF_WUP); bf16_t* WDN_T = (bf16_t*)(a.ws + OFF_WDN);
    constexpr int I_IN = (D / 64) * (NIN / 32), I_BR = 4 * (256 / 64) * (D / 32), I_OUT = (D / 64) * (D / 32), I_UP = (D / 64) * (DFF / 32), I_DN = (DFF / 64) * (D / 32);
    constexpr int NITEMS = I_IN + I_BR + I_OUT + I_UP + I_DN;
    for (int it = gw; it < NITEMS; it += NGW) {
        int r = it;
        if (r < I_IN) { const int nblk = NIN / 32, kb = r / nblk, nb = r % nblk, n0 = nb * 32;
            if (n0 >= C_Z && n0 < C_AQ) zfold_item(Win, wup, WIN_T, kb * 64, n0 - C_Z, scr, lane);
            else transpose_item(Win, DIN_SRC, D, WIN_T, kb * 64, n0 < C_Z ? n0 : n0 - 224, n0, scr, lane);
            continue; } r -= I_IN;
        if (r < I_BR) { const int br = r / (I_BR / 4), q = r % (I_BR / 4), nblk = D / 32, kb = q / nblk, nb = q % nblk;
            transpose_item(Wbr + (size_t)br * 256 * D, D, 256, WBR_T + (size_t)br * D * 256, kb * 64, nb * 32, nb * 32, scr, lane); continue; } r -= I_BR;
        if (r < I_OUT) { const int nblk = D / 32, kb = r / nblk, nb = r % nblk; transpose_item(Wout, D, D, WOUT_T, kb * 64, nb * 32, nb * 32, scr, lane); continue; } r -= I_OUT;
        if (r < I_UP) { const int nblk = DFF / 32, kb = r / nblk, nb = r % nblk; transpose_item(Wfu, DFF, D, WUP_T, kb * 64, nb * 32, nb * 32, scr, lane); continue; } r -= I_UP;
        { const int nblk = D / 32, kb = r / nblk, nb = r % nblk; transpose_item(Wfd, D, DFF, WDN_T, kb * 64, nb * 32, nb * 32, scr, lane); }
    }
    if (layer == 0) { float* rope = (float*)(a.ws + OFF_ROPE);
        for (int e = blockIdx.x * NTHREADS + tid; e < SEQ * 8; e += gridDim.x * NTHREADS) { float c, s; rope_entry(e >> 3, e & 7, c, s); rope[2 * e] = c; rope[2 * e + 1] = s; } }
}

DEVI void phase_rmsnorm_bf16(const float* x, const float* g, bf16_t* out) {
    const int tid = launder_tid(), lane = tid & 63, wave = rfl(tid >> 6);
    const int gw = blockIdx.x * NWAVES + wave, NGW = gridDim.x * NWAVES;
    f32x4 gv[4];
#pragma unroll
    for (int j = 0; j < 4; ++j) gv[j] = *(const f32x4*)(g + 4 * lane + 256 * j);
    for (int m = gw; m < M; m += NGW) {
        const f32x4* xr = (const f32x4*)(x + (size_t)m * D) + lane; f32x4 v[4]; float s = 0.f;
#pragma unroll
        for (int j = 0; j < 4; ++j) { v[j] = xr[64 * j]; s += (v[j].x * v[j].x + v[j].y * v[j].y) + (v[j].z * v[j].z + v[j].w * v[j].w); }
        const float rstd = rsqf_(wave_sum(s) * (1.f / D) + EPS);
        u32x2* o8 = (u32x2*)(out + (size_t)m * D) + lane;
#pragma unroll
        for (int j = 0; j < 4; ++j) { u32x2 w; w.x = pk2(v[j].x * rstd * gv[j].x, v[j].y * rstd * gv[j].y); w.y = pk2(v[j].z * rstd * gv[j].z, v[j].w * rstd * gv[j].w); o8[64 * j] = w; }
    }
}
DEVI void phase_rmsnorm_f32_inplace(float* x, const float* g) {
    const int tid = launder_tid(), lane = tid & 63, wave = rfl(tid >> 6);
    const int gw = blockIdx.x * NWAVES + wave, NGW = gridDim.x * NWAVES;
    f32x4 gv[4];
#pragma unroll
    for (int j = 0; j < 4; ++j) gv[j] = *(const f32x4*)(g + 4 * lane + 256 * j);
    for (int m = gw; m < M; m += NGW) {
        f32x4* xr = (f32x4*)(x + (size_t)m * D) + lane; f32x4 v[4]; float s = 0.f;
#pragma unroll
        for (int j = 0; j < 4; ++j) { v[j] = xr[64 * j]; s += (v[j].x * v[j].x + v[j].y * v[j].y) + (v[j].z * v[j].z + v[j].w * v[j].w); }
        const float rstd = rsqf_(wave_sum(s) * (1.f / D) + EPS);
#pragma unroll
        for (int j = 0; j < 4; ++j) xr[64 * j] = v[j] * rstd * gv[j];
    }
}

DEVI void conv_item(const Args& a, unsigned char* lds, int layer, int item) {
    const int tid = launder_tid(), lane = tid & 63, wave = rfl(tid >> 6), c = tid & 255, hf = tid >> 8;
    const int b = item / (SEQ / 32), t0 = (item % (SEQ / 32)) * 32;
    const bf16_t* HB = (const bf16_t*)(a.ws + OFF_HB); bf16_t* Y = (bf16_t*)(a.ws + OFF_Y);
    float* u = (float*)lds; float* y = u + 62 * 256;
    for (int r = hf; r < 62; r += 2) { const int t = t0 - 15 + r; float v = 0.f;
        if (t >= 0 && t < SEQ) { const bf16_t* hp = HB + (size_t)(b * SEQ + t) * NHB; v = bf2f(hp[C_GLUA + c]) * sigmoidf_(bf2f(hp[C_GLUG + c])); }
        u[r * 256 + c] = v; }
    float w[31];
    const float* cw = a.in[I_CW] + (size_t)layer * 31 * 256;
#pragma unroll
    for (int k = 0; k < 31; ++k) w[k] = cw[k * 256 + c];
    const float bias = a.in[I_CB][layer * 256 + c];
    __syncthreads();
    for (int i = 0; i < 16; ++i) { const int tt = hf * 16 + i; float acc = bias;
#pragma unroll
        for (int k = 0; k < 31; ++k) acc += u[(tt + k) * 256 + c] * w[k];
        y[tt * 256 + c] = acc; }
    __syncthreads();
    const f32x4 lg = *(const f32x4*)(a.in[I_CLG] + layer * 256 + 4 * lane), lb = *(const f32x4*)(a.in[I_CLB] + layer * 256 + 4 * lane);
#pragma unroll
    for (int i = 0; i < 4; ++i) { const int tt = wave * 4 + i; f32x4 v = *(const f32x4*)(y + tt * 256 + 4 * lane);
        const float mu = wave_sum((v.x + v.y) + (v.z + v.w)) * (1.f / 256); v = v - mu;
        const float var = wave_sum((v.x * v.x + v.y * v.y) + (v.z * v.z + v.w * v.w)) * (1.f / 256); const float rstd = rsqf_(var + EPS);
        v = v * rstd * lg + lb;
        u32x2 o; o.x = pk2(siluf_(v.x), siluf_(v.y)); o.y = pk2(siluf_(v.z), siluf_(v.w));
        *(u32x2*)(Y + (size_t)(b * SEQ + t0 + tt) * D + 0 + 4 * lane) = o; }
    __syncthreads();
}
DEVI void pool_item(const Args& a, unsigned char* lds, int layer, int item) {
    const int tid = launder_tid(), c = tid & 255, hf = tid >> 8;
    const int b = item / (SEQ / 32), t0 = (item % (SEQ / 32)) * 32;
    const bf16_t* HB = (const bf16_t*)(a.ws + OFF_HB); bf16_t* Y = (bf16_t*)(a.ws + OFF_Y);
    float* u = (float*)lds; float* d = u + 48 * 256;
    for (int r = hf; r < 48; r += 2) { const int t = t0 - 8 + r; float v = 0.f;
        if (t >= 0 && t < SEQ) v = bf2f(HB[(size_t)(b * SEQ + t) * NHB + C_PIN + c]);
        u[r * 256 + c] = v; }
    const int e = tid & 63, g = (tid >> 6) & 3;
    const float* pwp = a.in[I_PW] + ((size_t)layer * 4 + g) * 64 * 64 + e;
    const float psc = a.in[I_PS][layer * 256 + g * 64 + e];
    __syncthreads();
    { const int gg = c >> 6, hw = 1 << gg;
      for (int i = 0; i < 16; ++i) { const int tt = hf * 16 + i, t = t0 + tt; const int lo = (t - hw) < 0 ? 0 : (t - hw), hi = (t + hw) > SEQ ? SEQ : (t + hw);
          float s = 0.f; for (int p = lo; p < hi; ++p) s += u[(p - t0 + 8) * 256 + c];
          d[tt * 256 + c] = s / (float)(hi - lo) - u[(tt + 8) * 256 + c]; } }
    __syncthreads();
    { float acc[16];
#pragma unroll
      for (int i = 0; i < 16; ++i) acc[i] = 0.f;
      const float* dp = d + hf * 16 * 256 + g * 64;
#pragma unroll 4
      for (int cc = 0; cc < 64; ++cc) { const float wv = pwp[cc * 64];
#pragma unroll
          for (int i = 0; i < 16; ++i) acc[i] += dp[i * 256 + cc] * wv; }
#pragma unroll
      for (int i = 0; i < 16; ++i) Y[(size_t)(b * SEQ + t0 + hf * 16 + i) * D + 768 + g * 64 + e] = (bf16_t)f2bf(acc[i] * psc); }
    __syncthreads();
}
DEVI int crow(int r, int hi) { return (r & 3) + 8 * (r >> 2) + 4 * hi; }
constexpr int KS_LD = 72, VT_LD = 388;
DEVI void attn_item(const Args& a, unsigned char* lds, int layer, int item) {
    const int tid = launder_tid(), lane = tid & 63, wave = rfl(tid >> 6);
    const int b = item / (2 * NAB), kv = (item / NAB) & 1, n = item % NAB;
    const bf16_t* HB = (const bf16_t*)(a.ws + OFF_HB); bf16_t* Y = (bf16_t*)(a.ws + OFF_Y); const float* rope = (const float*)(a.ws + OFF_ROPE);
    bf16_t* Ks = (bf16_t*)lds; bf16_t* Vt = Ks + 384 * KS_LD;
    const int kbase = n * 128 - 128;
    for (int e = tid; e < 384 * 8; e += NTHREADS) { const int wr = e >> 3, c8 = e & 7, kpos = kbase + wr;
        u32x4 kw = (u32x4){0u, 0u, 0u, 0u}, vw = (u32x4){0u, 0u, 0u, 0u};
        if (kpos >= 0 && kpos < SEQ) { const bf16_t* hp = HB + (size_t)(b * SEQ + kpos) * NHB;
            kw = *(const u32x4*)(hp + C_AK + kv * 64 + c8 * 8); vw = *(const u32x4*)(hp + C_AV + kv * 64 + c8 * 8);
            if (c8 < 2) { const u32x4 pw = *(const u32x4*)(hp + C_AK + kv * 64 + (c8 ^ 1) * 8); const float sg = c8 ? 1.f : -1.f; const float* rp = rope + (size_t)kpos * 16;
                float o[8];
#pragma unroll
                for (int j = 0; j < 4; ++j) { const float m0 = bflo(kw[j]), m1 = bfhi(kw[j]), p0 = bflo(pw[j]), p1 = bfhi(pw[j]);
                    o[2 * j] = m0 * rp[4 * j] + sg * p0 * rp[4 * j + 1]; o[2 * j + 1] = m1 * rp[4 * j + 2] + sg * p1 * rp[4 * j + 3]; }
                kw = (u32x4){pk2(o[0], o[1]), pk2(o[2], o[3]), pk2(o[4], o[5]), pk2(o[6], o[7])}; } }
        *(u32x4*)(Ks + wr * KS_LD + c8 * 8) = kw;
#pragma unroll
        for (int j = 0; j < 4; ++j) { Vt[(c8 * 8 + 2 * j) * VT_LD + wr] = (bf16_t)(vw[j] & 0xffffu); Vt[(c8 * 8 + 2 * j + 1) * VT_LD + wr] = (bf16_t)(vw[j] >> 16); } }
    const int g = wave >> 2, hq = kv * 2 + g, q0l = (wave & 3) * 32, ql = lane & 31, hi = lane >> 5, qpos = n * 128 + q0l + ql;
    bf16x8 qf[4];
    { const bf16_t* qp = HB + (size_t)(b * SEQ + qpos) * NHB + C_AQ + hq * 64 + hi * 8; const float* rp = rope + (size_t)qpos * 16; const float sg = hi ? 1.f : -1.f;
#pragma unroll
      for (int ds = 0; ds < 4; ++ds) { const u32x4 w = *(const u32x4*)(qp + ds * 16); float v[8];
#pragma unroll
          for (int j = 0; j < 4; ++j) { v[2 * j] = bflo(w[j]); v[2 * j + 1] = bfhi(w[j]); }
          if (ds == 0) {
#pragma unroll
              for (int j = 0; j < 8; ++j) { const float p = __shfl_xor(v[j], 32); v[j] = v[j] * rp[2 * j] + sg * p * rp[2 * j + 1]; } }
          u32x4 o = (u32x4){pk2(v[0] * 0.125f, v[1] * 0.125f), pk2(v[2] * 0.125f, v[3] * 0.125f), pk2(v[4] * 0.125f, v[5] * 0.125f), pk2(v[6] * 0.125f, v[7] * 0.125f)};
          qf[ds] = __builtin_bit_cast(bf16x8, o); } }
    __syncthreads();
    float m2 = a.in[I_SINK][layer * 4 + hq] * LOG2E, l_own = hi ? 0.f : 1.f;
    f32x16 o0 = {}, o1 = {};
    for (int kt = 0; kt < 9; ++kt) {
        const int wb = q0l + 32 * kt, kpos0 = kbase + wb;
        if (kpos0 < 0 || kpos0 >= SEQ) continue;
        f32x16 s = {};
#pragma unroll
        for (int ds = 0; ds < 4; ++ds) { const bf16x8 kf = *(const bf16x8*)(Ks + (wb + ql) * KS_LD + ds * 16 + hi * 8); s = mfma32(kf, qf[ds], s); }
        float mt = -INFINITY;
#pragma unroll
        for (int r = 0; r < 16; ++r) { const int kin = crow(r, hi); float v = s[r] * LOG2E;
            if (kt == 0 && kin < ql) v = -INFINITY;
            if (kt == 8 && kin > ql) v = -INFINITY;
            s[r] = v; mt = fmaxf(mt, v); }
        mt = fmaxf(mt, __shfl_xor(mt, 32));
        const float mn = fmaxf(m2, mt), alpha = ex2(m2 - mn); m2 = mn;
        float ps = 0.f;
#pragma unroll
        for (int r = 0; r < 16; ++r) { s[r] = ex2(s[r] - mn); ps += s[r]; }
        l_own = l_own * alpha + ps;
#pragma unroll
        for (int r = 0; r < 16; ++r) { o0[r] *= alpha; o1[r] *= alpha; }
        bf16x8 pb[2];
#pragma unroll
        for (int sI = 0; sI < 2; ++sI) { u32x4 w = (u32x4){pk2(s[8 * sI + 0], s[8 * sI + 1]), pk2(s[8 * sI + 2], s[8 * sI + 3]), pk2(s[8 * sI + 4], s[8 * sI + 5]), pk2(s[8 * sI + 6], s[8 * sI + 7])}; pb[sI] = __builtin_bit_cast(bf16x8, w); }
#pragma unroll
        for (int sI = 0; sI < 2; ++sI) {
            const bf16_t* v0 = Vt + (size_t)ql * VT_LD + wb + 16 * sI + 4 * hi;
            const s16x4 a0 = *(const s16x4*)(v0), a1 = *(const s16x4*)(v0 + 8), c0 = *(const s16x4*)(v0 + 32 * VT_LD), c1 = *(const s16x4*)(v0 + 32 * VT_LD + 8);
            o0 = mfma32((bf16x8){a0[0], a0[1], a0[2], a0[3], a1[0], a1[1], a1[2], a1[3]}, pb[sI], o0);
            o1 = mfma32((bf16x8){c0[0], c0[1], c0[2], c0[3], c1[0], c1[1], c1[2], c1[3]}, pb[sI], o1); }
    }
    const float linv = 1.0f / (l_own + __shfl_xor(l_own, 32));
    bf16_t* yp = Y + (size_t)(b * SEQ + qpos) * D + 512 + hq * 64 + 4 * hi;
#pragma unroll
    for (int g4 = 0; g4 < 4; ++g4) {
        u32x2 w0, w1; w0.x = pk2(o0[4 * g4] * linv, o0[4 * g4 + 1] * linv); w0.y = pk2(o0[4 * g4 + 2] * linv, o0[4 * g4 + 3] * linv);
        w1.x = pk2(o1[4 * g4] * linv, o1[4 * g4 + 1] * linv); w1.y = pk2(o1[4 * g4 + 2] * linv, o1[4 * g4 + 3] * linv);
        *(u32x2*)(yp + 8 * g4) = w0; *(u32x2*)(yp + 32 + 8 * g4) = w1; }
    __syncthreads();
}
DEVI void gla_load_b(const Args& a, int layer, const bf16_t* hrow0  , int h, float* lgb, float* tot) {
    const int tid = launder_tid();
    const float* bup = a.in[I_BUP] + (size_t)layer * 2 * 128;
    for (int e = tid; e < 2 * 64 * 32; e += NTHREADS) { const int dir = e >> 11, j = (e >> 5) & 63, d = e & 31;
        const float z = bf2f(hrow0[(size_t)j * NHB + C_Z + dir * 128 + h * 32 + d]) + bup[dir * 128 + h * 32 + d];
        lgb[e] = logsigf_(z) * (1.f / 16.f); }
    __syncthreads();
    if (tid < 64) { const int dir = tid >> 5, d = tid & 31; float* p = lgb + dir * 2048 + d; float acc = 0.f;
        if (dir == 0) { for (int j = 0; j < 64; ++j) { acc += p[j * 32]; p[j * 32] = acc; } }
        else { for (int j = 63; j >= 0; --j) { acc += p[j * 32]; p[j * 32] = acc; } }
        tot[tid] = acc; }
    __syncthreads();
}
DEVI void gla_x_item(const Args& a, unsigned char* lds, int layer, int item) {
    const int tid = launder_tid();
    const int h = item & 3, c = (item >> 2) % NCH, b = item / (4 * NCH);
    const bf16_t* hrow0 = (const bf16_t*)(a.ws + OFF_HB) + (size_t)(b * SEQ + c * 64) * NHB;
    float* lgb = (float*)lds; float* kh = lgb + 4096; float* v = kh + 4096; float* tot = v + 4096;
    gla_load_b(a, layer, hrow0, h, lgb, tot);
    for (int e = tid; e < 2 * 2048; e += NTHREADS) { const int dir = e >> 11, j = (e >> 5) & 63, d = e & 31;
        kh[e] = bf2f(hrow0[(size_t)j * NHB + C_GK + h * 32 + d]) * ex2((tot[dir * 32 + d] - lgb[e]) * LOG2E); }
    for (int e = tid; e < 4096; e += NTHREADS) { const int j = e >> 6, ee = e & 63; v[e] = bf2f(hrow0[(size_t)j * NHB + C_GV + h * 64 + ee]); }
    float* GU = (float*)(a.ws + OFF_GU); float* GD = (float*)(a.ws + OFF_GD);
    if (tid < 64) { const int dir = tid >> 5, d = tid & 31; GD[((size_t)((b * 4 + h) * 2 + dir) * NCH + c) * 32 + d] = ex2(tot[tid] * LOG2E); }
    __syncthreads();
    const int e = tid & 63, dg = tid >> 6;
    float acc[2][4] = {};
    for (int j = 0; j < 64; ++j) { const float vv = v[j * 64 + e];
#pragma unroll
        for (int dir = 0; dir < 2; ++dir)
#pragma unroll
            for (int i = 0; i < 4; ++i) acc[dir][i] += kh[dir * 2048 + j * 32 + dg * 4 + i] * vv; }
#pragma unroll
    for (int dir = 0; dir < 2; ++dir)
#pragma unroll
        for (int i = 0; i < 4; ++i) GU[((size_t)((b * 4 + h) * 2 + dir) * NCH + c) * 2048 + (dg * 4 + i) * 64 + e] = acc[dir][i];
    __syncthreads();
}
DEVI void gla_scan(const Args& a) {
    float* GU = (float*)(a.ws + OFF_GU); const float* GD = (const float*)(a.ws + OFF_GD);
    constexpr int TOTAL = BATCH * 4 * 2 * 2048, UNR = (NCH % 16 == 0) ? 16 : 4;
    const int tid = launder_tid(); if (tid >= 128) return;
    for (int eid = blockIdx.x * 128 + tid; eid < TOTAL; eid += gridDim.x * 128) {
        const int seq = eid >> 11, de = eid & 2047, d = de >> 6, dir = seq & 1; float S = 0.f;
        for (int s0 = 0; s0 < NCH; s0 += UNR) { float u[UNR], dc[UNR];
#pragma unroll
            for (int k = 0; k < UNR; ++k) { const int c = dir ? NCH - 1 - (s0 + k) : s0 + k; u[k] = GU[((size_t)seq * NCH + c) * 2048 + de]; dc[k] = GD[((size_t)seq * NCH + c) * 32 + d]; }
#pragma unroll
            for (int k = 0; k < UNR; ++k) { const int c = dir ? NCH - 1 - (s0 + k) : s0 + k; GU[((size_t)seq * NCH + c) * 2048 + de] = S; S = dc[k] * S + u[k]; } }
    }
}
DEVI void gla_z_item(const Args& a, unsigned char* lds, int layer, int item) {
    const int tid = launder_tid(), wave = rfl(tid >> 6);
    const int h = item & 3, c = (item >> 2) % NCH, b = item / (4 * NCH);
    const bf16_t* hrow0 = (const bf16_t*)(a.ws + OFF_HB) + (size_t)(b * SEQ + c * 64) * NHB;
    float* lgb = (float*)lds;
    float* qt = lgb + 4096;
    float* kt = qt + 2 * 64 * 33;
    float* v = kt + 2 * 64 * 33;
    float* S = v + 4096;
    float* A = S + 4096;
    float* tot = A + 64 * 65;
    gla_load_b(a, layer, hrow0, h, lgb, tot);
    const float* GU = (const float*)(a.ws + OFF_GU);
    for (int e = tid; e < 2048; e += NTHREADS) { const int j = e >> 5, d = e & 31;
        const float q = bf2f(hrow0[(size_t)j * NHB + C_GQ + h * 32 + d]) * 0.17677669529663687f, k = bf2f(hrow0[(size_t)j * NHB + C_GK + h * 32 + d]);
#pragma unroll
        for (int dir = 0; dir < 2; ++dir) { const float bb = lgb[dir * 2048 + e] * LOG2E; qt[dir * 2112 + j * 33 + d] = q * ex2(bb); kt[dir * 2112 + j * 33 + d] = k * ex2(-bb); } }
    for (int e = tid; e < 4096; e += NTHREADS) { const int j = e >> 6, ee = e & 63; v[e] = bf2f(hrow0[(size_t)j * NHB + C_GV + h * 64 + ee]);
        const int dir = e >> 11; S[e] = GU[((size_t)((b * 4 + h) * 2 + dir) * NCH + c) * 2048 + (e & 2047)]; }
    __syncthreads();
    { const int j = tid & 63, ig = tid >> 6;
      for (int ii = 0; ii < 8; ++ii) { const int i = ig * 8 + ii; float af = 0.f, ab = 0.f;
#pragma unroll
          for (int d = 0; d < 32; ++d) { af += qt[i * 33 + d] * kt[j * 33 + d]; ab += qt[2112 + i * 33 + d] * kt[2112 + j * 33 + d]; }
          A[i * 65 + j] = (j <= i ? af : 0.f) + (j >= i ? ab : 0.f); } }
    __syncthreads();
    { const int e = tid & 63; const float ng = a.in[I_GNG][layer * 256 + h * 64 + e];
      bf16_t* Y = (bf16_t*)(a.ws + OFF_Y);
      for (int ii = 0; ii < 8; ++ii) { const int i = wave * 8 + ii; float o = 0.f;
#pragma unroll 8
          for (int j = 0; j < 64; ++j) o += A[i * 65 + j] * v[j * 64 + e];
#pragma unroll 8
          for (int d = 0; d < 32; ++d) o += qt[i * 33 + d] * S[d * 64 + e] + qt[2112 + i * 33 + d] * S[2048 + d * 64 + e];
          const float ms = wave_sum(o * o) * (1.f / 64.f); const float gr = bf2f(hrow0[(size_t)i * NHB + C_GR + h * 64 + e]);
          Y[(size_t)(b * SEQ + c * 64 + i) * D + 256 + h * 64 + e] = (bf16_t)f2bf(o * rsqf_(ms + EPS) * ng * siluf_(gr)); } }
    __syncthreads();
}
DEVI void phase_mix1(const Args& a, unsigned char* lds, int layer) {
    constexpr int N_ATT = BATCH * 2 * NAB, N_CONV = BATCH * (SEQ / 32), N_POOL = N_CONV, N_GX = BATCH * NCH * 4, N_ALL = N_ATT + N_CONV + N_POOL + N_GX;
    for (int it = blockIdx.x; it < N_ALL; it += gridDim.x) { int r = it;
        if (r < N_ATT) { attn_item(a, lds, layer, r); continue; } r -= N_ATT;
        if (r < N_CONV) { conv_item(a, lds, layer, r); continue; } r -= N_CONV;
        if (r < N_POOL) { pool_item(a, lds, layer, r); continue; } r -= N_POOL;
        gla_x_item(a, lds, layer, r); }
}
DEVI void phase_mix3(const Args& a, unsigned char* lds, int layer) {
    constexpr int N_GZ = BATCH * NCH * 4;
    for (int it = blockIdx.x; it < N_GZ; it += gridDim.x) gla_z_item(a, lds, layer, it);
}

namespace pg8 {
constexpr int BM = 256, BK = 64, HALF = 128, HTB = HALF * BK * 2, STAGE_BYTES = 8 * HTB, NXCD = 8, WGM = 8;
DEVI int lds_byte(int r, int c) { const int st = (r >> 4) * 2 + (c >> 5), rr = r & 15, cc = c & 31, ob = rr * 64 + cc * 2; return st * 1024 + (ob ^ (((ob >> 9) & 1) << 5)); }
DEVI void stage_rc(int b, int& R, int& C) { const int st = b / 1024, sb = b % 1024, swz = sb ^ (((sb >> 9) & 1) << 5); R = (st >> 1) * 16 + swz / 64; C = (st & 1) * 32 + (swz % 64) / 2; }
DEVI int perm32(int rho) { const int n = rho >> 4, i = rho & 15; return 8 * (i >> 2) + 4 * n + (i & 3); }
struct Unit { int pm, pn, br; };
struct Gemm { const bf16_t* A; const bf16_t* Bt; int K, lda, ldb; size_t a_br, b_br; };
struct StaticOrder {
    int nM, nN, nwg, G, c;
    DEVM void init(int Mr, int N, int G_, int c_) { nM = Mr / BM; nN = N / BM; nwg = nM * nN; G = G_; c = c_; }
    DEVM bool tile(long L, Unit& u) const {
        if (L >= nwg) return false;
        int wgid = (int)L; { const int q = nwg / NXCD, r = nwg % NXCD, xcd = wgid % NXCD, off = wgid / NXCD; wgid = (xcd < r ? xcd * (q + 1) : r * (q + 1) + (xcd - r) * q) + off; }
        const int nig = WGM * nN, gid = wgid / nig, fm = gid * WGM, gsz = (nM - fm) < WGM ? (nM - fm) : WGM;
        u.pm = fm + ((wgid % nig) % gsz); u.pn = (wgid % nig) / gsz; u.br = 0; return true;
    }
    DEVM bool next(int i, Unit& u) const { return tile((long)i * G + c, u); }
};
struct BranchOrder : StaticOrder {
    DEVM bool next(int i, Unit& u) const { if (!tile((long)(i >> 2) * G + c, u)) return false; u.br = i & 3; return true; }
};
template <int ACT  > struct EpiBf16 {
    static constexpr bool PERM = true;
    bf16_t* O; int ldc;
    DEVM void operator()(const f32x4 (&acc)[2][2][4][2], const Unit& u, int wr, int wc, int fr, int fq) const {
        const int row0 = u.pm * BM + wr * 64 + fr, col0 = u.pn * BM + wc * 32 + 8 * fq;
#pragma unroll
        for (int ai = 0; ai < 2; ++ai)
#pragma unroll
            for (int m = 0; m < 4; ++m) { bf16_t* rowp = O + (size_t)(row0 + ai * HALF + m * 16) * ldc + col0;
#pragma unroll
                for (int bj = 0; bj < 2; ++bj) { f32x4 v0 = acc[ai][bj][m][0], v1 = acc[ai][bj][m][1];
                    if (ACT == 1) {
#pragma unroll
                        for (int q = 0; q < 4; ++q) { v0[q] = sigmoidf_(v0[q]); v1[q] = sigmoidf_(v1[q]); } }
                    if (ACT == 2) {
#pragma unroll
                        for (int q = 0; q < 4; ++q) { const float r0 = fmaxf(v0[q], 0.f), r1 = fmaxf(v1[q], 0.f); v0[q] = r0 * r0; v1[q] = r1 * r1; } }
                    u32x4 w; w.x = pk2(v0[0], v0[1]); w.y = pk2(v0[2], v0[3]); w.z = pk2(v1[0], v1[1]); w.w = pk2(v1[2], v1[3]);
                    *(u32x4*)(rowp + bj * HALF) = w; } }
    }
};
struct EpiMerge {
    static constexpr bool PERM = true;
    bf16_t* O; const bf16_t* G;
    DEVM void operator()(const f32x4 (&acc)[2][2][4][2], const Unit& u, int wr, int wc, int fr, int fq) const {
        const int row0 = u.pm * BM + wr * 64 + fr, col0 = u.pn * BM + wc * 32 + 8 * fq;
#pragma unroll
        for (int ai = 0; ai < 2; ++ai)
#pragma unroll
            for (int m = 0; m < 4; ++m) { const size_t row = (size_t)(row0 + ai * HALF + m * 16); bf16_t* rowp = O + row * D + col0; const bf16_t* gp = G + row * NGATE + u.br * D + col0;
#pragma unroll
                for (int bj = 0; bj < 2; ++bj) { const f32x4 v0 = acc[ai][bj][m][0], v1 = acc[ai][bj][m][1];
                    const u32x4 gw = *(const u32x4*)(gp + bj * HALF);
                    float o[8] = {v0[0] * bflo(gw.x), v0[1] * bfhi(gw.x), v0[2] * bflo(gw.y), v0[3] * bfhi(gw.y), v1[0] * bflo(gw.z), v1[1] * bfhi(gw.z), v1[2] * bflo(gw.w), v1[3] * bfhi(gw.w)};
                    if (u.br != 0) { const u32x4 pw = *(const u32x4*)(rowp + bj * HALF);
                        o[0] += bflo(pw.x); o[1] += bfhi(pw.x); o[2] += bflo(pw.y); o[3] += bfhi(pw.y); o[4] += bflo(pw.z); o[5] += bfhi(pw.z); o[6] += bflo(pw.w); o[7] += bfhi(pw.w); }
                    u32x4 w; w.x = pk2(o[0], o[1]); w.y = pk2(o[2], o[3]); w.z = pk2(o[4], o[5]); w.w = pk2(o[6], o[7]);
                    *(u32x4*)(rowp + bj * HALF) = w; }
#ifndef CPU_EMU
                asm volatile("" ::: "memory");
#endif
            }
    }
};
struct EpiResF32 {
    static constexpr bool PERM = false;
    const float* base; float* out;
    DEVM void operator()(const f32x4 (&acc)[2][2][4][2], const Unit& u, int wr, int wc, int fr, int fq) const {
        const int row0 = u.pm * BM + wr * 64 + fr, col0 = u.pn * BM + wc * 32 + 4 * fq;
#pragma unroll
        for (int ai = 0; ai < 2; ++ai)
#pragma unroll
            for (int m = 0; m < 4; ++m) { const size_t off = (size_t)(row0 + ai * HALF + m * 16) * D + col0;
#pragma unroll
                for (int bj = 0; bj < 2; ++bj)
#pragma unroll
                    for (int n = 0; n < 2; ++n) { const f32x4 bs = *(const f32x4*)(base + off + bj * HALF + n * 16); *(f32x4*)(out + off + bj * HALF + n * 16) = bs + acc[ai][bj][m][n]; } }
    }
};
#ifndef CPU_EMU
#define PG8_LAS __attribute__((address_space(3)))
template <class Epi, class Sched, bool ALIGN_EPI = true>
__device__ __forceinline__ void gemm_phase(PG8_LAS unsigned char* lds, const Gemm g, const Sched& S, const Epi& E) {
    int tid_ = threadIdx.x; asm volatile("" : "+v"(tid_));
    const int tid = tid_, wid = __builtin_amdgcn_readfirstlane(tid >> 6), lane = tid & 63, wr = wid >> 2, wc = wid & 3, fr = lane & 15, fq = lane >> 4;
    const int K = g.K, nt = K / BK;
    unsigned voffA[2], voffB[2];
#pragma unroll
    for (int i = 0; i < 2; ++i) { int R, C; stage_rc(tid * 16 + i * 8192, R, C); const int Rb = Epi::PERM ? ((R & ~31) + perm32(R & 31)) : R;
        voffA[i] = (unsigned)(R * g.lda + C) * 2u; voffB[i] = (unsigned)(Rb * g.ldb + C) * 2u; }
    const size_t kstep = (size_t)(BK * 2);
    const size_t hstepA = (size_t)HALF * g.lda * 2, hstepB = (size_t)HALF * g.ldb * 2;
    const size_t tstepA = 2 * hstepA, tstepB = 2 * hstepB;
    const unsigned ldsw = (unsigned)wid * 1024u;
    const int aoff = lds_byte(wr * 64 + fr, fq * 8), boff = lds_byte(wc * 32 + fr, fq * 8);
#define PG8_SA(b, h) (((b) * 2 + (h)) * HTB)
#define PG8_SB(b, h) ((4 + (b) * 2 + (h)) * HTB)
#define PG8_STAGE(bufoff, gbase, voff) do { _Pragma("unroll") for (int _i = 0; _i < 2; ++_i) \
        __builtin_amdgcn_global_load_lds((const unsigned*)((const char*)(gbase) + (voff)[_i]), (PG8_LAS unsigned*)(lds + (bufoff) + ldsw + _i * 8192), 16, 0, 0); } while (0)
#define PG8_LDA(dst, b, h) do { _Pragma("unroll") for (int m = 0; m < 4; ++m) _Pragma("unroll") for (int k = 0; k < 2; ++k) dst[m][k] = *(const PG8_LAS bf16x8*)(lds + PG8_SA(b, h) + aoff + m * 2048 + k * 1024); } while (0)
#define PG8_LDB(dst, b, h) do { _Pragma("unroll") for (int n = 0; n < 2; ++n) _Pragma("unroll") for (int k = 0; k < 2; ++k) dst[n][k] = *(const PG8_LAS bf16x8*)(lds + PG8_SB(b, h) + boff + n * 2048 + k * 1024); } while (0)
#define PG8_MMA(ai, bj, At, Bt) do { __builtin_amdgcn_s_setprio(1); _Pragma("unroll") for (int m = 0; m < 4; ++m) _Pragma("unroll") for (int n = 0; n < 2; ++n) _Pragma("unroll") for (int k = 0; k < 2; ++k) \
        acc[ai][bj][m][n] = __builtin_amdgcn_mfma_f32_16x16x32_bf16(Bt[n][k], At[m][k], acc[ai][bj][m][n], 0, 0, 0); __builtin_amdgcn_s_setprio(0); } while (0)
#define PG8_WAIT_V(n) asm volatile("s_waitcnt vmcnt(" #n ")" ::: "memory")
#define PG8_WAIT_L(n) asm volatile("s_waitcnt lgkmcnt(" #n ")" ::: "memory")
#define PG8_BAR __builtin_amdgcn_s_barrier()
#define PG8_SCHED __builtin_amdgcn_sched_barrier(0)
#define PG8_ABASE(u) ((const char*)(g.A + (size_t)(u).br * g.a_br) + (size_t)(u).pm * tstepA)
#define PG8_BBASE(u) ((const char*)(g.Bt + (size_t)(u).br * g.b_br) + (size_t)(u).pn * tstepB)
    Unit cur, nxt; int ui = 0;
    if (!S.next(0, cur)) return;
    f32x4 acc[2][2][4][2];
#pragma unroll
    for (int a = 0; a < 2; ++a)
#pragma unroll
        for (int b = 0; b < 2; ++b)
#pragma unroll
            for (int m = 0; m < 4; ++m)
#pragma unroll
                for (int n = 0; n < 2; ++n) acc[a][b][m][n] = (f32x4){0.f, 0.f, 0.f, 0.f};
    bf16x8 At[4][2], B0[2][2], B1[2][2];
    const char* cA = PG8_ABASE(cur); const char* cB = PG8_BBASE(cur);
    PG8_STAGE(PG8_SB(0, 0), cB, voffB); PG8_STAGE(PG8_SB(0, 1), cB + hstepB, voffB); PG8_STAGE(PG8_SA(0, 0), cA, voffA); PG8_STAGE(PG8_SA(0, 1), cA + hstepA, voffA);
    if (wr == 1) PG8_BAR;
    PG8_WAIT_V(2); PG8_BAR;
    PG8_STAGE(PG8_SB(1, 0), cB + kstep, voffB); PG8_STAGE(PG8_SA(1, 0), cA + kstep, voffA); PG8_STAGE(PG8_SB(1, 1), cB + hstepB + kstep, voffB);
    PG8_WAIT_V(6); PG8_BAR;
    for (;;) {
        const bool has_next = S.next(ui + 1, nxt);
        const char* nA = has_next ? PG8_ABASE(nxt) : cA; const char* nB = has_next ? PG8_BBASE(nxt) : cB;
#pragma nounroll
        for (int t = 0; t < nt; t += 2) {
            const bool last = (t == nt - 2);
            const char* a1 = cA + (size_t)(t + 1) * kstep;
            const char* a2 = last ? nA : cA + (size_t)(t + 2) * kstep; const char* b2 = last ? nB : cB + (size_t)(t + 2) * kstep;
            const char* a3 = a2 + kstep; const char* b3 = b2 + kstep;
            PG8_LDB(B0, 0, 0); PG8_LDB(B1, 0, 1); PG8_SCHED; PG8_LDA(At, 0, 0); PG8_STAGE(PG8_SA(1, 1), a1 + hstepA, voffA);
            PG8_WAIT_V(8); PG8_WAIT_L(0); PG8_BAR; PG8_MMA(0, 0, At, B0); PG8_MMA(0, 1, At, B1); PG8_BAR; PG8_SCHED;
            PG8_LDA(At, 0, 1); PG8_STAGE(PG8_SB(0, 0), b2, voffB); PG8_STAGE(PG8_SB(0, 1), b2 + hstepB, voffB); PG8_STAGE(PG8_SA(0, 0), a2, voffA);
            PG8_WAIT_V(8); PG8_WAIT_L(0); PG8_BAR; PG8_MMA(1, 0, At, B0); PG8_MMA(1, 1, At, B1); PG8_BAR; PG8_SCHED;
            PG8_LDB(B0, 1, 0); PG8_LDB(B1, 1, 1); PG8_SCHED; PG8_LDA(At, 1, 0); PG8_STAGE(PG8_SA(0, 1), a2 + hstepA, voffA);
            PG8_WAIT_V(8); PG8_WAIT_L(0); PG8_BAR; PG8_MMA(0, 0, At, B0); PG8_MMA(0, 1, At, B1); PG8_BAR; PG8_SCHED;
            PG8_LDA(At, 1, 1); PG8_STAGE(PG8_SB(1, 0), b3, voffB); PG8_STAGE(PG8_SB(1, 1), b3 + hstepB, voffB); PG8_STAGE(PG8_SA(1, 0), a3, voffA);
            PG8_WAIT_V(8); PG8_WAIT_L(0); PG8_BAR; PG8_MMA(1, 0, At, B0); PG8_MMA(1, 1, At, B1); PG8_BAR; PG8_SCHED;
        }
        if constexpr (ALIGN_EPI) { if (wr == 0) PG8_BAR; }
        E(acc, cur, wr, wc, fr, fq);
        if (!has_next) break;
#pragma unroll
        for (int a = 0; a < 2; ++a)
#pragma unroll
            for (int b = 0; b < 2; ++b)
#pragma unroll
                for (int m = 0; m < 4; ++m)
#pragma unroll
                    for (int n = 0; n < 2; ++n) acc[a][b][m][n] = (f32x4){0.f, 0.f, 0.f, 0.f};
        cur = nxt; cA = nA; cB = nB; ++ui;
        if constexpr (ALIGN_EPI) { if (wr == 1) PG8_BAR; }
    }
    PG8_WAIT_V(0);
    if constexpr (!ALIGN_EPI) { if (wr == 0) PG8_BAR; }
    PG8_BAR;
#undef PG8_SA
#undef PG8_SB
#undef PG8_STAGE
#undef PG8_LDA
#undef PG8_LDB
#undef PG8_MMA
#undef PG8_WAIT_V
#undef PG8_WAIT_L
#undef PG8_BAR
#undef PG8_SCHED
#undef PG8_ABASE
#undef PG8_BBASE
}
#endif
}

#ifndef CPU_EMU
constexpr int LDS_BYTES = 147456;
__global__ void __launch_bounds__(NTHREADS, 2) mega_fwd(Args a) {
    extern __shared__ __attribute__((aligned(16))) unsigned char lds[];
    __attribute__((address_space(3))) unsigned char* lds3 = (__attribute__((address_space(3))) unsigned char*)lds;
    unsigned char* ws = a.ws;
    bf16_t* XN = (bf16_t*)(ws + OFF_XN); bf16_t* Yb = (bf16_t*)(ws + OFF_Y); bf16_t* HB = (bf16_t*)(ws + OFF_HB); bf16_t* Gb = (bf16_t*)(ws + OFF_G); bf16_t* UP = (bf16_t*)(ws + OFF_UP);
    const bf16_t* WIN_T = (const bf16_t*)(ws + OFF_WIN); const bf16_t* WBR_T = (const bf16_t*)(ws + OFF_WBR); const bf16_t* WOUT_T = (const bf16_t*)(ws + OFF_WOUT);
    const bf16_t* WUP_T = (const bf16_t*)(ws + OFF_WUP); const bf16_t* WDN_T = (const bf16_t*)(ws + OFF_WDN);
    const int G = gridDim.x, bid = blockIdx.x;
    const int lo = a.ph_lo, hi = a.ph_hi;
#define IN_PH(p) ((((PH_MASK) >> ((p) % PH_PER_LAYER + ((p) == PH_FINAL ? PH_PER_LAYER : 0))) & 1) && lo <= (p) && (p) < hi)
#pragma unroll
    for (int layer = 0; layer < NLAYER; ++layer) {
        const int pb = layer * PH_PER_LAYER;
        const float* xin = layer == 0 ? a.in[I_X] : a.out;
        if (IN_PH(pb + PH_WCONV)) phase_wconv(a, lds, layer);
        if (IN_PH(pb + PH_NORM1)) phase_rmsnorm_bf16(xin, a.in[I_NMG] + layer * D, XN);
        if (IN_PH(pb + PH_GEMM_IN)) { pg8::Gemm g{XN, WIN_T, D, D, D, 0, 0}; pg8::StaticOrder S; S.init(M, NHB, G, bid); pg8::EpiBf16<0> E{HB, NHB};
            pg8::gemm_phase<pg8::EpiBf16<0>, pg8::StaticOrder>(lds3, g, S, E); }
        if (IN_PH(pb + PH_MIX1)) phase_mix1(a, lds, layer);
        if (IN_PH(pb + PH_MIX2)) gla_scan(a);
        if (IN_PH(pb + PH_MIX3)) phase_mix3(a, lds, layer);
        if (IN_PH(pb + PH_GEMM_G)) { pg8::Gemm g{XN, WIN_T + (size_t)NHB * D, D, D, D, 0, 0}; pg8::StaticOrder S; S.init(M, NGATE, G, bid); pg8::EpiBf16<1> E{Gb, NGATE};
            pg8::gemm_phase<pg8::EpiBf16<1>, pg8::StaticOrder>(lds3, g, S, E); }
        if (IN_PH(pb + PH_GEMM_M)) { pg8::Gemm g{Yb, WBR_T, 256, D, 256, 256, (size_t)D * 256}; pg8::BranchOrder S; S.init(M, D, G, bid); pg8::EpiMerge E{XN, Gb};
            pg8::gemm_phase<pg8::EpiMerge, pg8::BranchOrder>(lds3, g, S, E); }
        if (IN_PH(pb + PH_GEMM_O)) { pg8::Gemm g{XN, WOUT_T, D, D, D, 0, 0}; pg8::StaticOrder S; S.init(M, D, G, bid); pg8::EpiResF32 E{xin, a.out};
            pg8::gemm_phase<pg8::EpiResF32, pg8::StaticOrder>(lds3, g, S, E); }
        if (IN_PH(pb + PH_NORM2)) phase_rmsnorm_bf16(a.out, a.in[I_NFG] + layer * D, XN);
        if (IN_PH(pb + PH_GEMM_U)) { pg8::Gemm g{XN, WUP_T, D, D, D, 0, 0}; pg8::StaticOrder S; S.init(M, DFF, G, bid); pg8::EpiBf16<2> E{UP, DFF};
            pg8::gemm_phase<pg8::EpiBf16<2>, pg8::StaticOrder>(lds3, g, S, E); }
        if (IN_PH(pb + PH_GEMM_D)) { pg8::Gemm g{UP, WDN_T, DFF, DFF, DFF, 0, 0}; pg8::StaticOrder S; S.init(M, D, G, bid); pg8::EpiResF32 E{a.out, a.out};
            pg8::gemm_phase<pg8::EpiResF32, pg8::StaticOrder>(lds3, g, S, E); }
    }
    if (IN_PH(PH_FINAL)) phase_rmsnorm_f32_inplace(a.out, a.in[I_FNG]);
#undef IN_PH
}

extern "C" void kernel_launch(void* const* d_in, const int* in_sizes, int n_in, void* d_out, int out_size, void* d_ws, size_t ws_size, hipStream_t stream) {
    static int grid = 0;
    if (grid == 0) {
        if (n_in != N_INPUTS || out_size != M * D || ws_size < WS_END) { fprintf(stderr, "kernel_launch: unexpected shapes (n_in %d out %d ws %zu)\n", n_in, out_size, ws_size); grid = -1; return; }
        int dev = 0, cus = 0;
        if (hipGetDevice(&dev) != hipSuccess || hipDeviceGetAttribute(&cus, hipDeviceAttributeMultiprocessorCount, dev) != hipSuccess) { grid = -1; return; }
        if (hipFuncSetAttribute((const void*)mega_fwd, hipFuncAttributeMaxDynamicSharedMemorySize, LDS_BYTES) != hipSuccess) { fprintf(stderr, "kernel_launch: hipFuncSetAttribute failed\n"); grid = -1; return; }
        grid = cus;
    }
    if (grid < 0) return;
    Args a{};
    for (int i = 0; i < N_INPUTS; ++i) a.in[i] = (const float*)d_in[i];
    a.out = (float*)d_out; a.ws = (unsigned char*)d_ws;
    for (int ph = 0; ph < N_PHASES; ++ph) { a.ph_lo = ph; a.ph_hi = ph + 1; hipLaunchKernelGGL(mega_fwd, dim3(grid), dim3(NTHREADS), LDS_BYTES, stream, a); }
}
#endif
```

```cpp
#ifndef CPU_EMU
#include <hip/hip_runtime.h>
#include <cstdio>
#include <cstdint>
#endif
#ifndef SEQ_T
#define SEQ_T 8192
#endif
#ifndef PH_MASK
#define PH_MASK 0xffff
#endif
#ifndef N_LAUNCH_MODE
#define N_LAUNCH_MODE 1
#endif

typedef unsigned short bf16_t;
typedef short bf16x8 __attribute__((ext_vector_type(8)));
typedef short s16x4 __attribute__((ext_vector_type(4)));
typedef float f32x4 __attribute__((ext_vector_type(4)));
typedef float f32x16 __attribute__((ext_vector_type(16)));
typedef unsigned u32x4 __attribute__((ext_vector_type(4)));
typedef unsigned u32x2 __attribute__((ext_vector_type(2)));
#ifdef CPU_EMU
#define DEVI static inline
#define DEVM inline
DEVI float ex2(float x) { return exp2f(x); }
DEVI float lg2(float x) { return log2f(x); }
DEVI float rcpf_(float x) { return 1.0f / x; }
DEVI float rsqf_(float x) { return 1.0f / sqrtf(x); }
DEVI f32x16 mfma32(bf16x8 a, bf16x8 b, f32x16 c) { return emu_mfma32(a, b, c); }
DEVI void wave_sync() { emu_wave->bar.wait(); }
DEVI int rfl(int x) { return x; }
#else
#define DEVI __device__ __forceinline__
#define DEVM __device__ __forceinline__
DEVI float ex2(float x) { return __builtin_amdgcn_exp2f(x); }
DEVI float lg2(float x) { return __builtin_amdgcn_logf(x); }
DEVI float rcpf_(float x) { return __builtin_amdgcn_rcpf(x); }
DEVI float rsqf_(float x) { return __builtin_amdgcn_rsqf(x); }
DEVI f32x16 mfma32(bf16x8 a, bf16x8 b, f32x16 c) { return __builtin_amdgcn_mfma_f32_32x32x16_bf16(a, b, c, 0, 0, 0); }
DEVI void wave_sync() { asm volatile("s_waitcnt lgkmcnt(0)" ::: "memory"); }
DEVI int rfl(int x) { return __builtin_amdgcn_readfirstlane(x); }
#endif
#ifdef CPU_EMU
DEVI int launder_tid() { return (int)threadIdx.x; }
#else
DEVI int launder_tid() { int t = threadIdx.x; asm volatile("" : "+v"(t)); return t; }
#endif
DEVI unsigned f2bf(float f) { unsigned u = __builtin_bit_cast(unsigned, f); return (u + 0x7fffu + ((u >> 16) & 1u)) >> 16; }
DEVI unsigned pk2(float lo, float hi) { return f2bf(lo) | (f2bf(hi) << 16); }
DEVI float bf2f(unsigned h) { return __builtin_bit_cast(float, h << 16); }
DEVI float bflo(unsigned w) { return __builtin_bit_cast(float, w << 16); }
DEVI float bfhi(unsigned w) { return __builtin_bit_cast(float, w & 0xffff0000u); }
constexpr float LOG2E = 1.4426950408889634f, LN2 = 0.6931471805599453f;
DEVI float sigmoidf_(float x) { return rcpf_(1.0f + ex2(-x * LOG2E)); }
DEVI float siluf_(float x) { return x * sigmoidf_(x); }
DEVI float logsigf_(float z) { const float a = fabsf(z); return fminf(z, 0.f) - LN2 * lg2(1.0f + ex2(-a * LOG2E)); }
DEVI float wave_sum(float v) {
#pragma unroll
    for (int o = 1; o < 64; o <<= 1) v += __shfl_xor(v, o);
    return v;
}

constexpr int BATCH = 2, SEQ = SEQ_T, M = BATCH * SEQ, D = 1024, DFF = 4096, NLAYER = 2;
constexpr int DIN_SRC = 6176;
constexpr int NHB = 2304, NGATE = 4096, NIN = NHB + NGATE;
constexpr int C_GLUA = 0, C_GLUG = 256, C_GQ = 512, C_GK = 640, C_GV = 768, C_GR = 1024, C_Z = 1280, C_AQ = 1536, C_AK = 1792, C_AV = 1920, C_PIN = 2048;
constexpr int SRC_GLR = 1280;
constexpr int NCH = SEQ / 64;
constexpr int NAB = SEQ / 128;
constexpr float EPS = 1e-6f;
constexpr int NTHREADS = 512, NWAVES = 8;
enum { I_X = 0, I_NMG, I_WIN, I_CW, I_CB, I_CLG, I_CLB, I_WUP, I_BUP, I_GNG, I_SINK, I_PW, I_PS, I_WBR, I_WOUT, I_NFG, I_WFU, I_WFD, I_FNG, N_INPUTS };
constexpr size_t al256(size_t x) { return (x + 255) & ~(size_t)255; }
constexpr size_t OFF_CTL = 0, CTL_BYTES = 1u << 20;
constexpr size_t SZ_WIN = (size_t)NIN * D * 2, SZ_WBR = (size_t)4 * D * 256 * 2, SZ_WOUT = (size_t)D * D * 2, SZ_WUP = (size_t)DFF * D * 2, SZ_WDN = (size_t)D * DFF * 2;
constexpr size_t OFF_WIN = OFF_CTL + CTL_BYTES, OFF_WBR = OFF_WIN + SZ_WIN, OFF_WOUT = OFF_WBR + SZ_WBR, OFF_WUP = OFF_WOUT + SZ_WOUT, OFF_WDN = OFF_WUP + SZ_WUP;
constexpr size_t OFF_ROPE = OFF_WDN + SZ_WDN, SZ_ROPE = al256((size_t)SEQ * 8 * 8);
constexpr size_t OFF_XN = OFF_ROPE + SZ_ROPE, SZ_ACT = al256((size_t)M * D * 2);
constexpr size_t OFF_Y = OFF_XN + SZ_ACT;
constexpr size_t OFF_BIG = OFF_Y + SZ_ACT;
constexpr size_t OFF_HB = OFF_BIG, SZ_HB = al256((size_t)M * NHB * 2);
constexpr size_t OFF_GU = OFF_HB + SZ_HB, SZ_GU = al256((size_t)BATCH * 4 * 2 * NCH * 2048 * 4);
constexpr size_t OFF_GD = OFF_GU + SZ_GU, SZ_GD = al256((size_t)BATCH * 4 * 2 * NCH * 32 * 4);
constexpr size_t OFF_G = OFF_BIG, SZ_G = al256((size_t)M * NGATE * 2);
constexpr size_t OFF_UP = OFF_BIG;
constexpr size_t WS_END = OFF_BIG + (SZ_G > SZ_HB + SZ_GU + SZ_GD ? SZ_G : SZ_HB + SZ_GU + SZ_GD);
static_assert(WS_END <= 268435456, "workspace map exceeds 256 MiB");

struct Args { const float* in[N_INPUTS]; float* out; unsigned char* ws; int ph_lo, ph_hi; };

enum { PH_WCONV = 0, PH_NORM1, PH_GEMM_IN, PH_MIX1, PH_MIX2, PH_MIX3, PH_GEMM_G, PH_GEMM_M, PH_GEMM_O, PH_NORM2, PH_GEMM_U, PH_GEMM_D, PH_PER_LAYER };
constexpr int PH_FINAL = NLAYER * PH_PER_LAYER, N_PHASES = PH_FINAL + 1;

DEVI void transpose_item(const float* W, int ldw, int K, bf16_t* WT, int k0, int src_n0, int dst_n0, float* scr, int lane) {
#pragma unroll 8
    for (int i = 0; i < 32; ++i) { const int kk = 2 * i + (lane >> 5); scr[kk * 33 + (lane & 31)] = W[(size_t)(k0 + kk) * ldw + src_n0 + (lane & 31)]; }
    wave_sync();
    const int c = lane & 7;
#pragma unroll
    for (int j = 0; j < 4; ++j) { const int n = (lane >> 3) + 8 * j; const float* s = scr + (8 * c) * 33 + n;
        u32x4 o; o.x = pk2(s[0 * 33], s[1 * 33]); o.y = pk2(s[2 * 33], s[3 * 33]); o.z = pk2(s[4 * 33], s[5 * 33]); o.w = pk2(s[6 * 33], s[7 * 33]);
        *(u32x4*)(WT + (size_t)(dst_n0 + n) * K + k0 + 8 * c) = o; }
    wave_sync();
}
DEVI void zfold_item(const float* Win, const float* wup, bf16_t* WT, int k0, int zc0  , float* scr, int lane) {
    const int s = zc0 >> 7, kc = (zc0 & 127) + (lane & 31);
    float wu[16];
#pragma unroll
    for (int r = 0; r < 16; ++r) wu[r] = wup[(s * 16 + r) * 128 + kc];
    for (int i = 0; i < 32; ++i) { const int kk = 2 * i + (lane >> 5); const float* g = Win + (size_t)(k0 + kk) * DIN_SRC + SRC_GLR + s * 16; float a = 0.f;
#pragma unroll
        for (int r = 0; r < 16; ++r) a += g[r] * wu[r];
        scr[kk * 33 + (lane & 31)] = a; }
    wave_sync();
    const int c = lane & 7;
#pragma unroll
    for (int j = 0; j < 4; ++j) { const int n = (lane >> 3) + 8 * j; const float* sp = scr + (8 * c) * 33 + n;
        u32x4 o; o.x = pk2(sp[0 * 33], sp[1 * 33]); o.y = pk2(sp[2 * 33], sp[3 * 33]); o.z = pk2(sp[4 * 33], sp[5 * 33]); o.w = pk2(sp[6 * 33], sp[7 * 33]);
        *(u32x4*)(WT + (size_t)(C_Z + zc0 + n) * D + k0 + 8 * c) = o; }
    wave_sync();
}
DEVI void rope_entry(int pos, int i, float& c, float& s) {
    const double inv[8] = {1.0, 0.19392274474868576, 0.03760603093086393, 0.007292664737217109, 0.001414213562373095, 0.0002742481756762073, 5.318295896944988e-05, 1.031338537721246e-05};
    double iv = inv[0];
#pragma unroll
    for (int k = 1; k < 8; ++k) iv = (i == k) ? inv[k] : iv;
    double rev = (double)pos * iv * 0.15915494309189535; rev -= __builtin_rint(rev);
    double q4 = rev * 4.0; const double qn = __builtin_rint(q4); const double t = (q4 - qn) * 1.5707963267948966;
    const double t2 = t * t;
    double sp = t * (1.0 + t2 * (-1.0 / 6 + t2 * (1.0 / 120 + t2 * (-1.0 / 5040 + t2 * (1.0 / 362880 + t2 * (-1.0 / 39916800 + t2 * (1.0 / 6227020800.0)))))));
    double cp = 1.0 + t2 * (-0.5 + t2 * (1.0 / 24 + t2 * (-1.0 / 720 + t2 * (1.0 / 40320 + t2 * (-1.0 / 3628800 + t2 * (1.0 / 479001600.0))))));
    const int qi = ((int)qn) & 3;
    const double cs = (qi == 0) ? cp : (qi == 1) ? -sp : (qi == 2) ? -cp : sp;
    const double sn = (qi == 0) ? sp : (qi == 1) ? cp : (qi == 2) ? -sp : -cp;
    c = (float)cs; s = (float)sn;
}
DEVI void phase_wconv(const Args& a, unsigned char* lds, int layer) {
    const int tid = launder_tid(), lane = tid & 63, wave = rfl(tid >> 6);
    float* scr = (float*)(lds + wave * 8448);
    const int gw = blockIdx.x * NWAVES + wave, NGW = gridDim.x * NWAVES;
    const float* Win = a.in[I_WIN] + (size_t)layer * D * DIN_SRC; const float* wup = a.in[I_WUP] + (size_t)layer * 2 * 16 * 128;
    const float* Wbr = a.in[I_WBR] + (size_t)layer * 4 * 256 * D; const float* Wout = a.in[I_WOUT] + (size_t)layer * D * D;
    const float* Wfu = a.in[I_WFU] + (size_t)layer * D * DFF; const float* Wfd = a.in[I_WFD] + (size_t)layer * DFF * D;
    bf16_t* WIN_T = (bf16_t*)(a.ws + OFF_WIN); bf16_t* WBR_T = (bf16_t*)(a.ws + OFF_WBR); bf16_t* WOUT_T = (bf16_t*)(a.ws + OFF_WOUT);
    bf16_t* WUP_T = (bf16_t*)(a.ws + OFF_WUP); bf16_t* WDN_T = (bf16_t*)(a.ws + OFF_WDN);
    constexpr int I_IN = (D / 64) * (NIN / 32), I_BR = 4 * (256 / 64) * (D / 32), I_OUT = (D / 64) * (D / 32), I_UP = (D / 64) * (DFF / 32), I_DN = (DFF / 64) * (D / 32);
    constexpr int NITEMS = I_IN + I_BR + I_OUT + I_UP + I_DN;
    for (int it = gw; it < NITEMS; it += NGW) {
        int r = it;
        if (r < I_IN) { const int nblk = NIN / 32, kb = r / nblk, nb = r % nblk, n0 = nb * 32;
            if (n0 >= C_Z && n0 < C_AQ) zfold_item(Win, wup, WIN_T, kb * 64, n0 - C_Z, scr, lane);
            else transpose_item(Win, DIN_SRC, D, WIN_T, kb * 64, n0 < C_Z ? n0 : n0 - 224, n0, scr, lane);
            continue; } r -= I_IN;
        if (r < I_BR) { const int br = r / (I_BR / 4), q = r % (I_BR / 4), nblk = D / 32, kb = q / nblk, nb = q % nblk;
            transpose_item(Wbr + (size_t)br * 256 * D, D, 256, WBR_T + (size_t)br * D * 256, kb * 64, nb * 32, nb * 32, scr, lane); continue; } r -= I_BR;
        if (r < I_OUT) { const int nblk = D / 32, kb = r / nblk, nb = r % nblk; transpose_item(Wout, D, D, WOUT_T, kb * 64, nb * 32, nb * 32, scr, lane); continue; } r -= I_OUT;
        if (r < I_UP) { const int nblk = DFF / 32, kb = r / nblk, nb = r % nblk; transpose_item(Wfu, DFF, D, WUP_T, kb * 64, nb * 32, nb * 32, scr, lane); continue; } r -= I_UP;
        { const int nblk = D / 32, kb = r / nblk, nb = r % nblk; transpose_item(Wfd, D, DFF, WDN_T, kb * 64, nb * 32, nb * 32, scr, lane); }
    }
    if (layer == 0) { float* rope = (float*)(a.ws + OFF_ROPE);
        for (int e = blockIdx.x * NTHREADS + tid; e < SEQ * 8; e += gridDim.x * NTHREADS) { float c, s; rope_entry(e >> 3, e & 7, c, s); rope[2 * e] = c; rope[2 * e + 1] = s; } }
}

DEVI void phase_rmsnorm_bf16(const float* x, const float* g, bf16_t* out) {
    const int tid = launder_tid(), lane = tid & 63, wave = rfl(tid >> 6);
    const int gw = blockIdx.x * NWAVES + wave, NGW = gridDim.x * NWAVES;
    f32x4 gv[4];
#pragma unroll
    for (int j = 0; j < 4; ++j) gv[j] = *(const f32x4*)(g + 4 * lane + 256 * j);
    for (int m = gw; m < M; m += NGW) {
        const f32x4* xr = (const f32x4*)(x + (size_t)m * D) + lane; f32x4 v[4]; float s = 0.f;
#pragma unroll
        for (int j = 0; j < 4; ++j) { v[j] = xr[64 * j]; s += (v[j].x * v[j].x + v[j].y * v[j].y) + (v[j].z * v[j].z + v[j].w * v[j].w); }
        const float rstd = rsqf_(wave_sum(s) * (1.f / D) + EPS);
        u32x2* o8 = (u32x2*)(out + (size_t)m * D) + lane;
#pragma unroll
        for (int j = 0; j < 4; ++j) { u32x2 w; w.x = pk2(v[j].x * rstd * gv[j].x, v[j].y * rstd * gv[j].y); w.y = pk2(v[j].z * rstd * gv[j].z, v[j].w * rstd * gv[j].w); o8[64 * j] = w; }
    }
}
DEVI void phase_rmsnorm_f32_inplace(float* x, const float* g) {
    const int tid = launder_tid(), lane = tid & 63, wave = rfl(tid >> 6);
    const int gw = blockIdx.x * NWAVES + wave, NGW = gridDim.x * NWAVES;
    f32x4 gv[4];
#pragma unroll
    for (int j = 0; j < 4; ++j) gv[j] = *(const f32x4*)(g + 4 * lane + 256 * j);
    for (int m = gw; m < M; m += NGW) {
        f32x4* xr = (f32x4*)(x + (size_t)m * D) + lane; f32x4 v[4]; float s = 0.f;
#pragma unroll
        for (int j = 0; j < 4; ++j) { v[j] = xr[64 * j]; s += (v[j].x * v[j].x + v[j].y * v[j].y) + (v[j].z * v[j].z + v[j].w * v[j].w); }
        const float rstd = rsqf_(wave_sum(s) * (1.f / D) + EPS);
#pragma unroll
        for (int j = 0; j < 4; ++j) xr[64 * j] = v[j] * rstd * gv[j];
    }
}

DEVI void conv_item(const Args& a, unsigned char* lds, int layer, int item) {
    const int tid = launder_tid(), lane = tid & 63, wave = rfl(tid >> 6), c = tid & 255, hf = tid >> 8;
    const int b = item / (SEQ / 32), t0 = (item % (SEQ / 32)) * 32;
    const bf16_t* HB = (const bf16_t*)(a.ws + OFF_HB); bf16_t* Y = (bf16_t*)(a.ws + OFF_Y);
    float* u = (float*)lds; float* y = u + 62 * 256;
    for (int r = hf; r < 62; r += 2) { const int t = t0 - 15 + r; float v = 0.f;
        if (t >= 0 && t < SEQ) { const bf16_t* hp = HB + (size_t)(b * SEQ + t) * NHB; v = bf2f(hp[C_GLUA + c]) * sigmoidf_(bf2f(hp[C_GLUG + c])); }
        u[r * 256 + c] = v; }
    float w[31];
    const float* cw = a.in[I_CW] + (size_t)layer * 31 * 256;
#pragma unroll
    for (int k = 0; k < 31; ++k) w[k] = cw[k * 256 + c];
    const float bias = a.in[I_CB][layer * 256 + c];
    __syncthreads();
    for (int i = 0; i < 16; ++i) { const int tt = hf * 16 + i; float acc = bias;
#pragma unroll
        for (int k = 0; k < 31; ++k) acc += u[(tt + k) * 256 + c] * w[k];
        y[tt * 256 + c] = acc; }
    __syncthreads();
    const f32x4 lg = *(const f32x4*)(a.in[I_CLG] + layer * 256 + 4 * lane), lb = *(const f32x4*)(a.in[I_CLB] + layer * 256 + 4 * lane);
#pragma unroll
    for (int i = 0; i < 4; ++i) { const int tt = wave * 4 + i; f32x4 v = *(const f32x4*)(y + tt * 256 + 4 * lane);
        const float mu = wave_sum((v.x + v.y) + (v.z + v.w)) * (1.f / 256); v = v - mu;
        const float var = wave_sum((v.x * v.x + v.y * v.y) + (v.z * v.z + v.w * v.w)) * (1.f / 256); const float rstd = rsqf_(var + EPS);
        v = v * rstd * lg + lb;
        u32x2 o; o.x = pk2(siluf_(v.x), siluf_(v.y)); o.y = pk2(siluf_(v.z), siluf_(v.w));
        *(u32x2*)(Y + (size_t)(b * SEQ + t0 + tt) * D + 0 + 4 * lane) = o; }
    __syncthreads();
}
DEVI void pool_item(const Args& a, unsigned char* lds, int layer, int item) {
    const int tid = launder_tid(), c = tid & 255, hf = tid >> 8;
    const int b = item / (SEQ / 32), t0 = (item % (SEQ / 32)) * 32;
    const bf16_t* HB = (const bf16_t*)(a.ws + OFF_HB); bf16_t* Y = (bf16_t*)(a.ws + OFF_Y);
    float* u = (float*)lds; float* d = u + 48 * 256;
    for (int r = hf; r < 48; r += 2) { const int t = t0 - 8 + r; float v = 0.f;
        if (t >= 0 && t < SEQ) v = bf2f(HB[(size_t)(b * SEQ + t) * NHB + C_PIN + c]);
        u[r * 256 + c] = v; }
    const int e = tid & 63, g = (tid >> 6) & 3;
    const float* pwp = a.in[I_PW] + ((size_t)layer * 4 + g) * 64 * 64 + e;
    const float psc = a.in[I_PS][layer * 256 + g * 64 + e];
    __syncthreads();
    { const int gg = c >> 6, hw = 1 << gg;
      for (int i = 0; i < 16; ++i) { const int tt = hf * 16 + i, t = t0 + tt; const int lo = (t - hw) < 0 ? 0 : (t - hw), hi = (t + hw) > SEQ ? SEQ : (t + hw);
          float s = 0.f; for (int p = lo; p < hi; ++p) s += u[(p - t0 + 8) * 256 + c];
          d[tt * 256 + c] = s / (float)(hi - lo) - u[(tt + 8) * 256 + c]; } }
    __syncthreads();
    { float acc[16];
#pragma unroll
      for (int i = 0; i < 16; ++i) acc[i] = 0.f;
      const float* dp = d + hf * 16 * 256 + g * 64;
#pragma unroll 4
      for (int cc = 0; cc < 64; ++cc) { const float wv = pwp[cc * 64];
#pragma unroll
          for (int i = 0; i < 16; ++i) acc[i] += dp[i * 256 + cc] * wv; }
#pragma unroll
      for (int i = 0; i < 16; ++i) Y[(size_t)(b * SEQ + t0 + hf * 16 + i) * D + 768 + g * 64 + e] = (bf16_t)f2bf(acc[i] * psc); }
    __syncthreads();
}
DEVI int crow(int r, int hi) { return (r & 3) + 8 * (r >> 2) + 4 * hi; }
constexpr int KS_LD = 72, VT_LD = 388;
DEVI void attn_item(const Args& a, unsigned char* lds, int layer, int item) {
    const int tid = launder_tid(), lane = tid & 63, wave = rfl(tid >> 6);
    const int b = item / (2 * NAB), kv = (item / NAB) & 1, n = item % NAB;
    const bf16_t* HB = (const bf16_t*)(a.ws + OFF_HB); bf16_t* Y = (bf16_t*)(a.ws + OFF_Y); const float* rope = (const float*)(a.ws + OFF_ROPE);
    bf16_t* Ks = (bf16_t*)lds; bf16_t* Vt = Ks + 384 * KS_LD;
    const int kbase = n * 128 - 128;
    for (int e = tid; e < 384 * 8; e += NTHREADS) { const int wr = e >> 3, c8 = e & 7, kpos = kbase + wr;
        u32x4 kw = (u32x4){0u, 0u, 0u, 0u}, vw = (u32x4){0u, 0u, 0u, 0u};
        if (kpos >= 0 && kpos < SEQ) { const bf16_t* hp = HB + (size_t)(b * SEQ + kpos) * NHB;
            kw = *(const u32x4*)(hp + C_AK + kv * 64 + c8 * 8); vw = *(const u32x4*)(hp + C_AV + kv * 64 + c8 * 8);
            if (c8 < 2) { const u32x4 pw = *(const u32x4*)(hp + C_AK + kv * 64 + (c8 ^ 1) * 8); const float sg = c8 ? 1.f : -1.f; const float* rp = rope + (size_t)kpos * 16;
                float o[8];
#pragma unroll
                for (int j = 0; j < 4; ++j) { const float m0 = bflo(kw[j]), m1 = bfhi(kw[j]), p0 = bflo(pw[j]), p1 = bfhi(pw[j]);
                    o[2 * j] = m0 * rp[4 * j] + sg * p0 * rp[4 * j + 1]; o[2 * j + 1] = m1 * rp[4 * j + 2] + sg * p1 * rp[4 * j + 3]; }
                kw = (u32x4){pk2(o[0], o[1]), pk2(o[2], o[3]), pk2(o[4], o[5]), pk2(o[6], o[7])}; } }
        *(u32x4*)(Ks + wr * KS_LD + c8 * 8) = kw;
#pragma unroll
        for (int j = 0; j < 4; ++j) { Vt[(c8 * 8 + 2 * j) * VT_LD + wr] = (bf16_t)(vw[j] & 0xffffu); Vt[(c8 * 8 + 2 * j + 1) * VT_LD + wr] = (bf16_t)(vw[j] >> 16); } }
    const int g = wave >> 2, hq = kv * 2 + g, q0l = (wave & 3) * 32, ql = lane & 31, hi = lane >> 5, qpos = n * 128 + q0l + ql;
    bf16x8 qf[4];
    { const bf16_t* qp = HB + (size_t)(b * SEQ + qpos) * NHB + C_AQ + hq * 64 + hi * 8; const float* rp = rope + (size_t)qpos * 16; const float sg = hi ? 1.f : -1.f;
#pragma unroll
      for (int ds = 0; ds < 4; ++ds) { const u32x4 w = *(const u32x4*)(qp + ds * 16); float v[8];
#pragma unroll
          for (int j = 0; j < 4; ++j) { v[2 * j] = bflo(w[j]); v[2 * j + 1] = bfhi(w[j]); }
          if (ds == 0) {
#pragma unroll
              for (int j = 0; j < 8; ++j) { const float p = __shfl_xor(v[j], 32); v[j] = v[j] * rp[2 * j] + sg * p * rp[2 * j + 1]; } }
          u32x4 o = (u32x4){pk2(v[0] * 0.125f, v[1] * 0.125f), pk2(v[2] * 0.125f, v[3] * 0.125f), pk2(v[4] * 0.125f, v[5] * 0.125f), pk2(v[6] * 0.125f, v[7] * 0.125f)};
          qf[ds] = __builtin_bit_cast(bf16x8, o); } }
    __syncthreads();
    float m2 = a.in[I_SINK][layer * 4 + hq] * LOG2E, l_own = hi ? 0.f : 1.f;
    f32x16 o0 = {}, o1 = {};
    for (int kt = 0; kt < 9; ++kt) {
        const int wb = q0l + 32 * kt, kpos0 = kbase + wb;
        if (kpos0 < 0 || kpos0 >= SEQ) continue;
        f32x16 s = {};
#pragma unroll
        for (int ds = 0; ds < 4; ++ds) { const bf16x8 kf = *(const bf16x8*)(Ks + (wb + ql) * KS_LD + ds * 16 + hi * 8); s = mfma32(kf, qf[ds], s); }
        float mt = -INFINITY;
#pragma unroll
        for (int r = 0; r < 16; ++r) { const int kin = crow(r, hi); float v = s[r] * LOG2E;
            if (kt == 0 && kin < ql) v = -INFINITY;
            if (kt == 8 && kin > ql) v = -INFINITY;
            s[r] = v; mt = fmaxf(mt, v); }
        mt = fmaxf(mt, __shfl_xor(mt, 32));
        const float mn = fmaxf(m2, mt), alpha = ex2(m2 - mn); m2 = mn;
        float ps = 0.f;
#pragma unroll
        for (int r = 0; r < 16; ++r) { s[r] = ex2(s[r] - mn); ps += s[r]; }
        l_own = l_own * alpha + ps;
#pragma unroll
        for (int r = 0; r < 16; ++r) { o0[r] *= alpha; o1[r] *= alpha; }
        bf16x8 pb[2];
#pragma unroll
        for (int sI = 0; sI < 2; ++sI) { u32x4 w = (u32x4){pk2(s[8 * sI + 0], s[8 * sI + 1]), pk2(s[8 * sI + 2], s[8 * sI + 3]), pk2(s[8 * sI + 4], s[8 * sI + 5]), pk2(s[8 * sI + 6], s[8 * sI + 7])}; pb[sI] = __builtin_bit_cast(bf16x8, w); }
#pragma unroll
        for (int sI = 0; sI < 2; ++sI) {
            const bf16_t* v0 = Vt + (size_t)ql * VT_LD + wb + 16 * sI + 4 * hi;
            const s16x4 a0 = *(const s16x4*)(v0), a1 = *(const s16x4*)(v0 + 8), c0 = *(const s16x4*)(v0 + 32 * VT_LD), c1 = *(const s16x4*)(v0 + 32 * VT_LD + 8);
            o0 = mfma32((bf16x8){a0[0], a0[1], a0[2], a0[3], a1[0], a1[1], a1[2], a1[3]}, pb[sI], o0);
            o1 = mfma32((bf16x8){c0[0], c0[1], c0[2], c0[3], c1[0], c1[1], c1[2], c1[3]}, pb[sI], o1); }
    }
    const float linv = 1.0f / (l_own + __shfl_xor(l_own, 32));
    bf16_t* yp = Y + (size_t)(b * SEQ + qpos) * D + 512 + hq * 64 + 4 * hi;
#pragma unroll
    for (int g4 = 0; g4 < 4; ++g4) {
        u32x2 w0, w1; w0.x = pk2(o0[4 * g4] * linv, o0[4 * g4 + 1] * linv); w0.y = pk2(o0[4 * g4 + 2] * linv, o0[4 * g4 + 3] * linv);
        w1.x = pk2(o1[4 * g4] * linv, o1[4 * g4 + 1] * linv); w1.y = pk2(o1[4 * g4 + 2] * linv, o1[4 * g4 + 3] * linv);
        *(u32x2*)(yp + 8 * g4) = w0; *(u32x2*)(yp + 32 + 8 * g4) = w1; }
    __syncthreads();
}
DEVI void gla_load_b(const Args& a, int layer, const bf16_t* hrow0  , int h, float* lgb, float* tot) {
    const int tid = launder_tid();
    const float* bup = a.in[I_BUP] + (size_t)layer * 2 * 128;
    for (int e = tid; e < 2 * 64 * 32; e += NTHREADS) { const int dir = e >> 11, j = (e >> 5) & 63, d = e & 31;
        const float z = bf2f(hrow0[(size_t)j * NHB + C_Z + dir * 128 + h * 32 + d]) + bup[dir * 128 + h * 32 + d];
        lgb[e] = logsigf_(z) * (1.f / 16.f); }
    __syncthreads();
    if (tid < 64) { const int dir = tid >> 5, d = tid & 31; float* p = lgb + dir * 2048 + d; float acc = 0.f;
        if (dir == 0) { for (int j = 0; j < 64; ++j) { acc += p[j * 32]; p[j * 32] = acc; } }
        else { for (int j = 63; j >= 0; --j) { acc += p[j * 32]; p[j * 32] = acc; } }
        tot[tid] = acc; }
    __syncthreads();
}
DEVI void gla_x_item(const Args& a, unsigned char* lds, int layer, int item) {
    const int tid = launder_tid();
    const int h = item & 3, c = (item >> 2) % NCH, b = item / (4 * NCH);
    const bf16_t* hrow0 = (const bf16_t*)(a.ws + OFF_HB) + (size_t)(b * SEQ + c * 64) * NHB;
    float* lgb = (float*)lds; float* kh = lgb + 4096; float* v = kh + 4096; float* tot = v + 4096;
    gla_load_b(a, layer, hrow0, h, lgb, tot);
    for (int e = tid; e < 2 * 2048; e += NTHREADS) { const int dir = e >> 11, j = (e >> 5) & 63, d = e & 31;
        kh[e] = bf2f(hrow0[(size_t)j * NHB + C_GK + h * 32 + d]) * ex2((tot[dir * 32 + d] - lgb[e]) * LOG2E); }
    for (int e = tid; e < 4096; e += NTHREADS) { const int j = e >> 6, ee = e & 63; v[e] = bf2f(hrow0[(size_t)j * NHB + C_GV + h * 64 + ee]); }
    float* GU = (float*)(a.ws + OFF_GU); float* GD = (float*)(a.ws + OFF_GD);
    if (tid < 64) { const int dir = tid >> 5, d = tid & 31; GD[((size_t)((b * 4 + h) * 2 + dir) * NCH + c) * 32 + d] = ex2(tot[tid] * LOG2E); }
    __syncthreads();
    const int e = tid & 63, dg = tid >> 6;
    float acc[2][4] = {};
    for (int j = 0; j < 64; ++j) { const float vv = v[j * 64 + e];
#pragma unroll
        for (int dir = 0; dir < 2; ++dir)
#pragma unroll
            for (int i = 0; i < 4; ++i) acc[dir][i] += kh[dir * 2048 + j * 32 + dg * 4 + i] * vv; }
#pragma unroll
    for (int dir = 0; dir < 2; ++dir)
#pragma unroll
        for (int i = 0; i < 4; ++i) GU[((size_t)((b * 4 + h) * 2 + dir) * NCH + c) * 2048 + (dg * 4 + i) * 64 + e] = acc[dir][i];
    __syncthreads();
}
DEVI void gla_scan(const Args& a) {
    float* GU = (float*)(a.ws + OFF_GU); const float* GD = (const float*)(a.ws + OFF_GD);
    constexpr int TOTAL = BATCH * 4 * 2 * 2048, UNR = (NCH % 16 == 0) ? 16 : 4;
    const int tid = launder_tid(); if (tid >= 128) return;
    for (int eid = blockIdx.x * 128 + tid; eid < TOTAL; eid += gridDim.x * 128) {
        const int seq = eid >> 11, de = eid & 2047, d = de >> 6, dir = seq & 1; float S = 0.f;
        for (int s0 = 0; s0 < NCH; s0 += UNR) { float u[UNR], dc[UNR];
#pragma unroll
            for (int k = 0; k < UNR; ++k) { const int c = dir ? NCH - 1 - (s0 + k) : s0 + k; u[k] = GU[((size_t)seq * NCH + c) * 2048 + de]; dc[k] = GD[((size_t)seq * NCH + c) * 32 + d]; }
#pragma unroll
            for (int k = 0; k < UNR; ++k) { const int c = dir ? NCH - 1 - (s0 + k) : s0 + k; GU[((size_t)seq * NCH + c) * 2048 + de] = S; S = dc[k] * S + u[k]; } }
    }
}
DEVI void gla_z_item(const Args& a, unsigned char* lds, int layer, int item) {
    const int tid = launder_tid(), wave = rfl(tid >> 6);
    const int h = item & 3, c = (item >> 2) % NCH, b = item / (4 * NCH);
    const bf16_t* hrow0 = (const bf16_t*)(a.ws + OFF_HB) + (size_t)(b * SEQ + c * 64) * NHB;
    float* lgb = (float*)lds;
    float* qt = lgb + 4096;
    float* kt = qt + 2 * 64 * 33;
    float* v = kt + 2 * 64 * 33;
    float* S = v + 4096;
    float* A = S + 4096;
    float* tot = A + 64 * 65;
    gla_load_b(a, layer, hrow0, h, lgb, tot);
    const float* GU = (const float*)(a.ws + OFF_GU);
    for (int e = tid; e < 2048; e += NTHREADS) { const int j = e >> 5, d = e & 31;
        const float q = bf2f(hrow0[(size_t)j * NHB + C_GQ + h * 32 + d]) * 0.17677669529663687f, k = bf2f(hrow0[(size_t)j * NHB + C_GK + h * 32 + d]);
#pragma unroll
        for (int dir = 0; dir < 2; ++dir) { const float bb = lgb[dir * 2048 + e] * LOG2E; qt[dir * 2112 + j * 33 + d] = q * ex2(bb); kt[dir * 2112 + j * 33 + d] = k * ex2(-bb); } }
    for (int e = tid; e < 4096; e += NTHREADS) { const int j = e >> 6, ee = e & 63; v[e] = bf2f(hrow0[(size_t)j * NHB + C_GV + h * 64 + ee]);
        const int dir = e >> 11; S[e] = GU[((size_t)((b * 4 + h) * 2 + dir) * NCH + c) * 2048 + (e & 2047)]; }
    __syncthreads();
    { const int j = tid & 63, ig = tid >> 6;
      for (int ii = 0; ii < 8; ++ii) { const int i = ig * 8 + ii; float af = 0.f, ab = 0.f;
#pragma unroll
          for (int d = 0; d < 32; ++d) { af += qt[i * 33 + d] * kt[j * 33 + d]; ab += qt[2112 + i * 33 + d] * kt[2112 + j * 33 + d]; }
          A[i * 65 + j] = (j <= i ? af : 0.f) + (j >= i ? ab : 0.f); } }
    __syncthreads();
    { const int e = tid & 63; const float ng = a.in[I_GNG][layer * 256 + h * 64 + e];
      bf16_t* Y = (bf16_t*)(a.ws + OFF_Y);
      for (int ii = 0; ii < 8; ++ii) { const int i = wave * 8 + ii; float o = 0.f;
#pragma unroll 8
          for (int j = 0; j < 64; ++j) o += A[i * 65 + j] * v[j * 64 + e];
#pragma unroll 8
          for (int d = 0; d < 32; ++d) o += qt[i * 33 + d] * S[d * 64 + e] + qt[2112 + i * 33 + d] * S[2048 + d * 64 + e];
          const float ms = wave_sum(o * o) * (1.f / 64.f); const float gr = bf2f(hrow0[(size_t)i * NHB + C_GR + h * 64 + e]);
          Y[(size_t)(b * SEQ + c * 64 + i) * D + 256 + h * 64 + e] = (bf16_t)f2bf(o * rsqf_(ms + EPS) * ng * siluf_(gr)); } }
    __syncthreads();
}
DEVI void phase_mix1(const Args& a, unsigned char* lds, int layer) {
    constexpr int N_ATT = BATCH * 2 * NAB, N_CONV = BATCH * (SEQ / 32), N_POOL = N_CONV, N_GX = BATCH * NCH * 4, N_ALL = N_ATT + N_CONV + N_POOL + N_GX;
    for (int it = blockIdx.x; it < N_ALL; it += gridDim.x) { int r = it;
        if (r < N_ATT) { attn_item(a, lds, layer, r); continue; } r -= N_ATT;
        if (r < N_CONV) { conv_item(a, lds, layer, r); continue; } r -= N_CONV;
        if (r < N_POOL) { pool_item(a, lds, layer, r); continue; } r -= N_POOL;
        gla_x_item(a, lds, layer, r); }
}
DEVI void phase_mix3(const Args& a, unsigned char* lds, int layer) {
    constexpr int N_GZ = BATCH * NCH * 4;
    for (int it = blockIdx.x; it < N_GZ; it += gridDim.x) gla_z_item(a, lds, layer, it);
}

namespace pg8 {
constexpr int BM = 256, BK = 64, HALF = 128, HTB = HALF * BK * 2, STAGE_BYTES = 8 * HTB, NXCD = 8, WGM = 8;
DEVI int lds_byte(int r, int c) { const int st = (r >> 4) * 2 + (c >> 5), rr = r & 15, cc = c & 31, ob = rr * 64 + cc * 2; return st * 1024 + (ob ^ (((ob >> 9) & 1) << 5)); }
DEVI void stage_rc(int b, int& R, int& C) { const int st = b / 1024, sb = b % 1024, swz = sb ^ (((sb >> 9) & 1) << 5); R = (st >> 1) * 16 + swz / 64; C = (st & 1) * 32 + (swz % 64) / 2; }
DEVI int perm32(int rho) { const int n = rho >> 4, i = rho & 15; return 8 * (i >> 2) + 4 * n + (i & 3); }
struct Unit { int pm, pn, br; };
struct Gemm { const bf16_t* A; const bf16_t* Bt; int K, lda, ldb; size_t a_br, b_br; };
struct StaticOrder {
    int nM, nN, nwg, G, c;
    DEVM void init(int Mr, int N, int G_, int c_) { nM = Mr / BM; nN = N / BM; nwg = nM * nN; G = G_; c = c_; }
    DEVM bool tile(long L, Unit& u) const {
        if (L >= nwg) return false;
        int wgid = (int)L; { const int q = nwg / NXCD, r = nwg % NXCD, xcd = wgid % NXCD, off = wgid / NXCD; wgid = (xcd < r ? xcd * (q + 1) : r * (q + 1) + (xcd - r) * q) + off; }
        const int nig = WGM * nN, gid = wgid / nig, fm = gid * WGM, gsz = (nM - fm) < WGM ? (nM - fm) : WGM;
        u.pm = fm + ((wgid % nig) % gsz); u.pn = (wgid % nig) / gsz; u.br = 0; return true;
    }
    DEVM bool next(int i, Unit& u) const { return tile((long)i * G + c, u); }
};
struct BranchOrder : StaticOrder {
    DEVM bool next(int i, Unit& u) const { if (!tile((long)(i >> 2) * G + c, u)) return false; u.br = i & 3; return true; }
};
template <int ACT  > struct EpiBf16 {
    static constexpr bool PERM = true;
    bf16_t* O; int ldc;
    DEVM void operator()(const f32x4 (&acc)[2][2][4][2], const Unit& u, int wr, int wc, int fr, int fq) const {
        const int row0 = u.pm * BM + wr * 64 + fr, col0 = u.pn * BM + wc * 32 + 8 * fq;
#pragma unroll
        for (int ai = 0; ai < 2; ++ai)
#pragma unroll
            for (int m = 0; m < 4; ++m) { bf16_t* rowp = O + (size_t)(row0 + ai * HALF + m * 16) * ldc + col0;
#pragma unroll
                for (int bj = 0; bj < 2; ++bj) { f32x4 v0 = acc[ai][bj][m][0], v1 = acc[ai][bj][m][1];
                    if (ACT == 1) {
#pragma unroll
                        for (int q = 0; q < 4; ++q) { v0[q] = sigmoidf_(v0[q]); v1[q] = sigmoidf_(v1[q]); } }
                    if (ACT == 2) {
#pragma unroll
                        for (int q = 0; q < 4; ++q) { const float r0 = fmaxf(v0[q], 0.f), r1 = fmaxf(v1[q], 0.f); v0[q] = r0 * r0; v1[q] = r1 * r1; } }
                    u32x4 w; w.x = pk2(v0[0], v0[1]); w.y = pk2(v0[2], v0[3]); w.z = pk2(v1[0], v1[1]); w.w = pk2(v1[2], v1[3]);
                    *(u32x4*)(rowp + bj * HALF) = w; } }
    }
};
struct EpiMerge {
    static constexpr bool PERM = true;
    bf16_t* O; const bf16_t* G;
    DEVM void operator()(const f32x4 (&acc)[2][2][4][2], const Unit& u, int wr, int wc, int fr, int fq) const {
        const int row0 = u.pm * BM + wr * 64 + fr, col0 = u.pn * BM + wc * 32 + 8 * fq;
#pragma unroll
        for (int ai = 0; ai < 2; ++ai)
#pragma unroll
            for (int m = 0; m < 4; ++m) { const size_t row = (size_t)(row0 + ai * HALF + m * 16); bf16_t* rowp = O + row * D + col0; const bf16_t* gp = G + row * NGATE + u.br * D + col0;
#pragma unroll
                for (int bj = 0; bj < 2; ++bj) { const f32x4 v0 = acc[ai][bj][m][0], v1 = acc[ai][bj][m][1];
                    const u32x4 gw = *(const u32x4*)(gp + bj * HALF);
                    float o[8] = {v0[0] * bflo(gw.x), v0[1] * bfhi(gw.x), v0[2] * bflo(gw.y), v0[3] * bfhi(gw.y), v1[0] * bflo(gw.z), v1[1] * bfhi(gw.z), v1[2] * bflo(gw.w), v1[3] * bfhi(gw.w)};
                    if (u.br != 0) { const u32x4 pw = *(const u32x4*)(rowp + bj * HALF);
                        o[0] += bflo(pw.x); o[1] += bfhi(pw.x); o[2] += bflo(pw.y); o[3] += bfhi(pw.y); o[4] += bflo(pw.z); o[5] += bfhi(pw.z); o[6] += bflo(pw.w); o[7] += bfhi(pw.w); }
                    u32x4 w; w.x = pk2(o[0], o[1]); w.y = pk2(o[2], o[3]); w.z = pk2(o[4], o[5]); w.w = pk2(o[6], o[7]);
                    *(u32x4*)(rowp + bj * HALF) = w; }
#ifndef CPU_EMU
                asm volatile("" ::: "memory");
#endif
            }
    }
};
struct EpiResF32 {
    static constexpr bool PERM = false;
    const float* base; float* out;
    DEVM void operator()(const f32x4 (&acc)[2][2][4][2], const Unit& u, int wr, int wc, int fr, int fq) const {
        const int row0 = u.pm * BM + wr * 64 + fr, col0 = u.pn * BM + wc * 32 + 4 * fq;
#pragma unroll
        for (int ai = 0; ai < 2; ++ai)
#pragma unroll
            for (int m = 0; m < 4; ++m) { const size_t off = (size_t)(row0 + ai * HALF + m * 16) * D + col0;
#pragma unroll
                for (int bj = 0; bj < 2; ++bj)
#pragma unroll
                    for (int n = 0; n < 2; ++n) { const f32x4 bs = *(const f32x4*)(base + off + bj * HALF + n * 16); *(f32x4*)(out + off + bj * HALF + n * 16) = bs + acc[ai][bj][m][n]; } }
    }
};
#ifndef CPU_EMU
#define PG8_LAS __attribute__((address_space(3)))
template <class Epi, class Sched, bool ALIGN_EPI = true>
__device__ __forceinline__ void gemm_phase(PG8_LAS unsigned char* lds, const Gemm g, const Sched& S, const Epi& E) {
    int tid_ = threadIdx.x; asm volatile("" : "+v"(tid_));
    const int tid = tid_, wid = __builtin_amdgcn_readfirstlane(tid >> 6), lane = tid & 63, wr = wid >> 2, wc = wid & 3, fr = lane & 15, fq = lane >> 4;
    const int K = g.K, nt = K / BK;
    unsigned voffA[2], voffB[2];
#pragma unroll
    for (int i = 0; i < 2; ++i) { int R, C; stage_rc(tid * 16 + i * 8192, R, C); const int Rb = Epi::PERM ? ((R & ~31) + perm32(R & 31)) : R;
        voffA[i] = (unsigned)(R * g.lda + C) * 2u; voffB[i] = (unsigned)(Rb * g.ldb + C) * 2u; }
    const size_t kstep = (size_t)(BK * 2);
    const size_t hstepA = (size_t)HALF * g.lda * 2, hstepB = (size_t)HALF * g.ldb * 2;
    const size_t tstepA = 2 * hstepA, tstepB = 2 * hstepB;
    const unsigned ldsw = (unsigned)wid * 1024u;
    const int aoff = lds_byte(wr * 64 + fr, fq * 8), boff = lds_byte(wc * 32 + fr, fq * 8);
#define PG8_SA(b, h) (((b) * 2 + (h)) * HTB)
#define PG8_SB(b, h) ((4 + (b) * 2 + (h)) * HTB)
#define PG8_STAGE(bufoff, gbase, voff) do { _Pragma("unroll") for (int _i = 0; _i < 2; ++_i) \
        __builtin_amdgcn_global_load_lds((const unsigned*)((const char*)(gbase) + (voff)[_i]), (PG8_LAS unsigned*)(lds + (bufoff) + ldsw + _i * 8192), 16, 0, 0); } while (0)
#define PG8_LDA(dst, b, h) do { _Pragma("unroll") for (int m = 0; m < 4; ++m) _Pragma("unroll") for (int k = 0; k < 2; ++k) dst[m][k] = *(const PG8_LAS bf16x8*)(lds + PG8_SA(b, h) + aoff + m * 2048 + k * 1024); } while (0)
#define PG8_LDB(dst, b, h) do { _Pragma("unroll") for (int n = 0; n < 2; ++n) _Pragma("unroll") for (int k = 0; k < 2; ++k) dst[n][k] = *(const PG8_LAS bf16x8*)(lds + PG8_SB(b, h) + boff + n * 2048 + k * 1024); } while (0)
#define PG8_MMA(ai, bj, At, Bt) do { __builtin_amdgcn_s_setprio(1); _Pragma("unroll") for (int m = 0; m < 4; ++m) _Pragma("unroll") for (int n = 0; n < 2; ++n) _Pragma("unroll") for (int k = 0; k < 2; ++k) \
        acc[ai][bj][m][n] = __builtin_amdgcn_mfma_f32_16x16x32_bf16(Bt[n][k], At[m][k], acc[ai][bj][m][n], 0, 0, 0); __builtin_amdgcn_s_setprio(0); } while (0)
#define PG8_WAIT_V(n) asm volatile("s_waitcnt vmcnt(" #n ")" ::: "memory")
#define PG8_WAIT_L(n) asm volatile("s_waitcnt lgkmcnt(" #n ")" ::: "memory")
#define PG8_BAR __builtin_amdgcn_s_barrier()
#define PG8_SCHED __builtin_amdgcn_sched_barrier(0)
#define PG8_ABASE(u) ((const char*)(g.A + (size_t)(u).br * g.a_br) + (size_t)(u).pm * tstepA)
#define PG8_BBASE(u) ((const char*)(g.Bt + (size_t)(u).br * g.b_br) + (size_t)(u).pn * tstepB)
    Unit cur, nxt; int ui = 0;
    if (!S.next(0, cur)) return;
    f32x4 acc[2][2][4][2];
#pragma unroll
    for (int a = 0; a < 2; ++a)
#pragma unroll
        for (int b = 0; b < 2; ++b)
#pragma unroll
            for (int m = 0; m < 4; ++m)
#pragma unroll
                for (int n = 0; n < 2; ++n) acc[a][b][m][n] = (f32x4){0.f, 0.f, 0.f, 0.f};
    bf16x8 At[4][2], B0[2][2], B1[2][2];
    const char* cA = PG8_ABASE(cur); const char* cB = PG8_BBASE(cur);
    PG8_STAGE(PG8_SB(0, 0), cB, voffB); PG8_STAGE(PG8_SB(0, 1), cB + hstepB, voffB); PG8_STAGE(PG8_SA(0, 0), cA, voffA); PG8_STAGE(PG8_SA(0, 1), cA + hstepA, voffA);
    if (wr == 1) PG8_BAR;
    PG8_WAIT_V(2); PG8_BAR;
    PG8_STAGE(PG8_SB(1, 0), cB + kstep, voffB); PG8_STAGE(PG8_SA(1, 0), cA + kstep, voffA); PG8_STAGE(PG8_SB(1, 1), cB + hstepB + kstep, voffB);
    PG8_WAIT_V(6); PG8_BAR;
    for (;;) {
        const bool has_next = S.next(ui + 1, nxt);
        const char* nA = has_next ? PG8_ABASE(nxt) : cA; const char* nB = has_next ? PG8_BBASE(nxt) : cB;
#pragma nounroll
        for (int t = 0; t < nt; t += 2) {
            const bool last = (t == nt - 2);
            const char* a1 = cA + (size_t)(t + 1) * kstep;
            const char* a2 = last ? nA : cA + (size_t)(t + 2) * kstep; const char* b2 = last ? nB : cB + (size_t)(t + 2) * kstep;
            const char* a3 = a2 + kstep; const char* b3 = b2 + kstep;
            PG8_LDB(B0, 0, 0); PG8_LDB(B1, 0, 1); PG8_SCHED; PG8_LDA(At, 0, 0); PG8_STAGE(PG8_SA(1, 1), a1 + hstepA, voffA);
            PG8_WAIT_V(8); PG8_WAIT_L(0); PG8_BAR; PG8_MMA(0, 0, At, B0); PG8_MMA(0, 1, At, B1); PG8_BAR; PG8_SCHED;
            PG8_LDA(At, 0, 1); PG8_STAGE(PG8_SB(0, 0), b2, voffB); PG8_STAGE(PG8_SB(0, 1), b2 + hstepB, voffB); PG8_STAGE(PG8_SA(0, 0), a2, voffA);
            PG8_WAIT_V(8); PG8_WAIT_L(0); PG8_BAR; PG8_MMA(1, 0, At, B0); PG8_MMA(1, 1, At, B1); PG8_BAR; PG8_SCHED;
            PG8_LDB(B0, 1, 0); PG8_LDB(B1, 1, 1); PG8_SCHED; PG8_LDA(At, 1, 0); PG8_STAGE(PG8_SA(0, 1), a2 + hstepA, voffA);
            PG8_WAIT_V(8); PG8_WAIT_L(0); PG8_BAR; PG8_MMA(0, 0, At, B0); PG8_MMA(0, 1, At, B1); PG8_BAR; PG8_SCHED;
            PG8_LDA(At, 1, 1); PG8_STAGE(PG8_SB(1, 0), b3, voffB); PG8_STAGE(PG8_SB(1, 1), b3 + hstepB, voffB); PG8_STAGE(PG8_SA(1, 0), a3, voffA);
            PG8_WAIT_V(8); PG8_WAIT_L(0); PG8_BAR; PG8_MMA(1, 0, At, B0); PG8_MMA(1, 1, At, B1); PG8_BAR; PG8_SCHED;
        }
        if constexpr (ALIGN_EPI) { if (wr == 0) PG8_BAR; }
        E(acc, cur, wr, wc, fr, fq);
        if (!has_next) break;
#pragma unroll
        for (int a = 0; a < 2; ++a)
#pragma unroll
            for (int b = 0; b < 2; ++b)
#pragma unroll
                for (int m = 0; m < 4; ++m)
#pragma unroll
                    for (int n = 0; n < 2; ++n) acc[a][b][m][n] = (f32x4){0.f, 0.f, 0.f, 0.f};
        cur = nxt; cA = nA; cB = nB; ++ui;
        if constexpr (ALIGN_EPI) { if (wr == 1) PG8_BAR; }
    }
    PG8_WAIT_V(0);
    if constexpr (!ALIGN_EPI) { if (wr == 0) PG8_BAR; }
    PG8_BAR;
#undef PG8_SA
#undef PG8_SB
#undef PG8_STAGE
#undef PG8_LDA
#undef PG8_LDB
#undef PG8_MMA
#undef PG8_WAIT_V
#undef PG8_WAIT_L
#undef PG8_BAR
#undef PG8_SCHED
#undef PG8_ABASE
#undef PG8_BBASE
}
#endif
}

#ifndef CPU_EMU
#define LAS __attribute__((address_space(3)))
#define XB_TMO      128
#define XB_XCNT(j)  (256  + 64 * (j))
#define XB_XSUB(j)  (1280 + 64 * (j))
#define XB_XGEN(j)  (2304 + 64 * (j))
#define XB_TOP      3328
#define XB_TOPGEN   3392
#define XCD_BAR_WORDS 3456
#define XB_SPIN_CAP (1u << 20)
__device__ __forceinline__ unsigned xb_ld(unsigned* p)              { return __hip_atomic_load(p, __ATOMIC_RELAXED, __HIP_MEMORY_SCOPE_AGENT); }
__device__ __forceinline__ unsigned xb_add(unsigned* p, unsigned v) { return __hip_atomic_fetch_add(p, v, __ATOMIC_RELAXED, __HIP_MEMORY_SCOPE_AGENT); }
__device__ __forceinline__ unsigned xb_xcc_id() { return (unsigned)__builtin_amdgcn_s_getreg((3 << 11) | 20) & 0xFu; }
#define XB_SPIN(cond, bar) do { unsigned _sp = 0; while (cond) { __builtin_amdgcn_s_sleep(1); \
    if ((++_sp & 255u) == 0u) { if (xb_ld(&(bar)[XB_TMO])) break; if (_sp > XB_SPIN_CAP) { atomicAdd(&(bar)[XB_TMO], 1u); break; } } } } while (0)
struct XcdBarrier { unsigned* bar; unsigned x; volatile LAS unsigned* st; };
__device__ __forceinline__ XcdBarrier xcd_barrier_post(unsigned* bar, volatile LAS unsigned* st) {
    XcdBarrier b; b.bar = bar; b.x = xb_xcc_id(); b.st = st;
    if (threadIdx.x == 0) (void)xb_add(&bar[XB_XCNT(b.x)], 1u);
    return b;
}
__device__ __forceinline__ void xcd_barrier_complete(unsigned* bar, unsigned x, unsigned& nloc, unsigned& nx) {
    const unsigned G = gridDim.x * gridDim.y * gridDim.z;
    unsigned sum, cnt, mine, sp = 0u;
    for (;;) {
        sum = 0u; cnt = 0u; mine = 0u;
#pragma unroll
        for (unsigned j = 0; j < 16; ++j) { const unsigned c = xb_ld(&bar[XB_XCNT(j)]); sum += c; cnt += (c > 0u) ? 1u : 0u; mine = (j == x) ? c : mine; }
        if (sum == G) break;
        __builtin_amdgcn_s_sleep(1);
        if ((++sp & 255u) == 0u) { if (xb_ld(&bar[XB_TMO])) break; if (sp > XB_SPIN_CAP) { atomicAdd(&bar[XB_TMO], 1u); break; } }
    }
    nloc = mine > 0u ? mine : 1u; nx = cnt > 0u ? cnt : 1u;
}
__device__ __forceinline__ void xcd_barrier(const XcdBarrier& b) {
    asm volatile("s_waitcnt vmcnt(0)" ::: "memory");
    __syncthreads();
    if (threadIdx.x == 0) {
        unsigned* bar = b.bar;
        __builtin_amdgcn_s_waitcnt(0);
        unsigned nloc = b.st[0], nx = b.st[1];
        if (nloc == 0u) { xcd_barrier_complete(bar, b.x, nloc, nx); b.st[0] = nloc; b.st[1] = nx; }
        const unsigned old = xb_add(&bar[XB_XSUB(b.x)], 1u);
        const unsigned gen = old / nloc;
        if (old + 1u == (gen + 1u) * nloc) {
            __builtin_amdgcn_fence(__ATOMIC_RELEASE, "agent");
            asm volatile("s_waitcnt vmcnt(0)" ::: "memory");
            const unsigned og = xb_add(&bar[XB_TOP], 1u);
            const unsigned tg = og / nx;
            if (og + 1u == (tg + 1u) * nx) xb_add(&bar[XB_TOPGEN], 1u);
            else XB_SPIN(xb_ld(&bar[XB_TOPGEN]) == tg, bar);
            __builtin_amdgcn_fence(__ATOMIC_ACQUIRE, "agent");
            xb_add(&bar[XB_XGEN(b.x)], 1u);
            asm volatile("s_waitcnt vmcnt(0)" ::: "memory");
        } else {
            XB_SPIN(xb_ld(&bar[XB_XGEN(b.x)]) == gen, bar);
            __builtin_amdgcn_fence(__ATOMIC_ACQUIRE, "agent");
            asm volatile("s_waitcnt vmcnt(0)" ::: "memory");
        }
    }
    __syncthreads();
}
constexpr int LDS_BYTES = 147456;
constexpr int LDSCTL_OFF = 131072 + 320;
__global__ void __launch_bounds__(NTHREADS, 2) mega_fwd(Args a) {
    extern __shared__ __attribute__((aligned(16))) unsigned char lds[];
    __attribute__((address_space(3))) unsigned char* lds3 = (__attribute__((address_space(3))) unsigned char*)lds;
    unsigned char* ws = a.ws;
    bf16_t* XN = (bf16_t*)(ws + OFF_XN); bf16_t* Yb = (bf16_t*)(ws + OFF_Y); bf16_t* HB = (bf16_t*)(ws + OFF_HB); bf16_t* Gb = (bf16_t*)(ws + OFF_G); bf16_t* UP = (bf16_t*)(ws + OFF_UP);
    const bf16_t* WIN_T = (const bf16_t*)(ws + OFF_WIN); const bf16_t* WBR_T = (const bf16_t*)(ws + OFF_WBR); const bf16_t* WOUT_T = (const bf16_t*)(ws + OFF_WOUT);
    const bf16_t* WUP_T = (const bf16_t*)(ws + OFF_WUP); const bf16_t* WDN_T = (const bf16_t*)(ws + OFF_WDN);
    const int G = gridDim.x, bid = blockIdx.x;
    const int lo = a.ph_lo, hi = a.ph_hi;
    volatile LAS unsigned* MISC = (volatile LAS unsigned*)(lds3 + LDSCTL_OFF);
    if (threadIdx.x < 16) MISC[threadIdx.x] = 0u;
    __syncthreads();
    XcdBarrier bar; bar.bar = (unsigned*)(ws + OFF_CTL) + 4096; bar.x = 0; bar.st = nullptr;
    if (hi - lo > 1) bar = xcd_barrier_post((unsigned*)(ws + OFF_CTL) + 4096, MISC + 8);
#define SEAM(p) do { if (lo <= (p) && (p) + 1 < hi) xcd_barrier(bar); } while (0)
#define IN_PH(p) ((((PH_MASK) >> ((p) % PH_PER_LAYER + ((p) == PH_FINAL ? PH_PER_LAYER : 0))) & 1) && lo <= (p) && (p) < hi)
#pragma unroll
    for (int layer = 0; layer < NLAYER; ++layer) {
        const int pb = layer * PH_PER_LAYER;
        const float* xin = layer == 0 ? a.in[I_X] : a.out;
        if (IN_PH(pb + PH_WCONV)) phase_wconv(a, lds, layer);
        SEAM(pb + PH_WCONV);
        if (IN_PH(pb + PH_NORM1)) phase_rmsnorm_bf16(xin, a.in[I_NMG] + layer * D, XN);
        SEAM(pb + PH_NORM1);
        if (IN_PH(pb + PH_GEMM_IN)) { pg8::Gemm g{XN, WIN_T, D, D, D, 0, 0}; pg8::StaticOrder S; S.init(M, NHB, G, bid); pg8::EpiBf16<0> E{HB, NHB};
            pg8::gemm_phase<pg8::EpiBf16<0>, pg8::StaticOrder>(lds3, g, S, E); }
        SEAM(pb + PH_GEMM_IN);
        if (IN_PH(pb + PH_MIX1)) phase_mix1(a, lds, layer);
        SEAM(pb + PH_MIX1);
        if (IN_PH(pb + PH_MIX2)) gla_scan(a);
        SEAM(pb + PH_MIX2);
        if (IN_PH(pb + PH_MIX3)) phase_mix3(a, lds, layer);
        SEAM(pb + PH_MIX3);
        if (IN_PH(pb + PH_GEMM_G)) { pg8::Gemm g{XN, WIN_T + (size_t)NHB * D, D, D, D, 0, 0}; pg8::StaticOrder S; S.init(M, NGATE, G, bid); pg8::EpiBf16<1> E{Gb, NGATE};
            pg8::gemm_phase<pg8::EpiBf16<1>, pg8::StaticOrder>(lds3, g, S, E); }
        SEAM(pb + PH_GEMM_G);
        if (IN_PH(pb + PH_GEMM_M)) { pg8::Gemm g{Yb, WBR_T, 256, D, 256, 256, (size_t)D * 256}; pg8::BranchOrder S; S.init(M, D, G, bid); pg8::EpiMerge E{XN, Gb};
            pg8::gemm_phase<pg8::EpiMerge, pg8::BranchOrder>(lds3, g, S, E); }
        SEAM(pb + PH_GEMM_M);
        if (IN_PH(pb + PH_GEMM_O)) { pg8::Gemm g{XN, WOUT_T, D, D, D, 0, 0}; pg8::StaticOrder S; S.init(M, D, G, bid); pg8::EpiResF32 E{xin, a.out};
            pg8::gemm_phase<pg8::EpiResF32, pg8::StaticOrder>(lds3, g, S, E); }
        SEAM(pb + PH_GEMM_O);
        if (IN_PH(pb + PH_NORM2)) phase_rmsnorm_bf16(a.out, a.in[I_NFG] + layer * D, XN);
        SEAM(pb + PH_NORM2);
        if (IN_PH(pb + PH_GEMM_U)) { pg8::Gemm g{XN, WUP_T, D, D, D, 0, 0}; pg8::StaticOrder S; S.init(M, DFF, G, bid); pg8::EpiBf16<2> E{UP, DFF};
            pg8::gemm_phase<pg8::EpiBf16<2>, pg8::StaticOrder>(lds3, g, S, E); }
        SEAM(pb + PH_GEMM_U);
        if (IN_PH(pb + PH_GEMM_D)) { pg8::Gemm g{UP, WDN_T, DFF, DFF, DFF, 0, 0}; pg8::StaticOrder S; S.init(M, D, G, bid); pg8::EpiResF32 E{a.out, a.out};
            pg8::gemm_phase<pg8::EpiResF32, pg8::StaticOrder>(lds3, g, S, E); }
        SEAM(pb + PH_GEMM_D);
    }
    if (IN_PH(PH_FINAL)) phase_rmsnorm_f32_inplace(a.out, a.in[I_FNG]);
#undef IN_PH
#undef SEAM
}

extern "C" void kernel_launch(void* const* d_in, const int* in_sizes, int n_in, void* d_out, int out_size, void* d_ws, size_t ws_size, hipStream_t stream) {
    static int grid = 0;
    if (grid == 0) {
        if (n_in != N_INPUTS || out_size != M * D || ws_size < WS_END) { fprintf(stderr, "kernel_launch: unexpected shapes (n_in %d out %d ws %zu)\n", n_in, out_size, ws_size); grid = -1; return; }
        int dev = 0, cus = 0;
        if (hipGetDevice(&dev) != hipSuccess || hipDeviceGetAttribute(&cus, hipDeviceAttributeMultiprocessorCount, dev) != hipSuccess) { grid = -1; return; }
        if (hipFuncSetAttribute((const void*)mega_fwd, hipFuncAttributeMaxDynamicSharedMemorySize, LDS_BYTES) != hipSuccess) { fprintf(stderr, "kernel_launch: hipFuncSetAttribute failed\n"); grid = -1; return; }
        grid = cus;
    }
    if (grid < 0) return;
    Args a{};
    for (int i = 0; i < N_INPUTS; ++i) a.in[i] = (const float*)d_in[i];
    a.out = (float*)d_out; a.ws = (unsigned char*)d_ws;
#if N_LAUNCH_MODE == 0
    for (int ph = 0; ph < N_PHASES; ++ph) { a.ph_lo = ph; a.ph_hi = ph + 1; hipLaunchKernelGGL(mega_fwd, dim3(grid), dim3(NTHREADS), LDS_BYTES, stream, a); }
#else
    if (hipMemsetAsync((char*)d_ws + OFF_CTL, 0, 65536, stream) != hipSuccess) { fprintf(stderr, "kernel_launch: memset failed\n"); return; }
    a.ph_lo = 0; a.ph_hi = N_PHASES;
    hipLaunchKernelGGL(mega_fwd, dim3(grid), dim3(NTHREADS), LDS_BYTES, stream, a);
#endif
}
#endif
```

```cpp
#ifndef CPU_EMU
#include <hip/hip_runtime.h>
#include <cstdio>
#include <cstdint>
#endif
#ifndef SEQ_T
#define SEQ_T 8192
#endif
#ifndef PH_MASK
#define PH_MASK 0xffff
#endif
#ifndef REP_KIND
#define REP_KIND -1
#endif
#ifndef N_LAUNCH_MODE
#define N_LAUNCH_MODE 1
#endif

typedef unsigned short bf16_t;
typedef short bf16x8 __attribute__((ext_vector_type(8)));
typedef short s16x4 __attribute__((ext_vector_type(4)));
typedef float f32x4 __attribute__((ext_vector_type(4)));
typedef float f32x16 __attribute__((ext_vector_type(16)));
typedef unsigned u32x4 __attribute__((ext_vector_type(4)));
typedef unsigned u32x2 __attribute__((ext_vector_type(2)));
#ifdef CPU_EMU
#define DEVI static inline
#define DEVM inline
DEVI float ex2(float x) { return exp2f(x); }
DEVI float lg2(float x) { return log2f(x); }
DEVI float rcpf_(float x) { return 1.0f / x; }
DEVI float rsqf_(float x) { return 1.0f / sqrtf(x); }
DEVI f32x16 mfma32(bf16x8 a, bf16x8 b, f32x16 c) { return emu_mfma32(a, b, c); }
DEVI void wave_sync() { emu_wave->bar.wait(); }
DEVI int rfl(int x) { return x; }
#else
#define DEVI __device__ __forceinline__
#define DEVM __device__ __forceinline__
DEVI float ex2(float x) { return __builtin_amdgcn_exp2f(x); }
DEVI float lg2(float x) { return __builtin_amdgcn_logf(x); }
DEVI float rcpf_(float x) { return __builtin_amdgcn_rcpf(x); }
DEVI float rsqf_(float x) { return __builtin_amdgcn_rsqf(x); }
DEVI f32x16 mfma32(bf16x8 a, bf16x8 b, f32x16 c) { return __builtin_amdgcn_mfma_f32_32x32x16_bf16(a, b, c, 0, 0, 0); }
DEVI void wave_sync() { asm volatile("s_waitcnt lgkmcnt(0)" ::: "memory"); }
DEVI int rfl(int x) { return __builtin_amdgcn_readfirstlane(x); }
#endif
#ifdef CPU_EMU
DEVI int launder_tid() { return (int)threadIdx.x; }
#else
DEVI int launder_tid() { int t = threadIdx.x; asm volatile("" : "+v"(t)); return t; }
#endif
DEVI unsigned f2bf(float f) { unsigned u = __builtin_bit_cast(unsigned, f); return (u + 0x7fffu + ((u >> 16) & 1u)) >> 16; }
DEVI unsigned pk2(float lo, float hi) { return f2bf(lo) | (f2bf(hi) << 16); }
DEVI float bf2f(unsigned h) { return __builtin_bit_cast(float, h << 16); }
DEVI float bflo(unsigned w) { return __builtin_bit_cast(float, w << 16); }
DEVI float bfhi(unsigned w) { return __builtin_bit_cast(float, w & 0xffff0000u); }
constexpr float LOG2E = 1.4426950408889634f, LN2 = 0.6931471805599453f;
DEVI float sigmoidf_(float x) { return rcpf_(1.0f + ex2(-x * LOG2E)); }
DEVI float siluf_(float x) { return x * sigmoidf_(x); }
DEVI float logsigf_(float z) { const float a = fabsf(z); return fminf(z, 0.f) - LN2 * lg2(1.0f + ex2(-a * LOG2E)); }
DEVI float wave_sum(float v) {
#pragma unroll
    for (int o = 1; o < 64; o <<= 1) v += __shfl_xor(v, o);
    return v;
}

constexpr int BATCH = 2, SEQ = SEQ_T, M = BATCH * SEQ, D = 1024, DFF = 4096, NLAYER = 2;
constexpr int DIN_SRC = 6176;
constexpr int NHB = 2304, NGATE = 4096, NIN = NHB + NGATE;
constexpr int C_GLUA = 0, C_GLUG = 256, C_GQ = 512, C_GK = 640, C_GV = 768, C_GR = 1024, C_Z = 1280, C_AQ = 1536, C_AK = 1792, C_AV = 1920, C_PIN = 2048;
constexpr int SRC_GLR = 1280;
constexpr int NCH = SEQ / 64;
constexpr int NAB = SEQ / 128;
constexpr float EPS = 1e-6f;
constexpr int NTHREADS = 512, NWAVES = 8;
enum { I_X = 0, I_NMG, I_WIN, I_CW, I_CB, I_CLG, I_CLB, I_WUP, I_BUP, I_GNG, I_SINK, I_PW, I_PS, I_WBR, I_WOUT, I_NFG, I_WFU, I_WFD, I_FNG, N_INPUTS };
constexpr size_t al256(size_t x) { return (x + 255) & ~(size_t)255; }
constexpr size_t OFF_CTL = 0, CTL_BYTES = 1u << 20;
constexpr size_t SZ_WIN = (size_t)NIN * D * 2, SZ_WBR = (size_t)4 * D * 256 * 2, SZ_WOUT = (size_t)D * D * 2, SZ_WUP = (size_t)DFF * D * 2, SZ_WDN = (size_t)D * DFF * 2;
constexpr size_t OFF_WIN = OFF_CTL + CTL_BYTES, OFF_WBR = OFF_WIN + SZ_WIN, OFF_WOUT = OFF_WBR + SZ_WBR, OFF_WUP = OFF_WOUT + SZ_WOUT, OFF_WDN = OFF_WUP + SZ_WUP;
constexpr size_t OFF_ROPE = OFF_WDN + SZ_WDN, SZ_ROPE = al256((size_t)SEQ * 8 * 8);
constexpr size_t OFF_XN = OFF_ROPE + SZ_ROPE, SZ_ACT = al256((size_t)M * D * 2);
constexpr size_t OFF_Y = OFF_XN + SZ_ACT;
constexpr size_t OFF_BIG = OFF_Y + SZ_ACT;
constexpr size_t OFF_HB = OFF_BIG, SZ_HB = al256((size_t)M * NHB * 2);
constexpr size_t OFF_GU = OFF_HB + SZ_HB, SZ_GU = al256((size_t)BATCH * 4 * 2 * NCH * 2048 * 4);
constexpr size_t OFF_GD = OFF_GU + SZ_GU, SZ_GD = al256((size_t)BATCH * 4 * 2 * NCH * 32 * 4);
constexpr size_t OFF_G = OFF_BIG, SZ_G = al256((size_t)M * NGATE * 2);
constexpr size_t OFF_UP = OFF_BIG;
constexpr size_t WS_END = OFF_BIG + (SZ_G > SZ_HB + SZ_GU + SZ_GD ? SZ_G : SZ_HB + SZ_GU + SZ_GD);
static_assert(WS_END <= 268435456, "workspace map exceeds 256 MiB");

struct Args { const float* in[N_INPUTS]; float* out; unsigned char* ws; int ph_lo, ph_hi; };

enum { PH_WCONV = 0, PH_NORM1, PH_GEMM_IN, PH_MIX1, PH_MIX2, PH_MIX3, PH_GEMM_G, PH_GEMM_M, PH_GEMM_O, PH_NORM2, PH_GEMM_U, PH_GEMM_D, PH_PER_LAYER };
constexpr int PH_FINAL = NLAYER * PH_PER_LAYER, N_PHASES = PH_FINAL + 1;

DEVI void transpose_item(const float* W, int ldw, int K, bf16_t* WT, int k0, int src_n0, int dst_n0, float* scr, int lane) {
#pragma unroll 8
    for (int i = 0; i < 32; ++i) { const int kk = 2 * i + (lane >> 5); scr[kk * 33 + (lane & 31)] = W[(size_t)(k0 + kk) * ldw + src_n0 + (lane & 31)]; }
    wave_sync();
    const int c = lane & 7;
#pragma unroll
    for (int j = 0; j < 4; ++j) { const int n = (lane >> 3) + 8 * j; const float* s = scr + (8 * c) * 33 + n;
        u32x4 o; o.x = pk2(s[0 * 33], s[1 * 33]); o.y = pk2(s[2 * 33], s[3 * 33]); o.z = pk2(s[4 * 33], s[5 * 33]); o.w = pk2(s[6 * 33], s[7 * 33]);
        *(u32x4*)(WT + (size_t)(dst_n0 + n) * K + k0 + 8 * c) = o; }
    wave_sync();
}
DEVI void zfold_item(const float* Win, const float* wup, bf16_t* WT, int k0, int zc0  , float* scr, int lane) {
    const int s = zc0 >> 7, kc = (zc0 & 127) + (lane & 31);
    float wu[16];
#pragma unroll
    for (int r = 0; r < 16; ++r) wu[r] = wup[(s * 16 + r) * 128 + kc];
    for (int i = 0; i < 32; ++i) { const int kk = 2 * i + (lane >> 5); const float* g = Win + (size_t)(k0 + kk) * DIN_SRC + SRC_GLR + s * 16; float a = 0.f;
#pragma unroll
        for (int r = 0; r < 16; ++r) a += g[r] * wu[r];
        scr[kk * 33 + (lane & 31)] = a; }
    wave_sync();
    const int c = lane & 7;
#pragma unroll
    for (int j = 0; j < 4; ++j) { const int n = (lane >> 3) + 8 * j; const float* sp = scr + (8 * c) * 33 + n;
        u32x4 o; o.x = pk2(sp[0 * 33], sp[1 * 33]); o.y = pk2(sp[2 * 33], sp[3 * 33]); o.z = pk2(sp[4 * 33], sp[5 * 33]); o.w = pk2(sp[6 * 33], sp[7 * 33]);
        *(u32x4*)(WT + (size_t)(C_Z + zc0 + n) * D + k0 + 8 * c) = o; }
    wave_sync();
}
DEVI void rope_entry(int pos, int i, float& c, float& s) {
    const double inv[8] = {1.0, 0.19392274474868576, 0.03760603093086393, 0.007292664737217109, 0.001414213562373095, 0.0002742481756762073, 5.318295896944988e-05, 1.031338537721246e-05};
    double iv = inv[0];
#pragma unroll
    for (int k = 1; k < 8; ++k) iv = (i == k) ? inv[k] : iv;
    double rev = (double)pos * iv * 0.15915494309189535; rev -= __builtin_rint(rev);
    double q4 = rev * 4.0; const double qn = __builtin_rint(q4); const double t = (q4 - qn) * 1.5707963267948966;
    const double t2 = t * t;
    double sp = t * (1.0 + t2 * (-1.0 / 6 + t2 * (1.0 / 120 + t2 * (-1.0 / 5040 + t2 * (1.0 / 362880 + t2 * (-1.0 / 39916800 + t2 * (1.0 / 6227020800.0)))))));
    double cp = 1.0 + t2 * (-0.5 + t2 * (1.0 / 24 + t2 * (-1.0 / 720 + t2 * (1.0 / 40320 + t2 * (-1.0 / 3628800 + t2 * (1.0 / 479001600.0))))));
    const int qi = ((int)qn) & 3;
    const double cs = (qi == 0) ? cp : (qi == 1) ? -sp : (qi == 2) ? -cp : sp;
    const double sn = (qi == 0) ? sp : (qi == 1) ? cp : (qi == 2) ? -sp : -cp;
    c = (float)cs; s = (float)sn;
}
DEVI void phase_wconv(const Args& a, unsigned char* lds, int layer) {
    const int tid = launder_tid(), lane = tid & 63, wave = rfl(tid >> 6);
    float* scr = (float*)(lds + wave * 8448);
    const int gw = blockIdx.x * NWAVES + wave, NGW = gridDim.x * NWAVES;
    const float* Win = a.in[I_WIN] + (size_t)layer * D * DIN_SRC; const float* wup = a.in[I_WUP] + (size_t)layer * 2 * 16 * 128;
    const float* Wbr = a.in[I_WBR] + (size_t)layer * 4 * 256 * D; const float* Wout = a.in[I_WOUT] + (size_t)layer * D * D;
    const float* Wfu = a.in[I_WFU] + (size_t)layer * D * DFF; const float* Wfd = a.in[I_WFD] + (size_t)layer * DFF * D;
    bf16_t* WIN_T = (bf16_t*)(a.ws + OFF_WIN); bf16_t* WBR_T = (bf16_t*)(a.ws + OFF_WBR); bf16_t* WOUT_T = (bf16_t*)(a.ws + OFF_WOUT);
    bf16_t* WUP_T = (bf16_t*)(a.ws + OFF_WUP); bf16_t* WDN_T = (bf16_t*)(a.ws + OFF_WDN);
    constexpr int I_IN = (D / 64) * (NIN / 32), I_BR = 4 * (256 / 64) * (D / 32), I_OUT = (D / 64) * (D / 32), I_UP = (D / 64) * (DFF / 32), I_DN = (DFF / 64) * (D / 32);
    constexpr int NITEMS = I_IN + I_BR + I_OUT + I_UP + I_DN;
    for (int it = gw; it < NITEMS; it += NGW) {
        int r = it;
        if (r < I_IN) { const int nblk = NIN / 32, kb = r / nblk, nb = r % nblk, n0 = nb * 32;
            if (n0 >= C_Z && n0 < C_AQ) zfold_item(Win, wup, WIN_T, kb * 64, n0 - C_Z, scr, lane);
            else transpose_item(Win, DIN_SRC, D, WIN_T, kb * 64, n0 < C_Z ? n0 : n0 - 224, n0, scr, lane);
            continue; } r -= I_IN;
        if (r < I_BR) { const int br = r / (I_BR / 4), q = r % (I_BR / 4), nblk = D / 32, kb = q / nblk, nb = q % nblk;
            transpose_item(Wbr + (size_t)br * 256 * D, D, 256, WBR_T + (size_t)br * D * 256, kb * 64, nb * 32, nb * 32, scr, lane); continue; } r -= I_BR;
        if (r < I_OUT) { const int nblk = D / 32, kb = r / nblk, nb = r % nblk; transpose_item(Wout, D, D, WOUT_T, kb * 64, nb * 32, nb * 32, scr, lane); continue; } r -= I_OUT;
        if (r < I_UP) { const int nblk = DFF / 32, kb = r / nblk, nb = r % nblk; transpose_item(Wfu, DFF, D, WUP_T, kb * 64, nb * 32, nb * 32, scr, lane); continue; } r -= I_UP;
        { const int nblk = D / 32, kb = r / nblk, nb = r % nblk; transpose_item(Wfd, D, DFF, WDN_T, kb * 64, nb * 32, nb * 32, scr, lane); }
    }
    if (layer == 0) { float* rope = (float*)(a.ws + OFF_ROPE);
        for (int e = blockIdx.x * NTHREADS + tid; e < SEQ * 8; e += gridDim.x * NTHREADS) { float c, s; rope_entry(e >> 3, e & 7, c, s); rope[2 * e] = c; rope[2 * e + 1] = s; } }
}

DEVI void phase_rmsnorm_bf16(const float* x, const float* g, bf16_t* out) {
    const int tid = launder_tid(), lane = tid & 63, wave = rfl(tid >> 6);
    const int gw = blockIdx.x * NWAVES + wave, NGW = gridDim.x * NWAVES;
    f32x4 gv[4];
#pragma unroll
    for (int j = 0; j < 4; ++j) gv[j] = *(const f32x4*)(g + 4 * lane + 256 * j);
    for (int m = gw; m < M; m += NGW) {
        const f32x4* xr = (const f32x4*)(x + (size_t)m * D) + lane; f32x4 v[4]; float s = 0.f;
#pragma unroll
        for (int j = 0; j < 4; ++j) { v[j] = xr[64 * j]; s += (v[j].x * v[j].x + v[j].y * v[j].y) + (v[j].z * v[j].z + v[j].w * v[j].w); }
        const float rstd = rsqf_(wave_sum(s) * (1.f / D) + EPS);
        u32x2* o8 = (u32x2*)(out + (size_t)m * D) + lane;
#pragma unroll
        for (int j = 0; j < 4; ++j) { u32x2 w; w.x = pk2(v[j].x * rstd * gv[j].x, v[j].y * rstd * gv[j].y); w.y = pk2(v[j].z * rstd * gv[j].z, v[j].w * rstd * gv[j].w); o8[64 * j] = w; }
    }
}
DEVI void phase_rmsnorm_f32_inplace(float* x, const float* g) {
    const int tid = launder_tid(), lane = tid & 63, wave = rfl(tid >> 6);
    const int gw = blockIdx.x * NWAVES + wave, NGW = gridDim.x * NWAVES;
    f32x4 gv[4];
#pragma unroll
    for (int j = 0; j < 4; ++j) gv[j] = *(const f32x4*)(g + 4 * lane + 256 * j);
    for (int m = gw; m < M; m += NGW) {
        f32x4* xr = (f32x4*)(x + (size_t)m * D) + lane; f32x4 v[4]; float s = 0.f;
#pragma unroll
        for (int j = 0; j < 4; ++j) { v[j] = xr[64 * j]; s += (v[j].x * v[j].x + v[j].y * v[j].y) + (v[j].z * v[j].z + v[j].w * v[j].w); }
        const float rstd = rsqf_(wave_sum(s) * (1.f / D) + EPS);
#pragma unroll
        for (int j = 0; j < 4; ++j) xr[64 * j] = v[j] * rstd * gv[j];
    }
}

DEVI void conv_item(const Args& a, unsigned char* lds, int layer, int item) {
    const int tid = launder_tid(), lane = tid & 63, wave = rfl(tid >> 6), c = tid & 255, hf = tid >> 8;
    const int b = item / (SEQ / 32), t0 = (item % (SEQ / 32)) * 32;
    const bf16_t* HB = (const bf16_t*)(a.ws + OFF_HB); bf16_t* Y = (bf16_t*)(a.ws + OFF_Y);
    float* u = (float*)lds; float* y = u + 62 * 256;
    for (int r = hf; r < 62; r += 2) { const int t = t0 - 15 + r; float v = 0.f;
        if (t >= 0 && t < SEQ) { const bf16_t* hp = HB + (size_t)(b * SEQ + t) * NHB; v = bf2f(hp[C_GLUA + c]) * sigmoidf_(bf2f(hp[C_GLUG + c])); }
        u[r * 256 + c] = v; }
    float w[31];
    const float* cw = a.in[I_CW] + (size_t)layer * 31 * 256;
#pragma unroll
    for (int k = 0; k < 31; ++k) w[k] = cw[k * 256 + c];
    const float bias = a.in[I_CB][layer * 256 + c];
    __syncthreads();
    for (int i = 0; i < 16; ++i) { const int tt = hf * 16 + i; float acc = bias;
#pragma unroll
        for (int k = 0; k < 31; ++k) acc += u[(tt + k) * 256 + c] * w[k];
        y[tt * 256 + c] = acc; }
    __syncthreads();
    const f32x4 lg = *(const f32x4*)(a.in[I_CLG] + layer * 256 + 4 * lane), lb = *(const f32x4*)(a.in[I_CLB] + layer * 256 + 4 * lane);
#pragma unroll
    for (int i = 0; i < 4; ++i) { const int tt = wave * 4 + i; f32x4 v = *(const f32x4*)(y + tt * 256 + 4 * lane);
        const float mu = wave_sum((v.x + v.y) + (v.z + v.w)) * (1.f / 256); v = v - mu;
        const float var = wave_sum((v.x * v.x + v.y * v.y) + (v.z * v.z + v.w * v.w)) * (1.f / 256); const float rstd = rsqf_(var + EPS);
        v = v * rstd * lg + lb;
        u32x2 o; o.x = pk2(siluf_(v.x), siluf_(v.y)); o.y = pk2(siluf_(v.z), siluf_(v.w));
        *(u32x2*)(Y + (size_t)(b * SEQ + t0 + tt) * D + 0 + 4 * lane) = o; }
    __syncthreads();
}
DEVI void pool_item(const Args& a, unsigned char* lds, int layer, int item) {
    const int tid = launder_tid(), c = tid & 255, hf = tid >> 8;
    const int b = item / (SEQ / 32), t0 = (item % (SEQ / 32)) * 32;
    const bf16_t* HB = (const bf16_t*)(a.ws + OFF_HB); bf16_t* Y = (bf16_t*)(a.ws + OFF_Y);
    float* u = (float*)lds; float* d = u + 48 * 256;
    for (int r = hf; r < 48; r += 2) { const int t = t0 - 8 + r; float v = 0.f;
        if (t >= 0 && t < SEQ) v = bf2f(HB[(size_t)(b * SEQ + t) * NHB + C_PIN + c]);
        u[r * 256 + c] = v; }
    const int e = tid & 63, g = (tid >> 6) & 3;
    const float* pwp = a.in[I_PW] + ((size_t)layer * 4 + g) * 64 * 64 + e;
    const float psc = a.in[I_PS][layer * 256 + g * 64 + e];
    __syncthreads();
    { const int gg = c >> 6, hw = 1 << gg;
      for (int i = 0; i < 16; ++i) { const int tt = hf * 16 + i, t = t0 + tt; const int lo = (t - hw) < 0 ? 0 : (t - hw), hi = (t + hw) > SEQ ? SEQ : (t + hw);
          float s = 0.f; for (int p = lo; p < hi; ++p) s += u[(p - t0 + 8) * 256 + c];
          d[tt * 256 + c] = s / (float)(hi - lo) - u[(tt + 8) * 256 + c]; } }
    __syncthreads();
    { float acc[16];
#pragma unroll
      for (int i = 0; i < 16; ++i) acc[i] = 0.f;
      const float* dp = d + hf * 16 * 256 + g * 64;
#pragma unroll 4
      for (int cc = 0; cc < 64; ++cc) { const float wv = pwp[cc * 64];
#pragma unroll
          for (int i = 0; i < 16; ++i) acc[i] += dp[i * 256 + cc] * wv; }
#pragma unroll
      for (int i = 0; i < 16; ++i) Y[(size_t)(b * SEQ + t0 + hf * 16 + i) * D + 768 + g * 64 + e] = (bf16_t)f2bf(acc[i] * psc); }
    __syncthreads();
}
DEVI int crow(int r, int hi) { return (r & 3) + 8 * (r >> 2) + 4 * hi; }
constexpr int KS_LD = 72, VT_LD = 388;
DEVI void attn_item(const Args& a, unsigned char* lds, int layer, int item) {
    const int tid = launder_tid(), lane = tid & 63, wave = rfl(tid >> 6);
    const int b = item / (2 * NAB), kv = (item / NAB) & 1, n = item % NAB;
    const bf16_t* HB = (const bf16_t*)(a.ws + OFF_HB); bf16_t* Y = (bf16_t*)(a.ws + OFF_Y); const float* rope = (const float*)(a.ws + OFF_ROPE);
    bf16_t* Ks = (bf16_t*)lds; bf16_t* Vt = Ks + 384 * KS_LD;
    const int kbase = n * 128 - 128;
    for (int e = tid; e < 384 * 8; e += NTHREADS) { const int wr = e >> 3, c8 = e & 7, kpos = kbase + wr;
        u32x4 kw = (u32x4){0u, 0u, 0u, 0u}, vw = (u32x4){0u, 0u, 0u, 0u};
        if (kpos >= 0 && kpos < SEQ) { const bf16_t* hp = HB + (size_t)(b * SEQ + kpos) * NHB;
            kw = *(const u32x4*)(hp + C_AK + kv * 64 + c8 * 8); vw = *(const u32x4*)(hp + C_AV + kv * 64 + c8 * 8);
            if (c8 < 2) { const u32x4 pw = *(const u32x4*)(hp + C_AK + kv * 64 + (c8 ^ 1) * 8); const float sg = c8 ? 1.f : -1.f; const float* rp = rope + (size_t)kpos * 16;
                float o[8];
#pragma unroll
                for (int j = 0; j < 4; ++j) { const float m0 = bflo(kw[j]), m1 = bfhi(kw[j]), p0 = bflo(pw[j]), p1 = bfhi(pw[j]);
                    o[2 * j] = m0 * rp[4 * j] + sg * p0 * rp[4 * j + 1]; o[2 * j + 1] = m1 * rp[4 * j + 2] + sg * p1 * rp[4 * j + 3]; }
                kw = (u32x4){pk2(o[0], o[1]), pk2(o[2], o[3]), pk2(o[4], o[5]), pk2(o[6], o[7])}; } }
        *(u32x4*)(Ks + wr * KS_LD + c8 * 8) = kw;
#pragma unroll
        for (int j = 0; j < 4; ++j) { Vt[(c8 * 8 + 2 * j) * VT_LD + wr] = (bf16_t)(vw[j] & 0xffffu); Vt[(c8 * 8 + 2 * j + 1) * VT_LD + wr] = (bf16_t)(vw[j] >> 16); } }
    const int g = wave >> 2, hq = kv * 2 + g, q0l = (wave & 3) * 32, ql = lane & 31, hi = lane >> 5, qpos = n * 128 + q0l + ql;
    bf16x8 qf[4];
    { const bf16_t* qp = HB + (size_t)(b * SEQ + qpos) * NHB + C_AQ + hq * 64 + hi * 8; const float* rp = rope + (size_t)qpos * 16; const float sg = hi ? 1.f : -1.f;
#pragma unroll
      for (int ds = 0; ds < 4; ++ds) { const u32x4 w = *(const u32x4*)(qp + ds * 16); float v[8];
#pragma unroll
          for (int j = 0; j < 4; ++j) { v[2 * j] = bflo(w[j]); v[2 * j + 1] = bfhi(w[j]); }
          if (ds == 0) {
#pragma unroll
              for (int j = 0; j < 8; ++j) { const float p = __shfl_xor(v[j], 32); v[j] = v[j] * rp[2 * j] + sg * p * rp[2 * j + 1]; } }
          u32x4 o = (u32x4){pk2(v[0] * 0.125f, v[1] * 0.125f), pk2(v[2] * 0.125f, v[3] * 0.125f), pk2(v[4] * 0.125f, v[5] * 0.125f), pk2(v[6] * 0.125f, v[7] * 0.125f)};
          qf[ds] = __builtin_bit_cast(bf16x8, o); } }
    __syncthreads();
    float m2 = a.in[I_SINK][layer * 4 + hq] * LOG2E, l_own = hi ? 0.f : 1.f;
    f32x16 o0 = {}, o1 = {};
    for (int kt = 0; kt < 9; ++kt) {
        const int wb = q0l + 32 * kt, kpos0 = kbase + wb;
        if (kpos0 < 0 || kpos0 >= SEQ) continue;
        f32x16 s = {};
#pragma unroll
        for (int ds = 0; ds < 4; ++ds) { const bf16x8 kf = *(const bf16x8*)(Ks + (wb + ql) * KS_LD + ds * 16 + hi * 8); s = mfma32(kf, qf[ds], s); }
        float mt = -INFINITY;
#pragma unroll
        for (int r = 0; r < 16; ++r) { const int kin = crow(r, hi); float v = s[r] * LOG2E;
            if (kt == 0 && kin < ql) v = -INFINITY;
            if (kt == 8 && kin > ql) v = -INFINITY;
            s[r] = v; mt = fmaxf(mt, v); }
        mt = fmaxf(mt, __shfl_xor(mt, 32));
        const float mn = fmaxf(m2, mt), alpha = ex2(m2 - mn); m2 = mn;
        float ps = 0.f;
#pragma unroll
        for (int r = 0; r < 16; ++r) { s[r] = ex2(s[r] - mn); ps += s[r]; }
        l_own = l_own * alpha + ps;
#pragma unroll
        for (int r = 0; r < 16; ++r) { o0[r] *= alpha; o1[r] *= alpha; }
        bf16x8 pb[2];
#pragma unroll
        for (int sI = 0; sI < 2; ++sI) { u32x4 w = (u32x4){pk2(s[8 * sI + 0], s[8 * sI + 1]), pk2(s[8 * sI + 2], s[8 * sI + 3]), pk2(s[8 * sI + 4], s[8 * sI + 5]), pk2(s[8 * sI + 6], s[8 * sI + 7])}; pb[sI] = __builtin_bit_cast(bf16x8, w); }
#pragma unroll
        for (int sI = 0; sI < 2; ++sI) {
            const bf16_t* v0 = Vt + (size_t)ql * VT_LD + wb + 16 * sI + 4 * hi;
            const s16x4 a0 = *(const s16x4*)(v0), a1 = *(const s16x4*)(v0 + 8), c0 = *(const s16x4*)(v0 + 32 * VT_LD), c1 = *(const s16x4*)(v0 + 32 * VT_LD + 8);
            o0 = mfma32((bf16x8){a0[0], a0[1], a0[2], a0[3], a1[0], a1[1], a1[2], a1[3]}, pb[sI], o0);
            o1 = mfma32((bf16x8){c0[0], c0[1], c0[2], c0[3], c1[0], c1[1], c1[2], c1[3]}, pb[sI], o1); }
    }
    const float linv = 1.0f / (l_own + __shfl_xor(l_own, 32));
    bf16_t* yp = Y + (size_t)(b * SEQ + qpos) * D + 512 + hq * 64 + 4 * hi;
#pragma unroll
    for (int g4 = 0; g4 < 4; ++g4) {
        u32x2 w0, w1; w0.x = pk2(o0[4 * g4] * linv, o0[4 * g4 + 1] * linv); w0.y = pk2(o0[4 * g4 + 2] * linv, o0[4 * g4 + 3] * linv);
        w1.x = pk2(o1[4 * g4] * linv, o1[4 * g4 + 1] * linv); w1.y = pk2(o1[4 * g4 + 2] * linv, o1[4 * g4 + 3] * linv);
        *(u32x2*)(yp + 8 * g4) = w0; *(u32x2*)(yp + 32 + 8 * g4) = w1; }
    __syncthreads();
}
DEVI void gla_prep(const Args& a, int layer, const bf16_t* hrow0, int h, int t, bool act, float* tot4  , float (&bcum)[16], float& total) {
    const int d = t & 31, dir = (t >> 5) & 1, seg = t >> 6;
    const float bu = a.in[I_BUP][(size_t)layer * 256 + dir * 128 + h * 32 + d];
    float lg[16];
    const bf16_t* zp = hrow0 + (size_t)(seg * 16) * NHB + C_Z + dir * 128 + h * 32 + d;
#pragma unroll
    for (int jj = 0; jj < 16; ++jj) lg[jj] = act ? logsigf_(bf2f(zp[(size_t)jj * NHB]) + bu) * (1.f / 16.f) : 0.f;
    float acc = 0.f;
    if (dir == 0) {
#pragma unroll
        for (int jj = 0; jj < 16; ++jj) { acc += lg[jj]; bcum[jj] = acc; } }
    else {
#pragma unroll
        for (int jj = 15; jj >= 0; --jj) { acc += lg[jj]; bcum[jj] = acc; } }
    tot4[seg * 64 + dir * 32 + d] = acc;
    __syncthreads();
    const float t0 = tot4[dir * 32 + d], t1 = tot4[64 + dir * 32 + d], t2 = tot4[128 + dir * 32 + d], t3 = tot4[192 + dir * 32 + d];
    total = (t0 + t1) + (t2 + t3);
    float off;
    if (dir == 0) off = (seg > 0 ? t0 : 0.f) + (seg > 1 ? t1 : 0.f) + (seg > 2 ? t2 : 0.f);
    else off = (seg < 3 ? t3 : 0.f) + (seg < 2 ? t2 : 0.f) + (seg < 1 ? t1 : 0.f);
#pragma unroll
    for (int jj = 0; jj < 16; ++jj) bcum[jj] += off;
}
constexpr int GVT_LD = 72, GQ_LD = 40;
DEVI void gla_stage_vt(const bf16_t* hrow0, int h, int t, bool act, bf16_t* Vt) {
    for (int e8 = t; e8 < 512; e8 += 256) { const int j = e8 >> 3, c8 = e8 & 7;
        u32x4 vw = (u32x4){0u, 0u, 0u, 0u}; if (act) vw = *(const u32x4*)(hrow0 + (size_t)j * NHB + C_GV + h * 64 + c8 * 8);
#pragma unroll
        for (int q = 0; q < 4; ++q) { Vt[(c8 * 8 + 2 * q) * GVT_LD + j] = (bf16_t)(vw[q] & 0xffffu); Vt[(c8 * 8 + 2 * q + 1) * GVT_LD + j] = (bf16_t)(vw[q] >> 16); } }
}
constexpr int GX_HALF = 9216 + 9216 + 1024;
DEVI void gla_x_pair(const Args& a, unsigned char* lds, int layer, int pair) {
    const int tid = launder_tid(), lane = tid & 63, wave = rfl(tid >> 6), hf = wave >> 2, t = tid & 255, w4 = wave & 3;
    constexpr int N_GX = BATCH * NCH * 4;
    const int item = pair * 2 + hf; const bool act = item < N_GX; const int it_ = act ? item : 0;
    const int h = it_ & 3, c = (it_ >> 2) % NCH, b = it_ / (4 * NCH);
    const bf16_t* hrow0 = (const bf16_t*)(a.ws + OFF_HB) + (size_t)(b * SEQ + c * 64) * NHB;
    unsigned char* base = lds + hf * GX_HALF;
    bf16_t* Kht = (bf16_t*)base; bf16_t* Vt = (bf16_t*)(base + 9216); float* tot4 = (float*)(base + 18432);
    float bc[16], total;
    gla_stage_vt(hrow0, h, t, act, Vt);
    gla_prep(a, layer, hrow0, h, t, act, tot4, bc, total);
    { const int d = t & 31, dir = (t >> 5) & 1, seg = t >> 6;
      const bf16_t* kp = hrow0 + (size_t)(seg * 16) * NHB + C_GK + h * 32 + d; unsigned w[8];
#pragma unroll
      for (int q = 0; q < 8; ++q) { const float k0 = act ? bf2f(kp[(size_t)(2 * q) * NHB]) : 0.f, k1 = act ? bf2f(kp[(size_t)(2 * q + 1) * NHB]) : 0.f;
          w[q] = pk2(k0 * ex2((total - bc[2 * q]) * LOG2E), k1 * ex2((total - bc[2 * q + 1]) * LOG2E)); }
      u32x4* dst = (u32x4*)(Kht + (dir * 32 + d) * GVT_LD + seg * 16); dst[0] = (u32x4){w[0], w[1], w[2], w[3]}; dst[1] = (u32x4){w[4], w[5], w[6], w[7]};
      if (seg == 0 && act) ((float*)(a.ws + OFF_GD))[((size_t)((b * 4 + h) * 2 + dir) * NCH + c) * 32 + d] = ex2(total * LOG2E); }
    __syncthreads();
    { const int et = w4 & 1, dir = w4 >> 1, r32 = lane & 31, hi = lane >> 5; f32x16 u = {};
#pragma unroll
      for (int ks = 0; ks < 4; ++ks) { const bf16x8 af = *(const bf16x8*)(Vt + (et * 32 + r32) * GVT_LD + ks * 16 + hi * 8), bfr = *(const bf16x8*)(Kht + (dir * 32 + r32) * GVT_LD + ks * 16 + hi * 8); u = mfma32(af, bfr, u); }
      if (act) { float* gu = (float*)(a.ws + OFF_GU) + ((size_t)((b * 4 + h) * 2 + dir) * NCH + c) * 2048;
#pragma unroll
          for (int r = 0; r < 16; ++r) gu[(et * 32 + crow(r, hi)) * 32 + r32] = u[r]; } }
    __syncthreads();
}
DEVI void gla_scan(const Args& a) {
    float* GU = (float*)(a.ws + OFF_GU); const float* GD = (const float*)(a.ws + OFF_GD);
    constexpr int TOTAL = BATCH * 4 * 2 * 2048, UNR = (NCH % 16 == 0) ? 16 : 4;
    const int tid = launder_tid(); if (tid >= 128) return;
    for (int eid = blockIdx.x * 128 + tid; eid < TOTAL; eid += gridDim.x * 128) {
        const int seq = eid >> 11, de = eid & 2047, d = de & 31, dir = seq & 1; float S = 0.f;
        for (int s0 = 0; s0 < NCH; s0 += UNR) { float u[UNR], dc[UNR];
#pragma unroll
            for (int k = 0; k < UNR; ++k) { const int c = dir ? NCH - 1 - (s0 + k) : s0 + k; u[k] = GU[((size_t)seq * NCH + c) * 2048 + de]; dc[k] = GD[((size_t)seq * NCH + c) * 32 + d]; }
#pragma unroll
            for (int k = 0; k < UNR; ++k) { const int c = dir ? NCH - 1 - (s0 + k) : s0 + k; GU[((size_t)seq * NCH + c) * 2048 + de] = S; S = dc[k] * S + u[k]; } }
    }
}
constexpr int GZ_HALF = 10240 + 10240 + 9216 + 10240 + 1024 + 512;
DEVI void gla_z_pair(const Args& a, unsigned char* lds, int layer, int pair) {
    const int tid = launder_tid(), lane = tid & 63, wave = rfl(tid >> 6), hf = wave >> 2, t = tid & 255, w4 = wave & 3;
    constexpr int N_GZ = BATCH * NCH * 4;
    const int item = pair * 2 + hf; const bool act = item < N_GZ; const int it_ = act ? item : 0;
    const int h = it_ & 3, c = (it_ >> 2) % NCH, b = it_ / (4 * NCH);
    const bf16_t* hrow0 = (const bf16_t*)(a.ws + OFF_HB) + (size_t)(b * SEQ + c * 64) * NHB;
    unsigned char* base = lds + hf * GZ_HALF;
    bf16_t* Qs = (bf16_t*)base; bf16_t* Ks = (bf16_t*)(base + 10240); bf16_t* Vt = (bf16_t*)(base + 20480); bf16_t* St = (bf16_t*)(base + 29696);
    float* tot4 = (float*)(base + 39936); float* rsum = (float*)(base + 40960);
    float bc[16], total;
    gla_stage_vt(hrow0, h, t, act, Vt);
    { const float* GU = (const float*)(a.ws + OFF_GU);
      for (int e4 = t; e4 < 1024; e4 += 256) { const int dir = e4 >> 9, ed = (e4 & 511) * 4, e = ed >> 5, d0 = ed & 31;
          f32x4 s = {}; if (act) s = *(const f32x4*)(GU + ((size_t)((b * 4 + h) * 2 + dir) * NCH + c) * 2048 + ed);
          u32x2 w; w.x = pk2(s[0], s[1]); w.y = pk2(s[2], s[3]); *(u32x2*)(St + (dir * 64 + e) * GQ_LD + d0) = w; } }
    gla_prep(a, layer, hrow0, h, t, act, tot4, bc, total);
    { const int d = t & 31, dir = (t >> 5) & 1, seg = t >> 6;
      const bf16_t* qp = hrow0 + (size_t)(seg * 16) * NHB + C_GQ + h * 32 + d; const bf16_t* kp = qp + (C_GK - C_GQ);
#pragma unroll
      for (int jj = 0; jj < 16; ++jj) { const float q = act ? bf2f(qp[(size_t)jj * NHB]) * 0.17677669529663687f : 0.f, k = act ? bf2f(kp[(size_t)jj * NHB]) : 0.f; const float bb = bc[jj] * LOG2E;
          Qs[(dir * 64 + seg * 16 + jj) * GQ_LD + d] = (bf16_t)f2bf(q * ex2(bb)); Ks[(dir * 64 + seg * 16 + jj) * GQ_LD + d] = (bf16_t)f2bf(k * ex2(-bb)); } }
    __syncthreads();
    const int itl = w4 & 1, et = w4 >> 1, r32 = lane & 31, hi = lane >> 5;
    bf16x8 qf[2][2];
#pragma unroll
    for (int dir = 0; dir < 2; ++dir)
#pragma unroll
        for (int ks = 0; ks < 2; ++ks) qf[dir][ks] = *(const bf16x8*)(Qs + (dir * 64 + itl * 32 + r32) * GQ_LD + ks * 16 + hi * 8);
    f32x16 o = {};
#pragma unroll
    for (int jt = 0; jt < 2; ++jt) {
        f32x16 xa = {};
        if (jt == itl) { f32x16 xf = {}, xb = {};
#pragma unroll
            for (int ks = 0; ks < 2; ++ks) { xf = mfma32(*(const bf16x8*)(Ks + (jt * 32 + r32) * GQ_LD + ks * 16 + hi * 8), qf[0][ks], xf);
                                             xb = mfma32(*(const bf16x8*)(Ks + (64 + jt * 32 + r32) * GQ_LD + ks * 16 + hi * 8), qf[1][ks], xb); }
#pragma unroll
            for (int r = 0; r < 16; ++r) { const int jl = crow(r, hi); xa[r] = (jl <= r32 ? xf[r] : 0.f) + (jl >= r32 ? xb[r] : 0.f); } }
        else { const int dir = jt < itl ? 0 : 1;
#pragma unroll
            for (int ks = 0; ks < 2; ++ks) xa = mfma32(*(const bf16x8*)(Ks + (dir * 64 + jt * 32 + r32) * GQ_LD + ks * 16 + hi * 8), qf[dir][ks], xa); }
#pragma unroll
        for (int s = 0; s < 2; ++s) { const u32x4 w = (u32x4){pk2(xa[8 * s + 0], xa[8 * s + 1]), pk2(xa[8 * s + 2], xa[8 * s + 3]), pk2(xa[8 * s + 4], xa[8 * s + 5]), pk2(xa[8 * s + 6], xa[8 * s + 7])};
            const bf16_t* vp = Vt + (et * 32 + r32) * GVT_LD + jt * 32 + 16 * s + 4 * hi; const s16x4 a0 = *(const s16x4*)vp, a1 = *(const s16x4*)(vp + 8);
            o = mfma32((bf16x8){a0[0], a0[1], a0[2], a0[3], a1[0], a1[1], a1[2], a1[3]}, __builtin_bit_cast(bf16x8, w), o); } }
#pragma unroll
    for (int dir = 0; dir < 2; ++dir)
#pragma unroll
        for (int ks = 0; ks < 2; ++ks) o = mfma32(*(const bf16x8*)(St + (dir * 64 + et * 32 + r32) * GQ_LD + ks * 16 + hi * 8), qf[dir][ks], o);
    float ss = 0.f;
#pragma unroll
    for (int r = 0; r < 16; ++r) ss += o[r] * o[r];
    ss += __shfl_xor(ss, 32);
    if (hi == 0) rsum[et * 64 + itl * 32 + r32] = ss;
    __syncthreads();
    if (act) { const int il = itl * 32 + r32; const float rstd = rsqf_((rsum[il] + rsum[64 + il]) * (1.f / 64.f) + EPS);
        const bf16_t* grp = hrow0 + (size_t)il * NHB + C_GR + h * 64 + et * 32 + 4 * hi; const float* ngp = a.in[I_GNG] + layer * 256 + h * 64 + et * 32 + 4 * hi;
        bf16_t* yp = (bf16_t*)(a.ws + OFF_Y) + (size_t)(b * SEQ + c * 64 + il) * D + 256 + h * 64 + et * 32 + 4 * hi;
#pragma unroll
        for (int g4 = 0; g4 < 4; ++g4) { const u32x2 gw = *(const u32x2*)(grp + 8 * g4); const f32x4 ng = *(const f32x4*)(ngp + 8 * g4);
            u32x2 w; w.x = pk2(o[4 * g4] * rstd * ng[0] * siluf_(bflo(gw.x)), o[4 * g4 + 1] * rstd * ng[1] * siluf_(bfhi(gw.x)));
            w.y = pk2(o[4 * g4 + 2] * rstd * ng[2] * siluf_(bflo(gw.y)), o[4 * g4 + 3] * rstd * ng[3] * siluf_(bfhi(gw.y)));
            *(u32x2*)(yp + 8 * g4) = w; } }
    __syncthreads();
}
DEVI void phase_mix1(const Args& a, unsigned char* lds, int layer) {
    constexpr int N_ATT = BATCH * 2 * NAB, N_CONV = BATCH * (SEQ / 32), N_POOL = N_CONV, N_GXP = BATCH * NCH * 4 / 2, N_ALL = N_ATT + N_CONV + N_POOL + N_GXP;
    for (int it = blockIdx.x; it < N_ALL; it += gridDim.x) { int r = it;
        if (r < N_ATT) { attn_item(a, lds, layer, r); continue; } r -= N_ATT;
        if (r < N_CONV) { conv_item(a, lds, layer, r); continue; } r -= N_CONV;
        if (r < N_POOL) { pool_item(a, lds, layer, r); continue; } r -= N_POOL;
        gla_x_pair(a, lds, layer, r); }
}
DEVI void phase_mix3(const Args& a, unsigned char* lds, int layer) {
    constexpr int N_GZP = BATCH * NCH * 4 / 2;
    for (int it = blockIdx.x; it < N_GZP; it += gridDim.x) gla_z_pair(a, lds, layer, it);
}

namespace pg8 {
constexpr int BM = 256, BK = 64, HALF = 128, HTB = HALF * BK * 2, STAGE_BYTES = 8 * HTB, NXCD = 8, WGM = 8;
DEVI int lds_byte(int r, int c) { const int st = (r >> 4) * 2 + (c >> 5), rr = r & 15, cc = c & 31, ob = rr * 64 + cc * 2; return st * 1024 + (ob ^ (((ob >> 9) & 1) << 5)); }
DEVI void stage_rc(int b, int& R, int& C) { const int st = b / 1024, sb = b % 1024, swz = sb ^ (((sb >> 9) & 1) << 5); R = (st >> 1) * 16 + swz / 64; C = (st & 1) * 32 + (swz % 64) / 2; }
DEVI int perm32(int rho) { const int n = rho >> 4, i = rho & 15; return 8 * (i >> 2) + 4 * n + (i & 3); }
struct Unit { int pm, pn, br; };
struct Gemm { const bf16_t* A; const bf16_t* Bt; int K, lda, ldb; size_t a_br, b_br; };
struct StaticOrder {
    int nM, nN, nwg, G, c;
    DEVM void init(int Mr, int N, int G_, int c_) { nM = Mr / BM; nN = N / BM; nwg = nM * nN; G = G_; c = c_; }
    DEVM bool tile(long L, Unit& u) const {
        if (L >= nwg) return false;
        int wgid = (int)L; { const int q = nwg / NXCD, r = nwg % NXCD, xcd = wgid % NXCD, off = wgid / NXCD; wgid = (xcd < r ? xcd * (q + 1) : r * (q + 1) + (xcd - r) * q) + off; }
        const int nig = WGM * nN, gid = wgid / nig, fm = gid * WGM, gsz = (nM - fm) < WGM ? (nM - fm) : WGM;
        u.pm = fm + ((wgid % nig) % gsz); u.pn = (wgid % nig) / gsz; u.br = 0; return true;
    }
    DEVM bool next(int i, Unit& u) const { return tile((long)i * G + c, u); }
};
struct BranchOrder : StaticOrder {
    DEVM bool next(int i, Unit& u) const { if (!tile((long)(i >> 2) * G + c, u)) return false; u.br = i & 3; return true; }
};
template <int ACT  > struct EpiBf16 {
    static constexpr bool PERM = true;
    bf16_t* O; int ldc;
    DEVM void operator()(const f32x4 (&acc)[2][2][4][2], const Unit& u, int wr, int wc, int fr, int fq) const {
        const int row0 = u.pm * BM + wr * 64 + fr, col0 = u.pn * BM + wc * 32 + 8 * fq;
#pragma unroll
        for (int ai = 0; ai < 2; ++ai)
#pragma unroll
            for (int m = 0; m < 4; ++m) { bf16_t* rowp = O + (size_t)(row0 + ai * HALF + m * 16) * ldc + col0;
#pragma unroll
                for (int bj = 0; bj < 2; ++bj) { f32x4 v0 = acc[ai][bj][m][0], v1 = acc[ai][bj][m][1];
                    if (ACT == 1) {
#pragma unroll
                        for (int q = 0; q < 4; ++q) { v0[q] = sigmoidf_(v0[q]); v1[q] = sigmoidf_(v1[q]); } }
                    if (ACT == 2) {
#pragma unroll
                        for (int q = 0; q < 4; ++q) { const float r0 = fmaxf(v0[q], 0.f), r1 = fmaxf(v1[q], 0.f); v0[q] = r0 * r0; v1[q] = r1 * r1; } }
                    u32x4 w; w.x = pk2(v0[0], v0[1]); w.y = pk2(v0[2], v0[3]); w.z = pk2(v1[0], v1[1]); w.w = pk2(v1[2], v1[3]);
                    *(u32x4*)(rowp + bj * HALF) = w; } }
    }
};
struct EpiMerge {
    static constexpr bool PERM = true;
    bf16_t* O; const bf16_t* G;
    DEVM void operator()(const f32x4 (&acc)[2][2][4][2], const Unit& u, int wr, int wc, int fr, int fq) const {
        const int row0 = u.pm * BM + wr * 64 + fr, col0 = u.pn * BM + wc * 32 + 8 * fq;
#pragma unroll
        for (int ai = 0; ai < 2; ++ai)
#pragma unroll
            for (int m = 0; m < 4; ++m) { const size_t row = (size_t)(row0 + ai * HALF + m * 16); bf16_t* rowp = O + row * D + col0; const bf16_t* gp = G + row * NGATE + u.br * D + col0;
#pragma unroll
                for (int bj = 0; bj < 2; ++bj) { const f32x4 v0 = acc[ai][bj][m][0], v1 = acc[ai][bj][m][1];
                    const u32x4 gw = *(const u32x4*)(gp + bj * HALF);
                    float o[8] = {v0[0] * bflo(gw.x), v0[1] * bfhi(gw.x), v0[2] * bflo(gw.y), v0[3] * bfhi(gw.y), v1[0] * bflo(gw.z), v1[1] * bfhi(gw.z), v1[2] * bflo(gw.w), v1[3] * bfhi(gw.w)};
                    if (u.br != 0) { const u32x4 pw = *(const u32x4*)(rowp + bj * HALF);
                        o[0] += bflo(pw.x); o[1] += bfhi(pw.x); o[2] += bflo(pw.y); o[3] += bfhi(pw.y); o[4] += bflo(pw.z); o[5] += bfhi(pw.z); o[6] += bflo(pw.w); o[7] += bfhi(pw.w); }
                    u32x4 w; w.x = pk2(o[0], o[1]); w.y = pk2(o[2], o[3]); w.z = pk2(o[4], o[5]); w.w = pk2(o[6], o[7]);
                    *(u32x4*)(rowp + bj * HALF) = w; }
#ifndef CPU_EMU
                asm volatile("" ::: "memory");
#endif
            }
    }
};
struct EpiResF32 {
    static constexpr bool PERM = false;
    const float* base; float* out;
    DEVM void operator()(const f32x4 (&acc)[2][2][4][2], const Unit& u, int wr, int wc, int fr, int fq) const {
        const int row0 = u.pm * BM + wr * 64 + fr, col0 = u.pn * BM + wc * 32 + 4 * fq;
#pragma unroll
        for (int ai = 0; ai < 2; ++ai)
#pragma unroll
            for (int m = 0; m < 4; ++m) { const size_t off = (size_t)(row0 + ai * HALF + m * 16) * D + col0;
#pragma unroll
                for (int bj = 0; bj < 2; ++bj)
#pragma unroll
                    for (int n = 0; n < 2; ++n) { const f32x4 bs = *(const f32x4*)(base + off + bj * HALF + n * 16); *(f32x4*)(out + off + bj * HALF + n * 16) = bs + acc[ai][bj][m][n]; } }
    }
};
#ifndef CPU_EMU
#define PG8_LAS __attribute__((address_space(3)))
template <class Epi, class Sched, bool ALIGN_EPI = true>
__device__ __forceinline__ void gemm_phase(PG8_LAS unsigned char* lds, const Gemm g, const Sched& S, const Epi& E) {
    int tid_ = threadIdx.x; asm volatile("" : "+v"(tid_));
    const int tid = tid_, wid = __builtin_amdgcn_readfirstlane(tid >> 6), lane = tid & 63, wr = wid >> 2, wc = wid & 3, fr = lane & 15, fq = lane >> 4;
    const int K = g.K, nt = K / BK;
    unsigned voffA[2], voffB[2];
#pragma unroll
    for (int i = 0; i < 2; ++i) { int R, C; stage_rc(tid * 16 + i * 8192, R, C); const int Rb = Epi::PERM ? ((R & ~31) + perm32(R & 31)) : R;
        voffA[i] = (unsigned)(R * g.lda + C) * 2u; voffB[i] = (unsigned)(Rb * g.ldb + C) * 2u; }
    const size_t kstep = (size_t)(BK * 2);
    const size_t hstepA = (size_t)HALF * g.lda * 2, hstepB = (size_t)HALF * g.ldb * 2;
    const size_t tstepA = 2 * hstepA, tstepB = 2 * hstepB;
    const unsigned ldsw = (unsigned)wid * 1024u;
    const int aoff = lds_byte(wr * 64 + fr, fq * 8), boff = lds_byte(wc * 32 + fr, fq * 8);
#define PG8_SA(b, h) (((b) * 2 + (h)) * HTB)
#define PG8_SB(b, h) ((4 + (b) * 2 + (h)) * HTB)
#define PG8_STAGE(bufoff, gbase, voff) do { _Pragma("unroll") for (int _i = 0; _i < 2; ++_i) \
        __builtin_amdgcn_global_load_lds((const unsigned*)((const char*)(gbase) + (voff)[_i]), (PG8_LAS unsigned*)(lds + (bufoff) + ldsw + _i * 8192), 16, 0, 0); } while (0)
#define PG8_LDA(dst, b, h) do { _Pragma("unroll") for (int m = 0; m < 4; ++m) _Pragma("unroll") for (int k = 0; k < 2; ++k) dst[m][k] = *(const PG8_LAS bf16x8*)(lds + PG8_SA(b, h) + aoff + m * 2048 + k * 1024); } while (0)
#define PG8_LDB(dst, b, h) do { _Pragma("unroll") for (int n = 0; n < 2; ++n) _Pragma("unroll") for (int k = 0; k < 2; ++k) dst[n][k] = *(const PG8_LAS bf16x8*)(lds + PG8_SB(b, h) + boff + n * 2048 + k * 1024); } while (0)
#define PG8_MMA(ai, bj, At, Bt) do { __builtin_amdgcn_s_setprio(1); _Pragma("unroll") for (int m = 0; m < 4; ++m) _Pragma("unroll") for (int n = 0; n < 2; ++n) _Pragma("unroll") for (int k = 0; k < 2; ++k) \
        acc[ai][bj][m][n] = __builtin_amdgcn_mfma_f32_16x16x32_bf16(Bt[n][k], At[m][k], acc[ai][bj][m][n], 0, 0, 0); __builtin_amdgcn_s_setprio(0); } while (0)
#define PG8_WAIT_V(n) asm volatile("s_waitcnt vmcnt(" #n ")" ::: "memory")
#define PG8_WAIT_L(n) asm volatile("s_waitcnt lgkmcnt(" #n ")" ::: "memory")
#define PG8_BAR __builtin_amdgcn_s_barrier()
#define PG8_SCHED __builtin_amdgcn_sched_barrier(0)
#define PG8_ABASE(u) ((const char*)(g.A + (size_t)(u).br * g.a_br) + (size_t)(u).pm * tstepA)
#define PG8_BBASE(u) ((const char*)(g.Bt + (size_t)(u).br * g.b_br) + (size_t)(u).pn * tstepB)
    Unit cur, nxt; int ui = 0;
    if (!S.next(0, cur)) return;
    f32x4 acc[2][2][4][2];
#pragma unroll
    for (int a = 0; a < 2; ++a)
#pragma unroll
        for (int b = 0; b < 2; ++b)
#pragma unroll
            for (int m = 0; m < 4; ++m)
#pragma unroll
                for (int n = 0; n < 2; ++n) acc[a][b][m][n] = (f32x4){0.f, 0.f, 0.f, 0.f};
    bf16x8 At[4][2], B0[2][2], B1[2][2];
    const char* cA = PG8_ABASE(cur); const char* cB = PG8_BBASE(cur);
    PG8_STAGE(PG8_SB(0, 0), cB, voffB); PG8_STAGE(PG8_SB(0, 1), cB + hstepB, voffB); PG8_STAGE(PG8_SA(0, 0), cA, voffA); PG8_STAGE(PG8_SA(0, 1), cA + hstepA, voffA);
    if (wr == 1) PG8_BAR;
    PG8_WAIT_V(2); PG8_BAR;
    PG8_STAGE(PG8_SB(1, 0), cB + kstep, voffB); PG8_STAGE(PG8_SA(1, 0), cA + kstep, voffA); PG8_STAGE(PG8_SB(1, 1), cB + hstepB + kstep, voffB);
    PG8_WAIT_V(6); PG8_BAR;
    for (;;) {
        const bool has_next = S.next(ui + 1, nxt);
        const char* nA = has_next ? PG8_ABASE(nxt) : cA; const char* nB = has_next ? PG8_BBASE(nxt) : cB;
#pragma nounroll
        for (int t = 0; t < nt; t += 2) {
            const bool last = (t == nt - 2);
            const char* a1 = cA + (size_t)(t + 1) * kstep;
            const char* a2 = last ? nA : cA + (size_t)(t + 2) * kstep; const char* b2 = last ? nB : cB + (size_t)(t + 2) * kstep;
            const char* a3 = a2 + kstep; const char* b3 = b2 + kstep;
            PG8_LDB(B0, 0, 0); PG8_LDB(B1, 0, 1); PG8_SCHED; PG8_LDA(At, 0, 0); PG8_STAGE(PG8_SA(1, 1), a1 + hstepA, voffA);
            PG8_WAIT_V(8); PG8_WAIT_L(0); PG8_BAR; PG8_MMA(0, 0, At, B0); PG8_MMA(0, 1, At, B1); PG8_BAR; PG8_SCHED;
            PG8_LDA(At, 0, 1); PG8_STAGE(PG8_SB(0, 0), b2, voffB); PG8_STAGE(PG8_SB(0, 1), b2 + hstepB, voffB); PG8_STAGE(PG8_SA(0, 0), a2, voffA);
            PG8_WAIT_V(8); PG8_WAIT_L(0); PG8_BAR; PG8_MMA(1, 0, At, B0); PG8_MMA(1, 1, At, B1); PG8_BAR; PG8_SCHED;
            PG8_LDB(B0, 1, 0); PG8_LDB(B1, 1, 1); PG8_SCHED; PG8_LDA(At, 1, 0); PG8_STAGE(PG8_SA(0, 1), a2 + hstepA, voffA);
            PG8_WAIT_V(8); PG8_WAIT_L(0); PG8_BAR; PG8_MMA(0, 0, At, B0); PG8_MMA(0, 1, At, B1); PG8_BAR; PG8_SCHED;
            PG8_LDA(At, 1, 1); PG8_STAGE(PG8_SB(1, 0), b3, voffB); PG8_STAGE(PG8_SB(1, 1), b3 + hstepB, voffB); PG8_STAGE(PG8_SA(1, 0), a3, voffA);
            PG8_WAIT_V(8); PG8_WAIT_L(0); PG8_BAR; PG8_MMA(1, 0, At, B0); PG8_MMA(1, 1, At, B1); PG8_BAR; PG8_SCHED;
        }
        if constexpr (ALIGN_EPI) { if (wr == 0) PG8_BAR; }
        E(acc, cur, wr, wc, fr, fq);
        if (!has_next) break;
#pragma unroll
        for (int a = 0; a < 2; ++a)
#pragma unroll
            for (int b = 0; b < 2; ++b)
#pragma unroll
                for (int m = 0; m < 4; ++m)
#pragma unroll
                    for (int n = 0; n < 2; ++n) acc[a][b][m][n] = (f32x4){0.f, 0.f, 0.f, 0.f};
        cur = nxt; cA = nA; cB = nB; ++ui;
        if constexpr (ALIGN_EPI) { if (wr == 1) PG8_BAR; }
    }
    PG8_WAIT_V(0);
    if constexpr (!ALIGN_EPI) { if (wr == 0) PG8_BAR; }
    PG8_BAR;
#undef PG8_SA
#undef PG8_SB
#undef PG8_STAGE
#undef PG8_LDA
#undef PG8_LDB
#undef PG8_MMA
#undef PG8_WAIT_V
#undef PG8_WAIT_L
#undef PG8_BAR
#undef PG8_SCHED
#undef PG8_ABASE
#undef PG8_BBASE
}
#endif
}

#ifndef CPU_EMU
#define LAS __attribute__((address_space(3)))
#define XB_TMO      128
#define XB_XCNT(j)  (256  + 64 * (j))
#define XB_XSUB(j)  (1280 + 64 * (j))
#define XB_XGEN(j)  (2304 + 64 * (j))
#define XB_TOP      3328
#define XB_TOPGEN   3392
#define XCD_BAR_WORDS 3456
#define XB_SPIN_CAP (1u << 20)
__device__ __forceinline__ unsigned xb_ld(unsigned* p)              { return __hip_atomic_load(p, __ATOMIC_RELAXED, __HIP_MEMORY_SCOPE_AGENT); }
__device__ __forceinline__ unsigned xb_add(unsigned* p, unsigned v) { return __hip_atomic_fetch_add(p, v, __ATOMIC_RELAXED, __HIP_MEMORY_SCOPE_AGENT); }
__device__ __forceinline__ unsigned xb_xcc_id() { return (unsigned)__builtin_amdgcn_s_getreg((3 << 11) | 20) & 0xFu; }
#define XB_SPIN(cond, bar) do { unsigned _sp = 0; while (cond) { __builtin_amdgcn_s_sleep(1); \
    if ((++_sp & 255u) == 0u) { if (xb_ld(&(bar)[XB_TMO])) break; if (_sp > XB_SPIN_CAP) { atomicAdd(&(bar)[XB_TMO], 1u); break; } } } } while (0)
struct XcdBarrier { unsigned* bar; unsigned x; volatile LAS unsigned* st; };
__device__ __forceinline__ XcdBarrier xcd_barrier_post(unsigned* bar, volatile LAS unsigned* st) {
    XcdBarrier b; b.bar = bar; b.x = xb_xcc_id(); b.st = st;
    if (threadIdx.x == 0) (void)xb_add(&bar[XB_XCNT(b.x)], 1u);
    return b;
}
__device__ __forceinline__ void xcd_barrier_complete(unsigned* bar, unsigned x, unsigned& nloc, unsigned& nx) {
    const unsigned G = gridDim.x * gridDim.y * gridDim.z;
    unsigned sum, cnt, mine, sp = 0u;
    for (;;) {
        sum = 0u; cnt = 0u; mine = 0u;
#pragma unroll
        for (unsigned j = 0; j < 16; ++j) { const unsigned c = xb_ld(&bar[XB_XCNT(j)]); sum += c; cnt += (c > 0u) ? 1u : 0u; mine = (j == x) ? c : mine; }
        if (sum == G) break;
        __builtin_amdgcn_s_sleep(1);
        if ((++sp & 255u) == 0u) { if (xb_ld(&bar[XB_TMO])) break; if (sp > XB_SPIN_CAP) { atomicAdd(&bar[XB_TMO], 1u); break; } }
    }
    nloc = mine > 0u ? mine : 1u; nx = cnt > 0u ? cnt : 1u;
}
__device__ __forceinline__ void xcd_barrier(const XcdBarrier& b) {
    asm volatile("s_waitcnt vmcnt(0)" ::: "memory");
    __syncthreads();
    if (threadIdx.x == 0) {
        unsigned* bar = b.bar;
        __builtin_amdgcn_s_waitcnt(0);
        unsigned nloc = b.st[0], nx = b.st[1];
        if (nloc == 0u) { xcd_barrier_complete(bar, b.x, nloc, nx); b.st[0] = nloc; b.st[1] = nx; }
        const unsigned old = xb_add(&bar[XB_XSUB(b.x)], 1u);
        const unsigned gen = old / nloc;
        if (old + 1u == (gen + 1u) * nloc) {
            __builtin_amdgcn_fence(__ATOMIC_RELEASE, "agent");
            asm volatile("s_waitcnt vmcnt(0)" ::: "memory");
            const unsigned og = xb_add(&bar[XB_TOP], 1u);
            const unsigned tg = og / nx;
            if (og + 1u == (tg + 1u) * nx) xb_add(&bar[XB_TOPGEN], 1u);
            else XB_SPIN(xb_ld(&bar[XB_TOPGEN]) == tg, bar);
            __builtin_amdgcn_fence(__ATOMIC_ACQUIRE, "agent");
            xb_add(&bar[XB_XGEN(b.x)], 1u);
            asm volatile("s_waitcnt vmcnt(0)" ::: "memory");
        } else {
            XB_SPIN(xb_ld(&bar[XB_XGEN(b.x)]) == gen, bar);
            __builtin_amdgcn_fence(__ATOMIC_ACQUIRE, "agent");
            asm volatile("s_waitcnt vmcnt(0)" ::: "memory");
        }
    }
    __syncthreads();
}
constexpr int LDS_BYTES = 147456;
constexpr int LDSCTL_OFF = 131072 + 320;
__global__ void __launch_bounds__(NTHREADS, 2) mega_fwd(Args a) {
    extern __shared__ __attribute__((aligned(16))) unsigned char lds[];
    __attribute__((address_space(3))) unsigned char* lds3 = (__attribute__((address_space(3))) unsigned char*)lds;
    unsigned char* ws = a.ws;
    bf16_t* XN = (bf16_t*)(ws + OFF_XN); bf16_t* Yb = (bf16_t*)(ws + OFF_Y); bf16_t* HB = (bf16_t*)(ws + OFF_HB); bf16_t* Gb = (bf16_t*)(ws + OFF_G); bf16_t* UP = (bf16_t*)(ws + OFF_UP);
    const bf16_t* WIN_T = (const bf16_t*)(ws + OFF_WIN); const bf16_t* WBR_T = (const bf16_t*)(ws + OFF_WBR); const bf16_t* WOUT_T = (const bf16_t*)(ws + OFF_WOUT);
    const bf16_t* WUP_T = (const bf16_t*)(ws + OFF_WUP); const bf16_t* WDN_T = (const bf16_t*)(ws + OFF_WDN);
    const int G = gridDim.x, bid = blockIdx.x;
    const int lo = a.ph_lo, hi = a.ph_hi;
    volatile LAS unsigned* MISC = (volatile LAS unsigned*)(lds3 + LDSCTL_OFF);
    if (threadIdx.x < 16) MISC[threadIdx.x] = 0u;
    __syncthreads();
    XcdBarrier bar; bar.bar = (unsigned*)(ws + OFF_CTL) + 4096; bar.x = 0; bar.st = nullptr;
    if (hi - lo > 1) bar = xcd_barrier_post((unsigned*)(ws + OFF_CTL) + 4096, MISC + 8);
#define SEAM(p) do { if (lo <= (p) && (p) + 1 < hi) xcd_barrier(bar); } while (0)
#define IN_PH(p) ((((PH_MASK) >> ((p) % PH_PER_LAYER + ((p) == PH_FINAL ? PH_PER_LAYER : 0))) & 1) && lo <= (p) && (p) < hi)
#pragma unroll
    for (int layer = 0; layer < NLAYER; ++layer) {
        const int pb = layer * PH_PER_LAYER;
        const float* xin = layer == 0 ? a.in[I_X] : a.out;
        for (int rep_ = 0; rep_ < (REP_KIND == PH_WCONV ? 2 : 1); ++rep_) if (IN_PH(pb + PH_WCONV)) phase_wconv(a, lds, layer);
        SEAM(pb + PH_WCONV);
        for (int rep_ = 0; rep_ < (REP_KIND == PH_NORM1 ? 2 : 1); ++rep_) if (IN_PH(pb + PH_NORM1)) phase_rmsnorm_bf16(xin, a.in[I_NMG] + layer * D, XN);
        SEAM(pb + PH_NORM1);
        for (int rep_ = 0; rep_ < (REP_KIND == PH_GEMM_IN ? 2 : 1); ++rep_) if (IN_PH(pb + PH_GEMM_IN)) { pg8::Gemm g{XN, WIN_T, D, D, D, 0, 0}; pg8::StaticOrder S; S.init(M, NHB, G, bid); pg8::EpiBf16<0> E{HB, NHB};
            pg8::gemm_phase<pg8::EpiBf16<0>, pg8::StaticOrder>(lds3, g, S, E); }
        SEAM(pb + PH_GEMM_IN);
        for (int rep_ = 0; rep_ < (REP_KIND == PH_MIX1 ? 2 : 1); ++rep_) if (IN_PH(pb + PH_MIX1)) phase_mix1(a, lds, layer);
        SEAM(pb + PH_MIX1);
        for (int rep_ = 0; rep_ < (REP_KIND == PH_MIX2 ? 2 : 1); ++rep_) if (IN_PH(pb + PH_MIX2)) gla_scan(a);
        SEAM(pb + PH_MIX2);
        for (int rep_ = 0; rep_ < (REP_KIND == PH_MIX3 ? 2 : 1); ++rep_) if (IN_PH(pb + PH_MIX3)) phase_mix3(a, lds, layer);
        SEAM(pb + PH_MIX3);
        for (int rep_ = 0; rep_ < (REP_KIND == PH_GEMM_G ? 2 : 1); ++rep_) if (IN_PH(pb + PH_GEMM_G)) { pg8::Gemm g{XN, WIN_T + (size_t)NHB * D, D, D, D, 0, 0}; pg8::StaticOrder S; S.init(M, NGATE, G, bid); pg8::EpiBf16<1> E{Gb, NGATE};
            pg8::gemm_phase<pg8::EpiBf16<1>, pg8::StaticOrder>(lds3, g, S, E); }
        SEAM(pb + PH_GEMM_G);
        for (int rep_ = 0; rep_ < (REP_KIND == PH_GEMM_M ? 2 : 1); ++rep_) if (IN_PH(pb + PH_GEMM_M)) { pg8::Gemm g{Yb, WBR_T, 256, D, 256, 256, (size_t)D * 256}; pg8::BranchOrder S; S.init(M, D, G, bid); pg8::EpiMerge E{XN, Gb};
            pg8::gemm_phase<pg8::EpiMerge, pg8::BranchOrder>(lds3, g, S, E); }
        SEAM(pb + PH_GEMM_M);
        for (int rep_ = 0; rep_ < (REP_KIND == PH_GEMM_O ? 2 : 1); ++rep_) if (IN_PH(pb + PH_GEMM_O)) { pg8::Gemm g{XN, WOUT_T, D, D, D, 0, 0}; pg8::StaticOrder S; S.init(M, D, G, bid); pg8::EpiResF32 E{xin, a.out};
            pg8::gemm_phase<pg8::EpiResF32, pg8::StaticOrder>(lds3, g, S, E); }
        SEAM(pb + PH_GEMM_O);
        for (int rep_ = 0; rep_ < (REP_KIND == PH_NORM2 ? 2 : 1); ++rep_) if (IN_PH(pb + PH_NORM2)) phase_rmsnorm_bf16(a.out, a.in[I_NFG] + layer * D, XN);
        SEAM(pb + PH_NORM2);
        for (int rep_ = 0; rep_ < (REP_KIND == PH_GEMM_U ? 2 : 1); ++rep_) if (IN_PH(pb + PH_GEMM_U)) { pg8::Gemm g{XN, WUP_T, D, D, D, 0, 0}; pg8::StaticOrder S; S.init(M, DFF, G, bid); pg8::EpiBf16<2> E{UP, DFF};
            pg8::gemm_phase<pg8::EpiBf16<2>, pg8::StaticOrder>(lds3, g, S, E); }
        SEAM(pb + PH_GEMM_U);
        for (int rep_ = 0; rep_ < (REP_KIND == PH_GEMM_D ? 2 : 1); ++rep_) if (IN_PH(pb + PH_GEMM_D)) { pg8::Gemm g{UP, WDN_T, DFF, DFF, DFF, 0, 0}; pg8::StaticOrder S; S.init(M, D, G, bid); pg8::EpiResF32 E{a.out, a.out};
            pg8::gemm_phase<pg8::EpiResF32, pg8::StaticOrder>(lds3, g, S, E); }
        SEAM(pb + PH_GEMM_D);
    }
    if (IN_PH(PH_FINAL)) phase_rmsnorm_f32_inplace(a.out, a.in[I_FNG]);
#undef IN_PH
#undef SEAM
}

extern "C" void kernel_launch(void* const* d_in, const int* in_sizes, int n_in, void* d_out, int out_size, void* d_ws, size_t ws_size, hipStream_t stream) {
    static int grid = 0;
    if (grid == 0) {
        if (n_in != N_INPUTS || out_size != M * D || ws_size < WS_END) { fprintf(stderr, "kernel_launch: unexpected shapes (n_in %d out %d ws %zu)\n", n_in, out_size, ws_size); grid = -1; return; }
        int dev = 0, cus = 0;
        if (hipGetDevice(&dev) != hipSuccess || hipDeviceGetAttribute(&cus, hipDeviceAttributeMultiprocessorCount, dev) != hipSuccess) { grid = -1; return; }
        if (hipFuncSetAttribute((const void*)mega_fwd, hipFuncAttributeMaxDynamicSharedMemorySize, LDS_BYTES) != hipSuccess) { fprintf(stderr, "kernel_launch: hipFuncSetAttribute failed\n"); grid = -1; return; }
        grid = cus;
    }
    if (grid < 0) return;
    Args a{};
    for (int i = 0; i < N_INPUTS; ++i) a.in[i] = (const float*)d_in[i];
    a.out = (float*)d_out; a.ws = (unsigned char*)d_ws;
#if N_LAUNCH_MODE == 0
    for (int ph = 0; ph < N_PHASES; ++ph) { a.ph_lo = ph; a.ph_hi = ph + 1; hipLaunchKernelGGL(mega_fwd, dim3(grid), dim3(NTHREADS), LDS_BYTES, stream, a); }
#else
    if (hipMemsetAsync((char*)d_ws + OFF_CTL, 0, 65536, stream) != hipSuccess) { fprintf(stderr, "kernel_launch: memset failed\n"); return; }
    a.ph_lo = 0; a.ph_hi = N_PHASES;
    hipLaunchKernelGGL(mega_fwd, dim3(grid), dim3(NTHREADS), LDS_BYTES, stream, a);
#endif
}
#endif
```

```cpp
#ifndef CPU_EMU
#include <hip/hip_runtime.h>
#include <cstdio>
#include <cstdint>
#endif
#ifndef SEQ_T
#define SEQ_T 8192
#endif
#ifndef PH_MASK
#define PH_MASK 0xffff
#endif
#ifndef REP_ITEM
#define REP_ITEM -1
#endif
#ifndef REP_KIND
#define REP_KIND -1
#endif
#ifndef N_LAUNCH_MODE
#define N_LAUNCH_MODE 1
#endif

typedef unsigned short bf16_t;
typedef short bf16x8 __attribute__((ext_vector_type(8)));
typedef short s16x4 __attribute__((ext_vector_type(4)));
typedef float f32x4 __attribute__((ext_vector_type(4)));
typedef float f32x16 __attribute__((ext_vector_type(16)));
typedef unsigned u32x4 __attribute__((ext_vector_type(4)));
typedef unsigned u32x2 __attribute__((ext_vector_type(2)));
#ifdef CPU_EMU
#define DEVI static inline
#define DEVM inline
DEVI float ex2(float x) { return exp2f(x); }
DEVI float lg2(float x) { return log2f(x); }
DEVI float rcpf_(float x) { return 1.0f / x; }
DEVI float rsqf_(float x) { return 1.0f / sqrtf(x); }
DEVI f32x16 mfma32(bf16x8 a, bf16x8 b, f32x16 c) { return emu_mfma32(a, b, c); }
DEVI void wave_sync() { emu_wave->bar.wait(); }
DEVI int rfl(int x) { return x; }
#else
#define DEVI __device__ __forceinline__
#define DEVM __device__ __forceinline__
DEVI float ex2(float x) { return __builtin_amdgcn_exp2f(x); }
DEVI float lg2(float x) { return __builtin_amdgcn_logf(x); }
DEVI float rcpf_(float x) { return __builtin_amdgcn_rcpf(x); }
DEVI float rsqf_(float x) { return __builtin_amdgcn_rsqf(x); }
DEVI f32x16 mfma32(bf16x8 a, bf16x8 b, f32x16 c) { return __builtin_amdgcn_mfma_f32_32x32x16_bf16(a, b, c, 0, 0, 0); }
DEVI void wave_sync() { asm volatile("s_waitcnt lgkmcnt(0)" ::: "memory"); }
DEVI int rfl(int x) { return __builtin_amdgcn_readfirstlane(x); }
#endif
#ifdef CPU_EMU
DEVI int launder_tid() { return (int)threadIdx.x; }
#else
DEVI int launder_tid() { int t = threadIdx.x; asm volatile("" : "+v"(t)); return t; }
#endif
DEVI unsigned f2bf(float f) { unsigned u = __builtin_bit_cast(unsigned, f); return (u + 0x7fffu + ((u >> 16) & 1u)) >> 16; }
DEVI unsigned pk2(float lo, float hi) { return f2bf(lo) | (f2bf(hi) << 16); }
DEVI float bf2f(unsigned h) { return __builtin_bit_cast(float, h << 16); }
DEVI float bflo(unsigned w) { return __builtin_bit_cast(float, w << 16); }
DEVI float bfhi(unsigned w) { return __builtin_bit_cast(float, w & 0xffff0000u); }
constexpr float LOG2E = 1.4426950408889634f, LN2 = 0.6931471805599453f;
DEVI float sigmoidf_(float x) { return rcpf_(1.0f + ex2(-x * LOG2E)); }
DEVI float siluf_(float x) { return x * sigmoidf_(x); }
DEVI float logsigf_(float z) { const float a = fabsf(z); return fminf(z, 0.f) - LN2 * lg2(1.0f + ex2(-a * LOG2E)); }
DEVI float wave_sum(float v) {
#pragma unroll
    for (int o = 1; o < 64; o <<= 1) v += __shfl_xor(v, o);
    return v;
}

constexpr int BATCH = 2, SEQ = SEQ_T, M = BATCH * SEQ, D = 1024, DFF = 4096, NLAYER = 2;
constexpr int DIN_SRC = 6176;
constexpr int NHB = 2304, NGATE = 4096, NIN = NHB + NGATE;
constexpr int C_GLUA = 0, C_GLUG = 256, C_GQ = 512, C_GK = 640, C_GV = 768, C_GR = 1024, C_Z = 1280, C_AQ = 1536, C_AK = 1792, C_AV = 1920, C_PIN = 2048;
constexpr int SRC_GLR = 1280;
constexpr int NCH = SEQ / 64;
constexpr int NAB = SEQ / 128;
constexpr float EPS = 1e-6f;
constexpr int NTHREADS = 512, NWAVES = 8;
enum { I_X = 0, I_NMG, I_WIN, I_CW, I_CB, I_CLG, I_CLB, I_WUP, I_BUP, I_GNG, I_SINK, I_PW, I_PS, I_WBR, I_WOUT, I_NFG, I_WFU, I_WFD, I_FNG, N_INPUTS };
constexpr size_t al256(size_t x) { return (x + 255) & ~(size_t)255; }
constexpr size_t OFF_CTL = 0, CTL_BYTES = 1u << 20;
constexpr size_t SZ_WIN = (size_t)NIN * D * 2, SZ_WBR = (size_t)4 * D * 256 * 2, SZ_WOUT = (size_t)D * D * 2, SZ_WUP = (size_t)DFF * D * 2, SZ_WDN = (size_t)D * DFF * 2;
constexpr size_t OFF_WIN = OFF_CTL + CTL_BYTES, OFF_WBR = OFF_WIN + SZ_WIN, OFF_WOUT = OFF_WBR + SZ_WBR, OFF_WUP = OFF_WOUT + SZ_WOUT, OFF_WDN = OFF_WUP + SZ_WUP;
constexpr size_t OFF_ROPE = OFF_WDN + SZ_WDN, SZ_ROPE = al256((size_t)SEQ * 8 * 8);
constexpr size_t OFF_PWT = OFF_ROPE + SZ_ROPE, SZ_PWT = 4 * 64 * 64 * 2;
constexpr size_t OFF_XN = OFF_PWT + SZ_PWT, SZ_ACT = al256((size_t)M * D * 2);
constexpr size_t OFF_Y = OFF_XN + SZ_ACT;
constexpr size_t OFF_BIG = OFF_Y + SZ_ACT;
constexpr size_t OFF_HB = OFF_BIG, SZ_HB = al256((size_t)M * NHB * 2);
constexpr size_t OFF_GU = OFF_HB + SZ_HB, SZ_GU = al256((size_t)BATCH * 4 * 2 * NCH * 2048 * 4);
constexpr size_t OFF_GD = OFF_GU + SZ_GU, SZ_GD = al256((size_t)BATCH * 4 * 2 * NCH * 32 * 4);
constexpr size_t OFF_G = OFF_BIG, SZ_G = al256((size_t)M * NGATE * 2);
constexpr size_t OFF_UP = OFF_BIG;
constexpr size_t WS_END = OFF_BIG + (SZ_G > SZ_HB + SZ_GU + SZ_GD ? SZ_G : SZ_HB + SZ_GU + SZ_GD);
static_assert(WS_END <= 268435456, "workspace map exceeds 256 MiB");

struct Args { const float* in[N_INPUTS]; float* out; unsigned char* ws; int ph_lo, ph_hi; };

enum { PH_WCONV = 0, PH_NORM1, PH_GEMM_IN, PH_MIX1, PH_MIX2, PH_MIX3, PH_GEMM_G, PH_GEMM_M, PH_GEMM_O, PH_NORM2, PH_GEMM_U, PH_GEMM_D, PH_PER_LAYER };
constexpr int PH_FINAL = NLAYER * PH_PER_LAYER, N_PHASES = PH_FINAL + 1;

DEVI void transpose_item(const float* W, int ldw, int K, bf16_t* WT, int k0, int src_n0, int dst_n0, float* scr, int lane) {
#pragma unroll 8
    for (int i = 0; i < 32; ++i) { const int kk = 2 * i + (lane >> 5); scr[kk * 33 + (lane & 31)] = W[(size_t)(k0 + kk) * ldw + src_n0 + (lane & 31)]; }
    wave_sync();
    const int c = lane & 7;
#pragma unroll
    for (int j = 0; j < 4; ++j) { const int n = (lane >> 3) + 8 * j; const float* s = scr + (8 * c) * 33 + n;
        u32x4 o; o.x = pk2(s[0 * 33], s[1 * 33]); o.y = pk2(s[2 * 33], s[3 * 33]); o.z = pk2(s[4 * 33], s[5 * 33]); o.w = pk2(s[6 * 33], s[7 * 33]);
        *(u32x4*)(WT + (size_t)(dst_n0 + n) * K + k0 + 8 * c) = o; }
    wave_sync();
}
DEVI void zfold_item(const float* Win, const float* wup, bf16_t* WT, int k0, int zc0  , float* scr, int lane) {
    const int s = zc0 >> 7, kc = (zc0 & 127) + (lane & 31);
    float wu[16];
#pragma unroll
    for (int r = 0; r < 16; ++r) wu[r] = wup[(s * 16 + r) * 128 + kc];
    for (int i = 0; i < 32; ++i) { const int kk = 2 * i + (lane >> 5); const float* g = Win + (size_t)(k0 + kk) * DIN_SRC + SRC_GLR + s * 16; float a = 0.f;
#pragma unroll
        for (int r = 0; r < 16; ++r) a += g[r] * wu[r];
        scr[kk * 33 + (lane & 31)] = a; }
    wave_sync();
    const int c = lane & 7;
#pragma unroll
    for (int j = 0; j < 4; ++j) { const int n = (lane >> 3) + 8 * j; const float* sp = scr + (8 * c) * 33 + n;
        u32x4 o; o.x = pk2(sp[0 * 33], sp[1 * 33]); o.y = pk2(sp[2 * 33], sp[3 * 33]); o.z = pk2(sp[4 * 33], sp[5 * 33]); o.w = pk2(sp[6 * 33], sp[7 * 33]);
        *(u32x4*)(WT + (size_t)(C_Z + zc0 + n) * D + k0 + 8 * c) = o; }
    wave_sync();
}
DEVI void rope_entry(int pos, int i, float& c, float& s) {
    const double inv[8] = {1.0, 0.19392274474868576, 0.03760603093086393, 0.007292664737217109, 0.001414213562373095, 0.0002742481756762073, 5.318295896944988e-05, 1.031338537721246e-05};
    double iv = inv[0];
#pragma unroll
    for (int k = 1; k < 8; ++k) iv = (i == k) ? inv[k] : iv;
    double rev = (double)pos * iv * 0.15915494309189535; rev -= __builtin_rint(rev);
    double q4 = rev * 4.0; const double qn = __builtin_rint(q4); const double t = (q4 - qn) * 1.5707963267948966;
    const double t2 = t * t;
    double sp = t * (1.0 + t2 * (-1.0 / 6 + t2 * (1.0 / 120 + t2 * (-1.0 / 5040 + t2 * (1.0 / 362880 + t2 * (-1.0 / 39916800 + t2 * (1.0 / 6227020800.0)))))));
    double cp = 1.0 + t2 * (-0.5 + t2 * (1.0 / 24 + t2 * (-1.0 / 720 + t2 * (1.0 / 40320 + t2 * (-1.0 / 3628800 + t2 * (1.0 / 479001600.0))))));
    const int qi = ((int)qn) & 3;
    const double cs = (qi == 0) ? cp : (qi == 1) ? -sp : (qi == 2) ? -cp : sp;
    const double sn = (qi == 0) ? sp : (qi == 1) ? cp : (qi == 2) ? -sp : -cp;
    c = (float)cs; s = (float)sn;
}
DEVI void phase_wconv(const Args& a, unsigned char* lds, int layer) {
    const int tid = launder_tid(), lane = tid & 63, wave = rfl(tid >> 6);
    float* scr = (float*)(lds + wave * 8448);
    const int gw = blockIdx.x * NWAVES + wave, NGW = gridDim.x * NWAVES;
    const float* Win = a.in[I_WIN] + (size_t)layer * D * DIN_SRC; const float* wup = a.in[I_WUP] + (size_t)layer * 2 * 16 * 128;
    const float* Wbr = a.in[I_WBR] + (size_t)layer * 4 * 256 * D; const float* Wout = a.in[I_WOUT] + (size_t)layer * D * D;
    const float* Wfu = a.in[I_WFU] + (size_t)layer * D * DFF; const float* Wfd = a.in[I_WFD] + (size_t)layer * DFF * D;
    bf16_t* WIN_T = (bf16_t*)(a.ws + OFF_WIN); bf16_t* WBR_T = (bf16_t*)(a.ws + OFF_WBR); bf16_t* WOUT_T = (bf16_t*)(a.ws + OFF_WOUT);
    bf16_t* WUP_T = (bf16_t*)(a.ws + OFF_WUP); bf16_t* WDN_T = (bf16_t*)(a.ws + OFF_WDN);
    constexpr int I_IN = (D / 64) * (NIN / 32), I_BR = 4 * (256 / 64) * (D / 32), I_OUT = (D / 64) * (D / 32), I_UP = (D / 64) * (DFF / 32), I_DN = (DFF / 64) * (D / 32);
    constexpr int NITEMS = I_IN + I_BR + I_OUT + I_UP + I_DN;
    for (int it = gw; it < NITEMS; it += NGW) {
        int r = it;
        if (r < I_IN) { const int nblk = NIN / 32, kb = r / nblk, nb = r % nblk, n0 = nb * 32;
            if (n0 >= C_Z && n0 < C_AQ) zfold_item(Win, wup, WIN_T, kb * 64, n0 - C_Z, scr, lane);
            else transpose_item(Win, DIN_SRC, D, WIN_T, kb * 64, n0 < C_Z ? n0 : n0 - 224, n0, scr, lane);
            continue; } r -= I_IN;
        if (r < I_BR) { const int br = r / (I_BR / 4), q = r % (I_BR / 4), nblk = D / 32, kb = q / nblk, nb = q % nblk;
            transpose_item(Wbr + (size_t)br * 256 * D, D, 256, WBR_T + (size_t)br * D * 256, kb * 64, nb * 32, nb * 32, scr, lane); continue; } r -= I_BR;
        if (r < I_OUT) { const int nblk = D / 32, kb = r / nblk, nb = r % nblk; transpose_item(Wout, D, D, WOUT_T, kb * 64, nb * 32, nb * 32, scr, lane); continue; } r -= I_OUT;
        if (r < I_UP) { const int nblk = DFF / 32, kb = r / nblk, nb = r % nblk; transpose_item(Wfu, DFF, D, WUP_T, kb * 64, nb * 32, nb * 32, scr, lane); continue; } r -= I_UP;
        { const int nblk = D / 32, kb = r / nblk, nb = r % nblk; transpose_item(Wfd, D, DFF, WDN_T, kb * 64, nb * 32, nb * 32, scr, lane); }
    }
    { bf16_t* PWT = (bf16_t*)(a.ws + OFF_PWT); const float* pw = a.in[I_PW] + (size_t)layer * 4 * 64 * 64;
      for (int e = blockIdx.x * NTHREADS + tid; e < 4 * 64 * 64; e += gridDim.x * NTHREADS) { const int g = e >> 12, ee = (e >> 6) & 63, c = e & 63; PWT[e] = (bf16_t)f2bf(pw[(g * 64 + c) * 64 + ee]); } }
    if (layer == 0) { float* rope = (float*)(a.ws + OFF_ROPE);
        for (int e = blockIdx.x * NTHREADS + tid; e < SEQ * 8; e += gridDim.x * NTHREADS) { float c, s; rope_entry(e >> 3, e & 7, c, s); rope[2 * e] = c; rope[2 * e + 1] = s; } }
}

DEVI void phase_rmsnorm_bf16(const float* x, const float* g, bf16_t* out) {
    const int tid = launder_tid(), lane = tid & 63, wave = rfl(tid >> 6);
    const int gw = blockIdx.x * NWAVES + wave, NGW = gridDim.x * NWAVES;
    f32x4 gv[4];
#pragma unroll
    for (int j = 0; j < 4; ++j) gv[j] = *(const f32x4*)(g + 4 * lane + 256 * j);
    for (int m = gw; m < M; m += NGW) {
        const f32x4* xr = (const f32x4*)(x + (size_t)m * D) + lane; f32x4 v[4]; float s = 0.f;
#pragma unroll
        for (int j = 0; j < 4; ++j) { v[j] = xr[64 * j]; s += (v[j].x * v[j].x + v[j].y * v[j].y) + (v[j].z * v[j].z + v[j].w * v[j].w); }
        const float rstd = rsqf_(wave_sum(s) * (1.f / D) + EPS);
        u32x2* o8 = (u32x2*)(out + (size_t)m * D) + lane;
#pragma unroll
        for (int j = 0; j < 4; ++j) { u32x2 w; w.x = pk2(v[j].x * rstd * gv[j].x, v[j].y * rstd * gv[j].y); w.y = pk2(v[j].z * rstd * gv[j].z, v[j].w * rstd * gv[j].w); o8[64 * j] = w; }
    }
}
DEVI void phase_rmsnorm_f32_inplace(float* x, const float* g) {
    const int tid = launder_tid(), lane = tid & 63, wave = rfl(tid >> 6);
    const int gw = blockIdx.x * NWAVES + wave, NGW = gridDim.x * NWAVES;
    f32x4 gv[4];
#pragma unroll
    for (int j = 0; j < 4; ++j) gv[j] = *(const f32x4*)(g + 4 * lane + 256 * j);
    for (int m = gw; m < M; m += NGW) {
        f32x4* xr = (f32x4*)(x + (size_t)m * D) + lane; f32x4 v[4]; float s = 0.f;
#pragma unroll
        for (int j = 0; j < 4; ++j) { v[j] = xr[64 * j]; s += (v[j].x * v[j].x + v[j].y * v[j].y) + (v[j].z * v[j].z + v[j].w * v[j].w); }
        const float rstd = rsqf_(wave_sum(s) * (1.f / D) + EPS);
#pragma unroll
        for (int j = 0; j < 4; ++j) xr[64 * j] = v[j] * rstd * gv[j];
    }
}

DEVI void conv_item(const Args& a, unsigned char* lds, int layer, int item) {
    const int tid = launder_tid(), lane = tid & 63, wave = rfl(tid >> 6), c = tid & 255, hf = tid >> 8;
    const int b = item / (SEQ / 32), t0 = (item % (SEQ / 32)) * 32;
    const bf16_t* HB = (const bf16_t*)(a.ws + OFF_HB); bf16_t* Y = (bf16_t*)(a.ws + OFF_Y);
    float* u = (float*)lds; float* y = u + 62 * 256;
    for (int e = tid; e < 62 * 32; e += NTHREADS) { const int r = e >> 5, c8 = e & 31, t = t0 - 15 + r; f32x4 o0 = {}, o1 = {};
        if (t >= 0 && t < SEQ) { const bf16_t* hp = HB + (size_t)(b * SEQ + t) * NHB + c8 * 8; const u32x4 av = *(const u32x4*)(hp + C_GLUA), gv = *(const u32x4*)(hp + C_GLUG);
            o0 = (f32x4){bflo(av.x) * sigmoidf_(bflo(gv.x)), bfhi(av.x) * sigmoidf_(bfhi(gv.x)), bflo(av.y) * sigmoidf_(bflo(gv.y)), bfhi(av.y) * sigmoidf_(bfhi(gv.y))};
            o1 = (f32x4){bflo(av.z) * sigmoidf_(bflo(gv.z)), bfhi(av.z) * sigmoidf_(bfhi(gv.z)), bflo(av.w) * sigmoidf_(bflo(gv.w)), bfhi(av.w) * sigmoidf_(bfhi(gv.w))}; }
        *(f32x4*)(u + r * 256 + c8 * 8) = o0; *(f32x4*)(u + r * 256 + c8 * 8 + 4) = o1; }
    float w[31];
    const float* cw = a.in[I_CW] + (size_t)layer * 31 * 256;
#pragma unroll
    for (int k = 0; k < 31; ++k) w[k] = cw[k * 256 + c];
    const float bias = a.in[I_CB][layer * 256 + c];
    __syncthreads();
    { float acc[16];
#pragma unroll
      for (int i = 0; i < 16; ++i) acc[i] = bias;
      const float* up = u + hf * 16 * 256 + c;
#pragma unroll
      for (int r = 0; r < 46; ++r) { const float v = up[r * 256];
#pragma unroll
          for (int i = 0; i < 16; ++i) if (r - i >= 0 && r - i <= 30) acc[i] += v * w[r - i]; }
#pragma unroll
      for (int i = 0; i < 16; ++i) y[(hf * 16 + i) * 256 + c] = acc[i]; }
    __syncthreads();
    const f32x4 lg = *(const f32x4*)(a.in[I_CLG] + layer * 256 + 4 * lane), lb = *(const f32x4*)(a.in[I_CLB] + layer * 256 + 4 * lane);
#pragma unroll
    for (int i = 0; i < 4; ++i) { const int tt = wave * 4 + i; f32x4 v = *(const f32x4*)(y + tt * 256 + 4 * lane);
        const float mu = wave_sum((v.x + v.y) + (v.z + v.w)) * (1.f / 256); v = v - mu;
        const float var = wave_sum((v.x * v.x + v.y * v.y) + (v.z * v.z + v.w * v.w)) * (1.f / 256); const float rstd = rsqf_(var + EPS);
        v = v * rstd * lg + lb;
        u32x2 o; o.x = pk2(siluf_(v.x), siluf_(v.y)); o.y = pk2(siluf_(v.z), siluf_(v.w));
        *(u32x2*)(Y + (size_t)(b * SEQ + t0 + tt) * D + 0 + 4 * lane) = o; }
    __syncthreads();
}
constexpr int PD_LD = 264;
DEVI void pool_item(const Args& a, unsigned char* lds, int layer, int item) {
    const int tid = launder_tid(), lane = tid & 63, wave = rfl(tid >> 6), c = tid & 255, hf = tid >> 8;
    const int b = item / (SEQ / 32), t0 = (item % (SEQ / 32)) * 32;
    const bf16_t* HB = (const bf16_t*)(a.ws + OFF_HB); bf16_t* Y = (bf16_t*)(a.ws + OFF_Y);
    float* u = (float*)lds; bf16_t* ds = (bf16_t*)(u + 48 * 256);
    for (int e = tid; e < 48 * 32; e += NTHREADS) { const int r = e >> 5, c8 = e & 31, t = t0 - 8 + r; f32x4 o0 = {}, o1 = {};
        if (t >= 0 && t < SEQ) { const u32x4 v = *(const u32x4*)(HB + (size_t)(b * SEQ + t) * NHB + C_PIN + c8 * 8);
            o0 = (f32x4){bflo(v.x), bfhi(v.x), bflo(v.y), bfhi(v.y)}; o1 = (f32x4){bflo(v.z), bfhi(v.z), bflo(v.w), bfhi(v.w)}; }
        *(f32x4*)(u + r * 256 + c8 * 8) = o0; *(f32x4*)(u + r * 256 + c8 * 8 + 4) = o1; }
    __syncthreads();
    { const int gg = c >> 6, hw = 1 << gg;
      for (int i = 0; i < 16; ++i) { const int tt = hf * 16 + i, t = t0 + tt; const int lo = (t - hw) < 0 ? 0 : (t - hw), hi = (t + hw) > SEQ ? SEQ : (t + hw);
          float s = 0.f; for (int p = lo; p < hi; ++p) s += u[(p - t0 + 8) * 256 + c];
          ds[tt * PD_LD + c] = (bf16_t)f2bf(s / (float)(hi - lo) - u[(tt + 8) * 256 + c]); } }
    __syncthreads();
    { const int g = wave >> 1, et = wave & 1, r32 = lane & 31, hi = lane >> 5; const bf16_t* PWT = (const bf16_t*)(a.ws + OFF_PWT);
      f32x16 acc = {};
#pragma unroll
      for (int ks = 0; ks < 4; ++ks) { const bf16x8 af = *(const bf16x8*)(PWT + (size_t)(g * 64 + et * 32 + r32) * 64 + ks * 16 + hi * 8), bfr = *(const bf16x8*)(ds + r32 * PD_LD + g * 64 + ks * 16 + hi * 8); acc = mfma32(af, bfr, acc); }
      const float* psp = a.in[I_PS] + layer * 256 + g * 64 + et * 32 + 4 * hi; bf16_t* yp = Y + (size_t)(b * SEQ + t0 + r32) * D + 768 + g * 64 + et * 32 + 4 * hi;
#pragma unroll
      for (int g4 = 0; g4 < 4; ++g4) { const f32x4 ps = *(const f32x4*)(psp + 8 * g4); u32x2 w; w.x = pk2(acc[4 * g4] * ps[0], acc[4 * g4 + 1] * ps[1]); w.y = pk2(acc[4 * g4 + 2] * ps[2], acc[4 * g4 + 3] * ps[3]); *(u32x2*)(yp + 8 * g4) = w; } }
    __syncthreads();
}
DEVI int crow(int r, int hi) { return (r & 3) + 8 * (r >> 2) + 4 * hi; }
constexpr int KS_LD = 72, VT_LD = 388;
DEVI void attn_item(const Args& a, unsigned char* lds, int layer, int item) {
    const int tid = launder_tid(), lane = tid & 63, wave = rfl(tid >> 6);
    const int b = item / (2 * NAB), kv = (item / NAB) & 1, n = item % NAB;
    const bf16_t* HB = (const bf16_t*)(a.ws + OFF_HB); bf16_t* Y = (bf16_t*)(a.ws + OFF_Y); const float* rope = (const float*)(a.ws + OFF_ROPE);
    bf16_t* Ks = (bf16_t*)lds; bf16_t* Vt = Ks + 384 * KS_LD;
    const int kbase = n * 128 - 128;
    for (int e = tid; e < 384 * 8; e += NTHREADS) { const int wr = e >> 3, c8 = e & 7, kpos = kbase + wr;
        u32x4 kw = (u32x4){0u, 0u, 0u, 0u}, vw = (u32x4){0u, 0u, 0u, 0u};
        if (kpos >= 0 && kpos < SEQ) { const bf16_t* hp = HB + (size_t)(b * SEQ + kpos) * NHB;
            kw = *(const u32x4*)(hp + C_AK + kv * 64 + c8 * 8); vw = *(const u32x4*)(hp + C_AV + kv * 64 + c8 * 8);
            if (c8 < 2) { const u32x4 pw = *(const u32x4*)(hp + C_AK + kv * 64 + (c8 ^ 1) * 8); const float sg = c8 ? 1.f : -1.f; const float* rp = rope + (size_t)kpos * 16;
                float o[8];
#pragma unroll
                for (int j = 0; j < 4; ++j) { const float m0 = bflo(kw[j]), m1 = bfhi(kw[j]), p0 = bflo(pw[j]), p1 = bfhi(pw[j]);
                    o[2 * j] = m0 * rp[4 * j] + sg * p0 * rp[4 * j + 1]; o[2 * j + 1] = m1 * rp[4 * j + 2] + sg * p1 * rp[4 * j + 3]; }
                kw = (u32x4){pk2(o[0], o[1]), pk2(o[2], o[3]), pk2(o[4], o[5]), pk2(o[6], o[7])}; } }
        *(u32x4*)(Ks + wr * KS_LD + c8 * 8) = kw;
#pragma unroll
        for (int j = 0; j < 4; ++j) { Vt[(c8 * 8 + 2 * j) * VT_LD + wr] = (bf16_t)(vw[j] & 0xffffu); Vt[(c8 * 8 + 2 * j + 1) * VT_LD + wr] = (bf16_t)(vw[j] >> 16); } }
    const int g = wave >> 2, hq = kv * 2 + g, q0l = (wave & 3) * 32, ql = lane & 31, hi = lane >> 5, qpos = n * 128 + q0l + ql;
    bf16x8 qf[4];
    { const bf16_t* qp = HB + (size_t)(b * SEQ + qpos) * NHB + C_AQ + hq * 64 + hi * 8; const float* rp = rope + (size_t)qpos * 16; const float sg = hi ? 1.f : -1.f;
#pragma unroll
      for (int ds = 0; ds < 4; ++ds) { const u32x4 w = *(const u32x4*)(qp + ds * 16); float v[8];
#pragma unroll
          for (int j = 0; j < 4; ++j) { v[2 * j] = bflo(w[j]); v[2 * j + 1] = bfhi(w[j]); }
          if (ds == 0) {
#pragma unroll
              for (int j = 0; j < 8; ++j) { const float p = __shfl_xor(v[j], 32); v[j] = v[j] * rp[2 * j] + sg * p * rp[2 * j + 1]; } }
          u32x4 o = (u32x4){pk2(v[0] * 0.125f, v[1] * 0.125f), pk2(v[2] * 0.125f, v[3] * 0.125f), pk2(v[4] * 0.125f, v[5] * 0.125f), pk2(v[6] * 0.125f, v[7] * 0.125f)};
          qf[ds] = __builtin_bit_cast(bf16x8, o); } }
    __syncthreads();
    float m2 = a.in[I_SINK][layer * 4 + hq] * LOG2E, l_own = hi ? 0.f : 1.f;
    f32x16 o0 = {}, o1 = {};
    for (int kt = 0; kt < 9; ++kt) {
        const int wb = q0l + 32 * kt, kpos0 = kbase + wb;
        if (kpos0 < 0 || kpos0 >= SEQ) continue;
        f32x16 s = {};
#pragma unroll
        for (int ds = 0; ds < 4; ++ds) { const bf16x8 kf = *(const bf16x8*)(Ks + (wb + ql) * KS_LD + ds * 16 + hi * 8); s = mfma32(kf, qf[ds], s); }
        float mt = -INFINITY;
#pragma unroll
        for (int r = 0; r < 16; ++r) { const int kin = crow(r, hi); float v = s[r] * LOG2E;
            if (kt == 0 && kin < ql) v = -INFINITY;
            if (kt == 8 && kin > ql) v = -INFINITY;
            s[r] = v; mt = fmaxf(mt, v); }
        mt = fmaxf(mt, __shfl_xor(mt, 32));
        const float mn = fmaxf(m2, mt), alpha = ex2(m2 - mn); m2 = mn;
        float ps = 0.f;
#pragma unroll
        for (int r = 0; r < 16; ++r) { s[r] = ex2(s[r] - mn); ps += s[r]; }
        l_own = l_own * alpha + ps;
#pragma unroll
        for (int r = 0; r < 16; ++r) { o0[r] *= alpha; o1[r] *= alpha; }
        bf16x8 pb[2];
#pragma unroll
        for (int sI = 0; sI < 2; ++sI) { u32x4 w = (u32x4){pk2(s[8 * sI + 0], s[8 * sI + 1]), pk2(s[8 * sI + 2], s[8 * sI + 3]), pk2(s[8 * sI + 4], s[8 * sI + 5]), pk2(s[8 * sI + 6], s[8 * sI + 7])}; pb[sI] = __builtin_bit_cast(bf16x8, w); }
#pragma unroll
        for (int sI = 0; sI < 2; ++sI) {
            const bf16_t* v0 = Vt + (size_t)ql * VT_LD + wb + 16 * sI + 4 * hi;
            const s16x4 a0 = *(const s16x4*)(v0), a1 = *(const s16x4*)(v0 + 8), c0 = *(const s16x4*)(v0 + 32 * VT_LD), c1 = *(const s16x4*)(v0 + 32 * VT_LD + 8);
            o0 = mfma32((bf16x8){a0[0], a0[1], a0[2], a0[3], a1[0], a1[1], a1[2], a1[3]}, pb[sI], o0);
            o1 = mfma32((bf16x8){c0[0], c0[1], c0[2], c0[3], c1[0], c1[1], c1[2], c1[3]}, pb[sI], o1); }
    }
    const float linv = 1.0f / (l_own + __shfl_xor(l_own, 32));
    bf16_t* yp = Y + (size_t)(b * SEQ + qpos) * D + 512 + hq * 64 + 4 * hi;
#pragma unroll
    for (int g4 = 0; g4 < 4; ++g4) {
        u32x2 w0, w1; w0.x = pk2(o0[4 * g4] * linv, o0[4 * g4 + 1] * linv); w0.y = pk2(o0[4 * g4 + 2] * linv, o0[4 * g4 + 3] * linv);
        w1.x = pk2(o1[4 * g4] * linv, o1[4 * g4 + 1] * linv); w1.y = pk2(o1[4 * g4 + 2] * linv, o1[4 * g4 + 3] * linv);
        *(u32x2*)(yp + 8 * g4) = w0; *(u32x2*)(yp + 32 + 8 * g4) = w1; }
    __syncthreads();
}
DEVI void gla_prep(const Args& a, int layer, const bf16_t* hrow0, int h, int t, bool act, float* tot4  , float (&bcum)[16], float& total) {
    const int d = t & 31, dir = (t >> 5) & 1, seg = t >> 6;
    const float bu = a.in[I_BUP][(size_t)layer * 256 + dir * 128 + h * 32 + d];
    float lg[16];
    const bf16_t* zp = hrow0 + (size_t)(seg * 16) * NHB + C_Z + dir * 128 + h * 32 + d;
#pragma unroll
    for (int jj = 0; jj < 16; ++jj) lg[jj] = act ? logsigf_(bf2f(zp[(size_t)jj * NHB]) + bu) * (1.f / 16.f) : 0.f;
    float acc = 0.f;
    if (dir == 0) {
#pragma unroll
        for (int jj = 0; jj < 16; ++jj) { acc += lg[jj]; bcum[jj] = acc; } }
    else {
#pragma unroll
        for (int jj = 15; jj >= 0; --jj) { acc += lg[jj]; bcum[jj] = acc; } }
    tot4[seg * 64 + dir * 32 + d] = acc;
    __syncthreads();
    const float t0 = tot4[dir * 32 + d], t1 = tot4[64 + dir * 32 + d], t2 = tot4[128 + dir * 32 + d], t3 = tot4[192 + dir * 32 + d];
    total = (t0 + t1) + (t2 + t3);
    float off;
    if (dir == 0) off = (seg > 0 ? t0 : 0.f) + (seg > 1 ? t1 : 0.f) + (seg > 2 ? t2 : 0.f);
    else off = (seg < 3 ? t3 : 0.f) + (seg < 2 ? t2 : 0.f) + (seg < 1 ? t1 : 0.f);
#pragma unroll
    for (int jj = 0; jj < 16; ++jj) bcum[jj] += off;
}
constexpr int GVT_LD = 72, GQ_LD = 40;
DEVI void gla_stage_vt(const bf16_t* hrow0, int h, int t, bool act, bf16_t* Vt) {
    for (int e8 = t; e8 < 512; e8 += 256) { const int j = e8 >> 3, c8 = e8 & 7;
        u32x4 vw = (u32x4){0u, 0u, 0u, 0u}; if (act) vw = *(const u32x4*)(hrow0 + (size_t)j * NHB + C_GV + h * 64 + c8 * 8);
#pragma unroll
        for (int q = 0; q < 4; ++q) { Vt[(c8 * 8 + 2 * q) * GVT_LD + j] = (bf16_t)(vw[q] & 0xffffu); Vt[(c8 * 8 + 2 * q + 1) * GVT_LD + j] = (bf16_t)(vw[q] >> 16); } }
}
constexpr int GX_HALF = 9216 + 9216 + 1024;
DEVI void gla_x_pair(const Args& a, unsigned char* lds, int layer, int pair) {
    const int tid = launder_tid(), lane = tid & 63, wave = rfl(tid >> 6), hf = wave >> 2, t = tid & 255, w4 = wave & 3;
    constexpr int N_GX = BATCH * NCH * 4;
    const int item = pair * 2 + hf; const bool act = item < N_GX; const int it_ = act ? item : 0;
    const int h = it_ & 3, c = (it_ >> 2) % NCH, b = it_ / (4 * NCH);
    const bf16_t* hrow0 = (const bf16_t*)(a.ws + OFF_HB) + (size_t)(b * SEQ + c * 64) * NHB;
    unsigned char* base = lds + hf * GX_HALF;
    bf16_t* Kht = (bf16_t*)base; bf16_t* Vt = (bf16_t*)(base + 9216); float* tot4 = (float*)(base + 18432);
    float bc[16], total;
    gla_stage_vt(hrow0, h, t, act, Vt);
    gla_prep(a, layer, hrow0, h, t, act, tot4, bc, total);
    { const int d = t & 31, dir = (t >> 5) & 1, seg = t >> 6;
      const bf16_t* kp = hrow0 + (size_t)(seg * 16) * NHB + C_GK + h * 32 + d; unsigned w[8];
#pragma unroll
      for (int q = 0; q < 8; ++q) { const float k0 = act ? bf2f(kp[(size_t)(2 * q) * NHB]) : 0.f, k1 = act ? bf2f(kp[(size_t)(2 * q + 1) * NHB]) : 0.f;
          w[q] = pk2(k0 * ex2((total - bc[2 * q]) * LOG2E), k1 * ex2((total - bc[2 * q + 1]) * LOG2E)); }
      u32x4* dst = (u32x4*)(Kht + (dir * 32 + d) * GVT_LD + seg * 16); dst[0] = (u32x4){w[0], w[1], w[2], w[3]}; dst[1] = (u32x4){w[4], w[5], w[6], w[7]};
      if (seg == 0 && act) ((float*)(a.ws + OFF_GD))[((size_t)((b * 4 + h) * 2 + dir) * NCH + c) * 32 + d] = ex2(total * LOG2E); }
    __syncthreads();
    { const int et = w4 & 1, dir = w4 >> 1, r32 = lane & 31, hi = lane >> 5; f32x16 u = {};
#pragma unroll
      for (int ks = 0; ks < 4; ++ks) { const bf16x8 af = *(const bf16x8*)(Vt + (et * 32 + r32) * GVT_LD + ks * 16 + hi * 8), bfr = *(const bf16x8*)(Kht + (dir * 32 + r32) * GVT_LD + ks * 16 + hi * 8); u = mfma32(af, bfr, u); }
      if (act) { float* gu = (float*)(a.ws + OFF_GU) + ((size_t)((b * 4 + h) * 2 + dir) * NCH + c) * 2048;
#pragma unroll
          for (int r = 0; r < 16; ++r) gu[(et * 32 + crow(r, hi)) * 32 + r32] = u[r]; } }
    __syncthreads();
}
DEVI void gla_scan(const Args& a) {
    float* GU = (float*)(a.ws + OFF_GU); const float* GD = (const float*)(a.ws + OFF_GD);
    constexpr int TOTAL = BATCH * 4 * 2 * 2048, UNR = (NCH % 16 == 0) ? 16 : 4;
    const int tid = launder_tid(); if (tid >= 128) return;
    for (int eid = blockIdx.x * 128 + tid; eid < TOTAL; eid += gridDim.x * 128) {
        const int seq = eid >> 11, de = eid & 2047, d = de & 31, dir = seq & 1; float S = 0.f;
        for (int s0 = 0; s0 < NCH; s0 += UNR) { float u[UNR], dc[UNR];
#pragma unroll
            for (int k = 0; k < UNR; ++k) { const int c = dir ? NCH - 1 - (s0 + k) : s0 + k; u[k] = GU[((size_t)seq * NCH + c) * 2048 + de]; dc[k] = GD[((size_t)seq * NCH + c) * 32 + d]; }
#pragma unroll
            for (int k = 0; k < UNR; ++k) { const int c = dir ? NCH - 1 - (s0 + k) : s0 + k; GU[((size_t)seq * NCH + c) * 2048 + de] = S; S = dc[k] * S + u[k]; } }
    }
}
constexpr int GZ_HALF = 10240 + 10240 + 9216 + 10240 + 1024 + 512;
DEVI void gla_z_pair(const Args& a, unsigned char* lds, int layer, int pair) {
    const int tid = launder_tid(), lane = tid & 63, wave = rfl(tid >> 6), hf = wave >> 2, t = tid & 255, w4 = wave & 3;
    constexpr int N_GZ = BATCH * NCH * 4;
    const int item = pair * 2 + hf; const bool act = item < N_GZ; const int it_ = act ? item : 0;
    const int h = it_ & 3, c = (it_ >> 2) % NCH, b = it_ / (4 * NCH);
    const bf16_t* hrow0 = (const bf16_t*)(a.ws + OFF_HB) + (size_t)(b * SEQ + c * 64) * NHB;
    unsigned char* base = lds + hf * GZ_HALF;
    bf16_t* Qs = (bf16_t*)base; bf16_t* Ks = (bf16_t*)(base + 10240); bf16_t* Vt = (bf16_t*)(base + 20480); bf16_t* St = (bf16_t*)(base + 29696);
    float* tot4 = (float*)(base + 39936); float* rsum = (float*)(base + 40960);
    float bc[16], total;
    gla_stage_vt(hrow0, h, t, act, Vt);
    { const float* GU = (const float*)(a.ws + OFF_GU);
      for (int e4 = t; e4 < 1024; e4 += 256) { const int dir = e4 >> 9, ed = (e4 & 511) * 4, e = ed >> 5, d0 = ed & 31;
          f32x4 s = {}; if (act) s = *(const f32x4*)(GU + ((size_t)((b * 4 + h) * 2 + dir) * NCH + c) * 2048 + ed);
          u32x2 w; w.x = pk2(s[0], s[1]); w.y = pk2(s[2], s[3]); *(u32x2*)(St + (dir * 64 + e) * GQ_LD + d0) = w; } }
    gla_prep(a, layer, hrow0, h, t, act, tot4, bc, total);
    { const int d = t & 31, dir = (t >> 5) & 1, seg = t >> 6;
      const bf16_t* qp = hrow0 + (size_t)(seg * 16) * NHB + C_GQ + h * 32 + d; const bf16_t* kp = qp + (C_GK - C_GQ);
#pragma unroll
      for (int jj = 0; jj < 16; ++jj) { const float q = act ? bf2f(qp[(size_t)jj * NHB]) * 0.17677669529663687f : 0.f, k = act ? bf2f(kp[(size_t)jj * NHB]) : 0.f; const float bb = bc[jj] * LOG2E;
          Qs[(dir * 64 + seg * 16 + jj) * GQ_LD + d] = (bf16_t)f2bf(q * ex2(bb)); Ks[(dir * 64 + seg * 16 + jj) * GQ_LD + d] = (bf16_t)f2bf(k * ex2(-bb)); } }
    __syncthreads();
    const int itl = w4 & 1, et = w4 >> 1, r32 = lane & 31, hi = lane >> 5;
    bf16x8 qf[2][2];
#pragma unroll
    for (int dir = 0; dir < 2; ++dir)
#pragma unroll
        for (int ks = 0; ks < 2; ++ks) qf[dir][ks] = *(const bf16x8*)(Qs + (dir * 64 + itl * 32 + r32) * GQ_LD + ks * 16 + hi * 8);
    f32x16 o = {};
#pragma unroll
    for (int jt = 0; jt < 2; ++jt) {
        f32x16 xa = {};
        if (jt == itl) { f32x16 xf = {}, xb = {};
#pragma unroll
            for (int ks = 0; ks < 2; ++ks) { xf = mfma32(*(const bf16x8*)(Ks + (jt * 32 + r32) * GQ_LD + ks * 16 + hi * 8), qf[0][ks], xf);
                                             xb = mfma32(*(const bf16x8*)(Ks + (64 + jt * 32 + r32) * GQ_LD + ks * 16 + hi * 8), qf[1][ks], xb); }
#pragma unroll
            for (int r = 0; r < 16; ++r) { const int jl = crow(r, hi); xa[r] = (jl <= r32 ? xf[r] : 0.f) + (jl >= r32 ? xb[r] : 0.f); } }
        else { const int dir = jt < itl ? 0 : 1;
#pragma unroll
            for (int ks = 0; ks < 2; ++ks) xa = mfma32(*(const bf16x8*)(Ks + (dir * 64 + jt * 32 + r32) * GQ_LD + ks * 16 + hi * 8), qf[dir][ks], xa); }
#pragma unroll
        for (int s = 0; s < 2; ++s) { const u32x4 w = (u32x4){pk2(xa[8 * s + 0], xa[8 * s + 1]), pk2(xa[8 * s + 2], xa[8 * s + 3]), pk2(xa[8 * s + 4], xa[8 * s + 5]), pk2(xa[8 * s + 6], xa[8 * s + 7])};
            const bf16_t* vp = Vt + (et * 32 + r32) * GVT_LD + jt * 32 + 16 * s + 4 * hi; const s16x4 a0 = *(const s16x4*)vp, a1 = *(const s16x4*)(vp + 8);
            o = mfma32((bf16x8){a0[0], a0[1], a0[2], a0[3], a1[0], a1[1], a1[2], a1[3]}, __builtin_bit_cast(bf16x8, w), o); } }
#pragma unroll
    for (int dir = 0; dir < 2; ++dir)
#pragma unroll
        for (int ks = 0; ks < 2; ++ks) o = mfma32(*(const bf16x8*)(St + (dir * 64 + et * 32 + r32) * GQ_LD + ks * 16 + hi * 8), qf[dir][ks], o);
    float ss = 0.f;
#pragma unroll
    for (int r = 0; r < 16; ++r) ss += o[r] * o[r];
    ss += __shfl_xor(ss, 32);
    if (hi == 0) rsum[et * 64 + itl * 32 + r32] = ss;
    __syncthreads();
    if (act) { const int il = itl * 32 + r32; const float rstd = rsqf_((rsum[il] + rsum[64 + il]) * (1.f / 64.f) + EPS);
        const bf16_t* grp = hrow0 + (size_t)il * NHB + C_GR + h * 64 + et * 32 + 4 * hi; const float* ngp = a.in[I_GNG] + layer * 256 + h * 64 + et * 32 + 4 * hi;
        bf16_t* yp = (bf16_t*)(a.ws + OFF_Y) + (size_t)(b * SEQ + c * 64 + il) * D + 256 + h * 64 + et * 32 + 4 * hi;
#pragma unroll
        for (int g4 = 0; g4 < 4; ++g4) { const u32x2 gw = *(const u32x2*)(grp + 8 * g4); const f32x4 ng = *(const f32x4*)(ngp + 8 * g4);
            u32x2 w; w.x = pk2(o[4 * g4] * rstd * ng[0] * siluf_(bflo(gw.x)), o[4 * g4 + 1] * rstd * ng[1] * siluf_(bfhi(gw.x)));
            w.y = pk2(o[4 * g4 + 2] * rstd * ng[2] * siluf_(bflo(gw.y)), o[4 * g4 + 3] * rstd * ng[3] * siluf_(bfhi(gw.y)));
            *(u32x2*)(yp + 8 * g4) = w; } }
    __syncthreads();
}
DEVI void phase_mix1(const Args& a, unsigned char* lds, int layer) {
    constexpr int N_ATT = BATCH * 2 * NAB, N_CONV = BATCH * (SEQ / 32), N_POOL = N_CONV, N_GXP = BATCH * NCH * 4 / 2, N_ALL = N_ATT + N_CONV + N_POOL + N_GXP;
    for (int it = blockIdx.x; it < N_ALL; it += gridDim.x) { int r = it;
        if (r < N_ATT) { for (int q_ = 0; q_ < (REP_ITEM == 0 ? 2 : 1); ++q_) attn_item(a, lds, layer, r); continue; } r -= N_ATT;
        if (r < N_CONV) { for (int q_ = 0; q_ < (REP_ITEM == 1 ? 2 : 1); ++q_) conv_item(a, lds, layer, r); continue; } r -= N_CONV;
        if (r < N_POOL) { for (int q_ = 0; q_ < (REP_ITEM == 2 ? 2 : 1); ++q_) pool_item(a, lds, layer, r); continue; } r -= N_POOL;
        for (int q_ = 0; q_ < (REP_ITEM == 3 ? 2 : 1); ++q_) gla_x_pair(a, lds, layer, r); }
}
DEVI void phase_mix3(const Args& a, unsigned char* lds, int layer) {
    constexpr int N_GZP = BATCH * NCH * 4 / 2;
    for (int it = blockIdx.x; it < N_GZP; it += gridDim.x) for (int q_ = 0; q_ < (REP_ITEM == 4 ? 2 : 1); ++q_) gla_z_pair(a, lds, layer, it);
}

namespace pg8 {
constexpr int BM = 256, BK = 64, HALF = 128, HTB = HALF * BK * 2, STAGE_BYTES = 8 * HTB, NXCD = 8, WGM = 8;
DEVI int lds_byte(int r, int c) { const int st = (r >> 4) * 2 + (c >> 5), rr = r & 15, cc = c & 31, ob = rr * 64 + cc * 2; return st * 1024 + (ob ^ (((ob >> 9) & 1) << 5)); }
DEVI void stage_rc(int b, int& R, int& C) { const int st = b / 1024, sb = b % 1024, swz = sb ^ (((sb >> 9) & 1) << 5); R = (st >> 1) * 16 + swz / 64; C = (st & 1) * 32 + (swz % 64) / 2; }
DEVI int perm32(int rho) { const int n = rho >> 4, i = rho & 15; return 8 * (i >> 2) + 4 * n + (i & 3); }
struct Unit { int pm, pn, br; };
struct Gemm { const bf16_t* A; const bf16_t* Bt; int K, lda, ldb; size_t a_br, b_br; };
struct StaticOrder {
    int nM, nN, nwg, G, c;
    DEVM void init(int Mr, int N, int G_, int c_) { nM = Mr / BM; nN = N / BM; nwg = nM * nN; G = G_; c = c_; }
    DEVM bool tile(long L, Unit& u) const {
        if (L >= nwg) return false;
        int wgid = (int)L; { const int q = nwg / NXCD, r = nwg % NXCD, xcd = wgid % NXCD, off = wgid / NXCD; wgid = (xcd < r ? xcd * (q + 1) : r * (q + 1) + (xcd - r) * q) + off; }
        const int nig = WGM * nN, gid = wgid / nig, fm = gid * WGM, gsz = (nM - fm) < WGM ? (nM - fm) : WGM;
        u.pm = fm + ((wgid % nig) % gsz); u.pn = (wgid % nig) / gsz; u.br = 0; return true;
    }
    DEVM bool next(int i, Unit& u) const { return tile((long)i * G + c, u); }
};
struct BranchOrder : StaticOrder {
    DEVM bool next(int i, Unit& u) const { if (!tile((long)(i >> 2) * G + c, u)) return false; u.br = i & 3; return true; }
};
template <int ACT  > struct EpiBf16 {
    static constexpr bool PERM = true;
    bf16_t* O; int ldc;
    DEVM void operator()(const f32x4 (&acc)[2][2][4][2], const Unit& u, int wr, int wc, int fr, int fq) const {
        const int row0 = u.pm * BM + wr * 64 + fr, col0 = u.pn * BM + wc * 32 + 8 * fq;
#pragma unroll
        for (int ai = 0; ai < 2; ++ai)
#pragma unroll
            for (int m = 0; m < 4; ++m) { bf16_t* rowp = O + (size_t)(row0 + ai * HALF + m * 16) * ldc + col0;
#pragma unroll
                for (int bj = 0; bj < 2; ++bj) { f32x4 v0 = acc[ai][bj][m][0], v1 = acc[ai][bj][m][1];
                    if (ACT == 1) {
#pragma unroll
                        for (int q = 0; q < 4; ++q) { v0[q] = sigmoidf_(v0[q]); v1[q] = sigmoidf_(v1[q]); } }
                    if (ACT == 2) {
#pragma unroll
                        for (int q = 0; q < 4; ++q) { const float r0 = fmaxf(v0[q], 0.f), r1 = fmaxf(v1[q], 0.f); v0[q] = r0 * r0; v1[q] = r1 * r1; } }
                    u32x4 w; w.x = pk2(v0[0], v0[1]); w.y = pk2(v0[2], v0[3]); w.z = pk2(v1[0], v1[1]); w.w = pk2(v1[2], v1[3]);
                    *(u32x4*)(rowp + bj * HALF) = w; } }
    }
};
struct EpiMerge {
    static constexpr bool PERM = true;
    bf16_t* O; const bf16_t* G;
    DEVM void operator()(const f32x4 (&acc)[2][2][4][2], const Unit& u, int wr, int wc, int fr, int fq) const {
        const int row0 = u.pm * BM + wr * 64 + fr, col0 = u.pn * BM + wc * 32 + 8 * fq;
#pragma unroll
        for (int ai = 0; ai < 2; ++ai)
#pragma unroll
            for (int m = 0; m < 4; ++m) { const size_t row = (size_t)(row0 + ai * HALF + m * 16); bf16_t* rowp = O + row * D + col0; const bf16_t* gp = G + row * NGATE + u.br * D + col0;
#pragma unroll
                for (int bj = 0; bj < 2; ++bj) { const f32x4 v0 = acc[ai][bj][m][0], v1 = acc[ai][bj][m][1];
                    const u32x4 gw = *(const u32x4*)(gp + bj * HALF);
                    float o[8] = {v0[0] * bflo(gw.x), v0[1] * bfhi(gw.x), v0[2] * bflo(gw.y), v0[3] * bfhi(gw.y), v1[0] * bflo(gw.z), v1[1] * bfhi(gw.z), v1[2] * bflo(gw.w), v1[3] * bfhi(gw.w)};
                    if (u.br != 0) { const u32x4 pw = *(const u32x4*)(rowp + bj * HALF);
                        o[0] += bflo(pw.x); o[1] += bfhi(pw.x); o[2] += bflo(pw.y); o[3] += bfhi(pw.y); o[4] += bflo(pw.z); o[5] += bfhi(pw.z); o[6] += bflo(pw.w); o[7] += bfhi(pw.w); }
                    u32x4 w; w.x = pk2(o[0], o[1]); w.y = pk2(o[2], o[3]); w.z = pk2(o[4], o[5]); w.w = pk2(o[6], o[7]);
                    *(u32x4*)(rowp + bj * HALF) = w; }
#ifndef CPU_EMU
                asm volatile("" ::: "memory");
#endif
            }
    }
};
struct EpiResF32 {
    static constexpr bool PERM = false;
    const float* base; float* out;
    DEVM void operator()(const f32x4 (&acc)[2][2][4][2], const Unit& u, int wr, int wc, int fr, int fq) const {
        const int row0 = u.pm * BM + wr * 64 + fr, col0 = u.pn * BM + wc * 32 + 4 * fq;
#pragma unroll
        for (int ai = 0; ai < 2; ++ai)
#pragma unroll
            for (int m = 0; m < 4; ++m) { const size_t off = (size_t)(row0 + ai * HALF + m * 16) * D + col0;
#pragma unroll
                for (int bj = 0; bj < 2; ++bj)
#pragma unroll
                    for (int n = 0; n < 2; ++n) { const f32x4 bs = *(const f32x4*)(base + off + bj * HALF + n * 16); *(f32x4*)(out + off + bj * HALF + n * 16) = bs + acc[ai][bj][m][n]; } }
    }
};
#ifndef CPU_EMU
#define PG8_LAS __attribute__((address_space(3)))
template <class Epi, class Sched, bool ALIGN_EPI = true>
__device__ __forceinline__ void gemm_phase(PG8_LAS unsigned char* lds, const Gemm g, const Sched& S, const Epi& E) {
    int tid_ = threadIdx.x; asm volatile("" : "+v"(tid_));
    const int tid = tid_, wid = __builtin_amdgcn_readfirstlane(tid >> 6), lane = tid & 63, wr = wid >> 2, wc = wid & 3, fr = lane & 15, fq = lane >> 4;
    const int K = g.K, nt = K / BK;
    unsigned voffA[2], voffB[2];
#pragma unroll
    for (int i = 0; i < 2; ++i) { int R, C; stage_rc(tid * 16 + i * 8192, R, C); const int Rb = Epi::PERM ? ((R & ~31) + perm32(R & 31)) : R;
        voffA[i] = (unsigned)(R * g.lda + C) * 2u; voffB[i] = (unsigned)(Rb * g.ldb + C) * 2u; }
    const size_t kstep = (size_t)(BK * 2);
    const size_t hstepA = (size_t)HALF * g.lda * 2, hstepB = (size_t)HALF * g.ldb * 2;
    const size_t tstepA = 2 * hstepA, tstepB = 2 * hstepB;
    const unsigned ldsw = (unsigned)wid * 1024u;
    const int aoff = lds_byte(wr * 64 + fr, fq * 8), boff = lds_byte(wc * 32 + fr, fq * 8);
#define PG8_SA(b, h) (((b) * 2 + (h)) * HTB)
#define PG8_SB(b, h) ((4 + (b) * 2 + (h)) * HTB)
#define PG8_STAGE(bufoff, gbase, voff) do { _Pragma("unroll") for (int _i = 0; _i < 2; ++_i) \
        __builtin_amdgcn_global_load_lds((const unsigned*)((const char*)(gbase) + (voff)[_i]), (PG8_LAS unsigned*)(lds + (bufoff) + ldsw + _i * 8192), 16, 0, 0); } while (0)
#define PG8_LDA(dst, b, h) do { _Pragma("unroll") for (int m = 0; m < 4; ++m) _Pragma("unroll") for (int k = 0; k < 2; ++k) dst[m][k] = *(const PG8_LAS bf16x8*)(lds + PG8_SA(b, h) + aoff + m * 2048 + k * 1024); } while (0)
#define PG8_LDB(dst, b, h) do { _Pragma("unroll") for (int n = 0; n < 2; ++n) _Pragma("unroll") for (int k = 0; k < 2; ++k) dst[n][k] = *(const PG8_LAS bf16x8*)(lds + PG8_SB(b, h) + boff + n * 2048 + k * 1024); } while (0)
#define PG8_MMA(ai, bj, At, Bt) do { __builtin_amdgcn_s_setprio(1); _Pragma("unroll") for (int m = 0; m < 4; ++m) _Pragma("unroll") for (int n = 0; n < 2; ++n) _Pragma("unroll") for (int k = 0; k < 2; ++k) \
        acc[ai][bj][m][n] = __builtin_amdgcn_mfma_f32_16x16x32_bf16(Bt[n][k], At[m][k], acc[ai][bj][m][n], 0, 0, 0); __builtin_amdgcn_s_setprio(0); } while (0)
#define PG8_WAIT_V(n) asm volatile("s_waitcnt vmcnt(" #n ")" ::: "memory")
#define PG8_WAIT_L(n) asm volatile("s_waitcnt lgkmcnt(" #n ")" ::: "memory")
#define PG8_BAR __builtin_amdgcn_s_barrier()
#define PG8_SCHED __builtin_amdgcn_sched_barrier(0)
#define PG8_ABASE(u) ((const char*)(g.A + (size_t)(u).br * g.a_br) + (size_t)(u).pm * tstepA)
#define PG8_BBASE(u) ((const char*)(g.Bt + (size_t)(u).br * g.b_br) + (size_t)(u).pn * tstepB)
    Unit cur, nxt; int ui = 0;
    if (!S.next(0, cur)) return;
    f32x4 acc[2][2][4][2];
#pragma unroll
    for (int a = 0; a < 2; ++a)
#pragma unroll
        for (int b = 0; b < 2; ++b)
#pragma unroll
            for (int m = 0; m < 4; ++m)
#pragma unroll
                for (int n = 0; n < 2; ++n) acc[a][b][m][n] = (f32x4){0.f, 0.f, 0.f, 0.f};
    bf16x8 At[4][2], B0[2][2], B1[2][2];
    const char* cA = PG8_ABASE(cur); const char* cB = PG8_BBASE(cur);
    PG8_STAGE(PG8_SB(0, 0), cB, voffB); PG8_STAGE(PG8_SB(0, 1), cB + hstepB, voffB); PG8_STAGE(PG8_SA(0, 0), cA, voffA); PG8_STAGE(PG8_SA(0, 1), cA + hstepA, voffA);
    if (wr == 1) PG8_BAR;
    PG8_WAIT_V(2); PG8_BAR;
    PG8_STAGE(PG8_SB(1, 0), cB + kstep, voffB); PG8_STAGE(PG8_SA(1, 0), cA + kstep, voffA); PG8_STAGE(PG8_SB(1, 1), cB + hstepB + kstep, voffB);
    PG8_WAIT_V(6); PG8_BAR;
    for (;;) {
        const bool has_next = S.next(ui + 1, nxt);
        const char* nA = has_next ? PG8_ABASE(nxt) : cA; const char* nB = has_next ? PG8_BBASE(nxt) : cB;
#pragma nounroll
        for (int t = 0; t < nt; t += 2) {
            const bool last = (t == nt - 2);
            const char* a1 = cA + (size_t)(t + 1) * kstep;
            const char* a2 = last ? nA : cA + (size_t)(t + 2) * kstep; const char* b2 = last ? nB : cB + (size_t)(t + 2) * kstep;
            const char* a3 = a2 + kstep; const char* b3 = b2 + kstep;
            PG8_LDB(B0, 0, 0); PG8_LDB(B1, 0, 1); PG8_SCHED; PG8_LDA(At, 0, 0); PG8_STAGE(PG8_SA(1, 1), a1 + hstepA, voffA);
            PG8_WAIT_V(8); PG8_WAIT_L(0); PG8_BAR; PG8_MMA(0, 0, At, B0); PG8_MMA(0, 1, At, B1); PG8_BAR; PG8_SCHED;
            PG8_LDA(At, 0, 1); PG8_STAGE(PG8_SB(0, 0), b2, voffB); PG8_STAGE(PG8_SB(0, 1), b2 + hstepB, voffB); PG8_STAGE(PG8_SA(0, 0), a2, voffA);
            PG8_WAIT_V(8); PG8_WAIT_L(0); PG8_BAR; PG8_MMA(1, 0, At, B0); PG8_MMA(1, 1, At, B1); PG8_BAR; PG8_SCHED;
            PG8_LDB(B0, 1, 0); PG8_LDB(B1, 1, 1); PG8_SCHED; PG8_LDA(At, 1, 0); PG8_STAGE(PG8_SA(0, 1), a2 + hstepA, voffA);
            PG8_WAIT_V(8); PG8_WAIT_L(0); PG8_BAR; PG8_MMA(0, 0, At, B0); PG8_MMA(0, 1, At, B1); PG8_BAR; PG8_SCHED;
            PG8_LDA(At, 1, 1); PG8_STAGE(PG8_SB(1, 0), b3, voffB); PG8_STAGE(PG8_SB(1, 1), b3 + hstepB, voffB); PG8_STAGE(PG8_SA(1, 0), a3, voffA);
            PG8_WAIT_V(8); PG8_WAIT_L(0); PG8_BAR; PG8_MMA(1, 0, At, B0); PG8_MMA(1, 1, At, B1); PG8_BAR; PG8_SCHED;
        }
        if constexpr (ALIGN_EPI) { if (wr == 0) PG8_BAR; }
        E(acc, cur, wr, wc, fr, fq);
        if (!has_next) break;
#pragma unroll
        for (int a = 0; a < 2; ++a)
#pragma unroll
            for (int b = 0; b < 2; ++b)
#pragma unroll
                for (int m = 0; m < 4; ++m)
#pragma unroll
                    for (int n = 0; n < 2; ++n) acc[a][b][m][n] = (f32x4){0.f, 0.f, 0.f, 0.f};
        cur = nxt; cA = nA; cB = nB; ++ui;
        if constexpr (ALIGN_EPI) { if (wr == 1) PG8_BAR; }
    }
    PG8_WAIT_V(0);
    if constexpr (!ALIGN_EPI) { if (wr == 0) PG8_BAR; }
    PG8_BAR;
#undef PG8_SA
#undef PG8_SB
#undef PG8_STAGE
#undef PG8_LDA
#undef PG8_LDB
#undef PG8_MMA
#undef PG8_WAIT_V
#undef PG8_WAIT_L
#undef PG8_BAR
#undef PG8_SCHED
#undef PG8_ABASE
#undef PG8_BBASE
}
#endif
}

#ifndef CPU_EMU
#define LAS __attribute__((address_space(3)))
#define XB_TMO      128
#define XB_XCNT(j)  (256  + 64 * (j))
#define XB_XSUB(j)  (1280 + 64 * (j))
#define XB_XGEN(j)  (2304 + 64 * (j))
#define XB_TOP      3328
#define XB_TOPGEN   3392
#define XCD_BAR_WORDS 3456
#define XB_SPIN_CAP (1u << 20)
__device__ __forceinline__ unsigned xb_ld(unsigned* p)              { return __hip_atomic_load(p, __ATOMIC_RELAXED, __HIP_MEMORY_SCOPE_AGENT); }
__device__ __forceinline__ unsigned xb_add(unsigned* p, unsigned v) { return __hip_atomic_fetch_add(p, v, __ATOMIC_RELAXED, __HIP_MEMORY_SCOPE_AGENT); }
__device__ __forceinline__ unsigned xb_xcc_id() { return (unsigned)__builtin_amdgcn_s_getreg((3 << 11) | 20) & 0xFu; }
#define XB_SPIN(cond, bar) do { unsigned _sp = 0; while (cond) { __builtin_amdgcn_s_sleep(1); \
    if ((++_sp & 255u) == 0u) { if (xb_ld(&(bar)[XB_TMO])) break; if (_sp > XB_SPIN_CAP) { atomicAdd(&(bar)[XB_TMO], 1u); break; } } } } while (0)
struct XcdBarrier { unsigned* bar; unsigned x; volatile LAS unsigned* st; };
__device__ __forceinline__ XcdBarrier xcd_barrier_post(unsigned* bar, volatile LAS unsigned* st) {
    XcdBarrier b; b.bar = bar; b.x = xb_xcc_id(); b.st = st;
    if (threadIdx.x == 0) (void)xb_add(&bar[XB_XCNT(b.x)], 1u);
    return b;
}
__device__ __forceinline__ void xcd_barrier_complete(unsigned* bar, unsigned x, unsigned& nloc, unsigned& nx) {
    const unsigned G = gridDim.x * gridDim.y * gridDim.z;
    unsigned sum, cnt, mine, sp = 0u;
    for (;;) {
        sum = 0u; cnt = 0u; mine = 0u;
#pragma unroll
        for (unsigned j = 0; j < 16; ++j) { const unsigned c = xb_ld(&bar[XB_XCNT(j)]); sum += c; cnt += (c > 0u) ? 1u : 0u; mine = (j == x) ? c : mine; }
        if (sum == G) break;
        __builtin_amdgcn_s_sleep(1);
        if ((++sp & 255u) == 0u) { if (xb_ld(&bar[XB_TMO])) break; if (sp > XB_SPIN_CAP) { atomicAdd(&bar[XB_TMO], 1u); break; } }
    }
    nloc = mine > 0u ? mine : 1u; nx = cnt > 0u ? cnt : 1u;
}
__device__ __forceinline__ void xcd_barrier(const XcdBarrier& b) {
    asm volatile("s_waitcnt vmcnt(0)" ::: "memory");
    __syncthreads();
    if (threadIdx.x == 0) {
        unsigned* bar = b.bar;
        __builtin_amdgcn_s_waitcnt(0);
        unsigned nloc = b.st[0], nx = b.st[1];
        if (nloc == 0u) { xcd_barrier_complete(bar, b.x, nloc, nx); b.st[0] = nloc; b.st[1] = nx; }
        const unsigned old = xb_add(&bar[XB_XSUB(b.x)], 1u);
        const unsigned gen = old / nloc;
        if (old + 1u == (gen + 1u) * nloc) {
            __builtin_amdgcn_fence(__ATOMIC_RELEASE, "agent");
            asm volatile("s_waitcnt vmcnt(0)" ::: "memory");
            const unsigned og = xb_add(&bar[XB_TOP], 1u);
            const unsigned tg = og / nx;
            if (og + 1u == (tg + 1u) * nx) xb_add(&bar[XB_TOPGEN], 1u);
            else XB_SPIN(xb_ld(&bar[XB_TOPGEN]) == tg, bar);
            __builtin_amdgcn_fence(__ATOMIC_ACQUIRE, "agent");
            xb_add(&bar[XB_XGEN(b.x)], 1u);
            asm volatile("s_waitcnt vmcnt(0)" ::: "memory");
        } else {
            XB_SPIN(xb_ld(&bar[XB_XGEN(b.x)]) == gen, bar);
            __builtin_amdgcn_fence(__ATOMIC_ACQUIRE, "agent");
            asm volatile("s_waitcnt vmcnt(0)" ::: "memory");
        }
    }
    __syncthreads();
}
constexpr int LDS_BYTES = 147456;
constexpr int LDSCTL_OFF = 131072 + 320;
__global__ void __launch_bounds__(NTHREADS, 2) mega_fwd(Args a) {
    extern __shared__ __attribute__((aligned(16))) unsigned char lds[];
    __attribute__((address_space(3))) unsigned char* lds3 = (__attribute__((address_space(3))) unsigned char*)lds;
    unsigned char* ws = a.ws;
    bf16_t* XN = (bf16_t*)(ws + OFF_XN); bf16_t* Yb = (bf16_t*)(ws + OFF_Y); bf16_t* HB = (bf16_t*)(ws + OFF_HB); bf16_t* Gb = (bf16_t*)(ws + OFF_G); bf16_t* UP = (bf16_t*)(ws + OFF_UP);
    const bf16_t* WIN_T = (const bf16_t*)(ws + OFF_WIN); const bf16_t* WBR_T = (const bf16_t*)(ws + OFF_WBR); const bf16_t* WOUT_T = (const bf16_t*)(ws + OFF_WOUT);
    const bf16_t* WUP_T = (const bf16_t*)(ws + OFF_WUP); const bf16_t* WDN_T = (const bf16_t*)(ws + OFF_WDN);
    const int G = gridDim.x, bid = blockIdx.x;
    const int lo = a.ph_lo, hi = a.ph_hi;
    volatile LAS unsigned* MISC = (volatile LAS unsigned*)(lds3 + LDSCTL_OFF);
    if (threadIdx.x < 16) MISC[threadIdx.x] = 0u;
    __syncthreads();
    XcdBarrier bar; bar.bar = (unsigned*)(ws + OFF_CTL) + 4096; bar.x = 0; bar.st = nullptr;
    if (hi - lo > 1) bar = xcd_barrier_post((unsigned*)(ws + OFF_CTL) + 4096, MISC + 8);
#define SEAM(p) do { if (lo <= (p) && (p) + 1 < hi) xcd_barrier(bar); } while (0)
#define IN_PH(p) ((((PH_MASK) >> ((p) % PH_PER_LAYER + ((p) == PH_FINAL ? PH_PER_LAYER : 0))) & 1) && lo <= (p) && (p) < hi)
#pragma unroll
    for (int layer = 0; layer < NLAYER; ++layer) {
        const int pb = layer * PH_PER_LAYER;
        const float* xin = layer == 0 ? a.in[I_X] : a.out;
        for (int rep_ = 0; rep_ < (REP_KIND == PH_WCONV ? 2 : 1); ++rep_) if (IN_PH(pb + PH_WCONV)) phase_wconv(a, lds, layer);
        SEAM(pb + PH_WCONV);
        for (int rep_ = 0; rep_ < (REP_KIND == PH_NORM1 ? 2 : 1); ++rep_) if (IN_PH(pb + PH_NORM1)) phase_rmsnorm_bf16(xin, a.in[I_NMG] + layer * D, XN);
        SEAM(pb + PH_NORM1);
        for (int rep_ = 0; rep_ < (REP_KIND == PH_GEMM_IN ? 2 : 1); ++rep_) if (IN_PH(pb + PH_GEMM_IN)) { pg8::Gemm g{XN, WIN_T, D, D, D, 0, 0}; pg8::StaticOrder S; S.init(M, NHB, G, bid); pg8::EpiBf16<0> E{HB, NHB};
            pg8::gemm_phase<pg8::EpiBf16<0>, pg8::StaticOrder>(lds3, g, S, E); }
        SEAM(pb + PH_GEMM_IN);
        for (int rep_ = 0; rep_ < (REP_KIND == PH_MIX1 ? 2 : 1); ++rep_) if (IN_PH(pb + PH_MIX1)) phase_mix1(a, lds, layer);
        SEAM(pb + PH_MIX1);
        for (int rep_ = 0; rep_ < (REP_KIND == PH_MIX2 ? 2 : 1); ++rep_) if (IN_PH(pb + PH_MIX2)) gla_scan(a);
        SEAM(pb + PH_MIX2);
        for (int rep_ = 0; rep_ < (REP_KIND == PH_MIX3 ? 2 : 1); ++rep_) if (IN_PH(pb + PH_MIX3)) phase_mix3(a, lds, layer);
        SEAM(pb + PH_MIX3);
        for (int rep_ = 0; rep_ < (REP_KIND == PH_GEMM_G ? 2 : 1); ++rep_) if (IN_PH(pb + PH_GEMM_G)) { pg8::Gemm g{XN, WIN_T + (size_t)NHB * D, D, D, D, 0, 0}; pg8::StaticOrder S; S.init(M, NGATE, G, bid); pg8::EpiBf16<1> E{Gb, NGATE};
            pg8::gemm_phase<pg8::EpiBf16<1>, pg8::StaticOrder>(lds3, g, S, E); }
        SEAM(pb + PH_GEMM_G);
        for (int rep_ = 0; rep_ < (REP_KIND == PH_GEMM_M ? 2 : 1); ++rep_) if (IN_PH(pb + PH_GEMM_M)) { pg8::Gemm g{Yb, WBR_T, 256, D, 256, 256, (size_t)D * 256}; pg8::BranchOrder S; S.init(M, D, G, bid); pg8::EpiMerge E{XN, Gb};
            pg8::gemm_phase<pg8::EpiMerge, pg8::BranchOrder>(lds3, g, S, E); }
        SEAM(pb + PH_GEMM_M);
        for (int rep_ = 0; rep_ < (REP_KIND == PH_GEMM_O ? 2 : 1); ++rep_) if (IN_PH(pb + PH_GEMM_O)) { pg8::Gemm g{XN, WOUT_T, D, D, D, 0, 0}; pg8::StaticOrder S; S.init(M, D, G, bid); pg8::EpiResF32 E{xin, a.out};
            pg8::gemm_phase<pg8::EpiResF32, pg8::StaticOrder>(lds3, g, S, E); }
        SEAM(pb + PH_GEMM_O);
        for (int rep_ = 0; rep_ < (REP_KIND == PH_NORM2 ? 2 : 1); ++rep_) if (IN_PH(pb + PH_NORM2)) phase_rmsnorm_bf16(a.out, a.in[I_NFG] + layer * D, XN);
        SEAM(pb + PH_NORM2);
        for (int rep_ = 0; rep_ < (REP_KIND == PH_GEMM_U ? 2 : 1); ++rep_) if (IN_PH(pb + PH_GEMM_U)) { pg8::Gemm g{XN, WUP_T, D, D, D, 0, 0}; pg8::StaticOrder S; S.init(M, DFF, G, bid); pg8::EpiBf16<2> E{UP, DFF};
            pg8::gemm_phase<pg8::EpiBf16<2>, pg8::StaticOrder>(lds3, g, S, E); }
        SEAM(pb + PH_GEMM_U);
        for (int rep_ = 0; rep_ < (REP_KIND == PH_GEMM_D ? 2 : 1); ++rep_) if (IN_PH(pb + PH_GEMM_D)) { pg8::Gemm g{UP, WDN_T, DFF, DFF, DFF, 0, 0}; pg8::StaticOrder S; S.init(M, D, G, bid); pg8::EpiResF32 E{a.out, a.out};
            pg8::gemm_phase<pg8::EpiResF32, pg8::StaticOrder>(lds3, g, S, E); }
        SEAM(pb + PH_GEMM_D);
    }
    if (IN_PH(PH_FINAL)) phase_rmsnorm_f32_inplace(a.out, a.in[I_FNG]);
#undef IN_PH
#undef SEAM
}

extern "C" void kernel_launch(void* const* d_in, const int* in_sizes, int n_in, void* d_out, int out_size, void* d_ws, size_t ws_size, hipStream_t stream) {
    static int grid = 0;
    if (grid == 0) {
        if (n_in != N_INPUTS || out_size != M * D || ws_size < WS_END) { fprintf(stderr, "kernel_launch: unexpected shapes (n_in %d out %d ws %zu)\n", n_in, out_size, ws_size); grid = -1; return; }
        int dev = 0, cus = 0;
        if (hipGetDevice(&dev) != hipSuccess || hipDeviceGetAttribute(&cus, hipDeviceAttributeMultiprocessorCount, dev) != hipSuccess) { grid = -1; return; }
        if (hipFuncSetAttribute((const void*)mega_fwd, hipFuncAttributeMaxDynamicSharedMemorySize, LDS_BYTES) != hipSuccess) { fprintf(stderr, "kernel_launch: hipFuncSetAttribute failed\n"); grid = -1; return; }
        grid = cus;
    }
    if (grid < 0) return;
    Args a{};
    for (int i = 0; i < N_INPUTS; ++i) a.in[i] = (const float*)d_in[i];
    a.out = (float*)d_out; a.ws = (unsigned char*)d_ws;
#if N_LAUNCH_MODE == 0
    for (int ph = 0; ph < N_PHASES; ++ph) { a.ph_lo = ph; a.ph_hi = ph + 1; hipLaunchKernelGGL(mega_fwd, dim3(grid), dim3(NTHREADS), LDS_BYTES, stream, a); }
#else
    if (hipMemsetAsync((char*)d_ws + OFF_CTL, 0, 65536, stream) != hipSuccess) { fprintf(stderr, "kernel_launch: memset failed\n"); return; }
    a.ph_lo = 0; a.ph_hi = N_PHASES;
    hipLaunchKernelGGL(mega_fwd, dim3(grid), dim3(NTHREADS), LDS_BYTES, stream, a);
#endif
}
#endif
```

```cpp
#ifndef CPU_EMU
#include <hip/hip_runtime.h>
#include <cstdio>
#include <cstdint>
#endif
#ifndef SEQ_T
#define SEQ_T 8192
#endif
#ifndef PH_MASK
#define PH_MASK 0xffff
#endif
#ifndef REP_ITEM
#define REP_ITEM -1
#endif
#ifndef REP_KIND
#define REP_KIND -1
#endif
#ifndef N_LAUNCH_MODE
#define N_LAUNCH_MODE 1
#endif

typedef unsigned short bf16_t;
typedef short bf16x8 __attribute__((ext_vector_type(8)));
typedef short s16x4 __attribute__((ext_vector_type(4)));
typedef float f32x4 __attribute__((ext_vector_type(4)));
typedef float f32x16 __attribute__((ext_vector_type(16)));
typedef unsigned u32x4 __attribute__((ext_vector_type(4)));
typedef unsigned u32x2 __attribute__((ext_vector_type(2)));
#ifdef CPU_EMU
#define DEVI static inline
#define DEVM inline
DEVI float ex2(float x) { return exp2f(x); }
DEVI float lg2(float x) { return log2f(x); }
DEVI float rcpf_(float x) { return 1.0f / x; }
DEVI float rsqf_(float x) { return 1.0f / sqrtf(x); }
DEVI f32x16 mfma32(bf16x8 a, bf16x8 b, f32x16 c) { return emu_mfma32(a, b, c); }
DEVI void wave_sync() { emu_wave->bar.wait(); }
DEVI int rfl(int x) { return x; }
#else
#define DEVI __device__ __forceinline__
#define DEVM __device__ __forceinline__
DEVI float ex2(float x) { return __builtin_amdgcn_exp2f(x); }
DEVI float lg2(float x) { return __builtin_amdgcn_logf(x); }
DEVI float rcpf_(float x) { return __builtin_amdgcn_rcpf(x); }
DEVI float rsqf_(float x) { return __builtin_amdgcn_rsqf(x); }
DEVI f32x16 mfma32(bf16x8 a, bf16x8 b, f32x16 c) { return __builtin_amdgcn_mfma_f32_32x32x16_bf16(a, b, c, 0, 0, 0); }
DEVI void wave_sync() { asm volatile("s_waitcnt lgkmcnt(0)" ::: "memory"); }
DEVI int rfl(int x) { return __builtin_amdgcn_readfirstlane(x); }
#endif
#ifdef CPU_EMU
DEVI int launder_tid() { return (int)threadIdx.x; }
#else
DEVI int launder_tid() { int t = threadIdx.x; asm volatile("" : "+v"(t)); return t; }
#endif
DEVI unsigned f2bf(float f) { unsigned u = __builtin_bit_cast(unsigned, f); return (u + 0x7fffu + ((u >> 16) & 1u)) >> 16; }
DEVI unsigned pk2(float lo, float hi) { return f2bf(lo) | (f2bf(hi) << 16); }
DEVI float bf2f(unsigned h) { return __builtin_bit_cast(float, h << 16); }
DEVI float bflo(unsigned w) { return __builtin_bit_cast(float, w << 16); }
DEVI float bfhi(unsigned w) { return __builtin_bit_cast(float, w & 0xffff0000u); }
struct pg8_unit_fwd { int pm, pn, br, ui; };
constexpr float LOG2E = 1.4426950408889634f, LN2 = 0.6931471805599453f;
DEVI float sigmoidf_(float x) { return rcpf_(1.0f + ex2(-x * LOG2E)); }
DEVI float siluf_(float x) { return x * sigmoidf_(x); }
DEVI float logsigf_(float z) { const float a = fabsf(z); return fminf(z, 0.f) - LN2 * lg2(1.0f + ex2(-a * LOG2E)); }
DEVI float wave_sum(float v) {
#pragma unroll
    for (int o = 1; o < 64; o <<= 1) v += __shfl_xor(v, o);
    return v;
}

constexpr int BATCH = 2, SEQ = SEQ_T, M = BATCH * SEQ, D = 1024, DFF = 4096, NLAYER = 2;
constexpr int DIN_SRC = 6176;
constexpr int NHB = 2304, NGATE = 4096, NIN = NHB + NGATE;
constexpr int C_GLUA = 0, C_GLUG = 256, C_GQ = 512, C_GK = 640, C_GV = 768, C_GR = 1024, C_Z = 1280, C_AQ = 1536, C_AK = 1792, C_AV = 1920, C_PIN = 2048;
constexpr int SRC_GLR = 1280;
constexpr int NCH = SEQ / 64;
constexpr int NAB = SEQ / 128;
constexpr float EPS = 1e-6f;
constexpr int NTHREADS = 512, NWAVES = 8;
enum { I_X = 0, I_NMG, I_WIN, I_CW, I_CB, I_CLG, I_CLB, I_WUP, I_BUP, I_GNG, I_SINK, I_PW, I_PS, I_WBR, I_WOUT, I_NFG, I_WFU, I_WFD, I_FNG, N_INPUTS };
constexpr size_t al256(size_t x) { return (x + 255) & ~(size_t)255; }
constexpr size_t OFF_CTL = 0, CTL_BYTES = 1u << 20;
constexpr size_t SZ_WIN = (size_t)NIN * D * 2, SZ_WBR = (size_t)4 * D * 256 * 2, SZ_WOUT = (size_t)D * D * 2, SZ_WUP = (size_t)DFF * D * 2, SZ_WDN = (size_t)D * DFF * 2;
constexpr size_t OFF_WIN = OFF_CTL + CTL_BYTES, OFF_WBR = OFF_WIN + SZ_WIN, OFF_WOUT = OFF_WBR + SZ_WBR, OFF_WUP = OFF_WOUT + SZ_WOUT, OFF_WDN = OFF_WUP + SZ_WUP;
constexpr size_t OFF_ROPE = OFF_WDN + SZ_WDN, SZ_ROPE = al256((size_t)SEQ * 8 * 8);
constexpr size_t OFF_PWT = OFF_ROPE + SZ_ROPE, SZ_PWT = 4 * 64 * 64 * 2;
constexpr size_t OFF_PART = OFF_PWT + SZ_PWT, SZ_PART = al256((size_t)M * 16 * 4);
constexpr size_t OFF_XN = OFF_PART + SZ_PART, SZ_ACT = al256((size_t)M * D * 2);
constexpr size_t OFF_Y = OFF_XN + SZ_ACT;
constexpr size_t OFF_BIG = OFF_Y + SZ_ACT;
constexpr size_t OFF_HB = OFF_BIG, SZ_HB = al256((size_t)M * NHB * 2);
constexpr size_t OFF_GU = OFF_HB + SZ_HB, SZ_GU = al256((size_t)BATCH * 4 * 2 * NCH * 2048 * 4);
constexpr size_t OFF_GD = OFF_GU + SZ_GU, SZ_GD = al256((size_t)BATCH * 4 * 2 * NCH * 32 * 4);
constexpr size_t OFF_G = OFF_BIG, SZ_G = al256((size_t)M * NGATE * 2);
constexpr size_t OFF_UP = OFF_BIG;
constexpr size_t WS_END = OFF_BIG + (SZ_G > SZ_HB + SZ_GU + SZ_GD ? SZ_G : SZ_HB + SZ_GU + SZ_GD);
static_assert(WS_END <= 268435456, "workspace map exceeds 256 MiB");

struct Args { const float* in[N_INPUTS]; float* out; unsigned char* ws; int ph_lo, ph_hi; };
#ifdef CPU_EMU
typedef const Args* KArgs;
#else
typedef const Args __attribute__((address_space(4)))* KArgs;
DEVI KArgs kargs() { KArgs p = (KArgs)__builtin_amdgcn_kernarg_segment_ptr(); asm volatile("" : "+s"(p)); return p; }
#endif

enum { PH_WCONV = 0, PH_GEMM_IN, PH_MIX1, PH_MIX2, PH_MIX3, PH_GEMM_G, PH_GEMM_M, PH_GEMM_O, PH_GEMM_U, PH_GEMM_D, PH_PER_LAYER };
constexpr int PH_FINAL = NLAYER * PH_PER_LAYER, N_PHASES = PH_FINAL + 1;

DEVI void transpose_item(const float* W, int ldw, int K, bf16_t* WT, int k0, int src_n0, int dst_n0, float* scr, int lane, const float* ksc = nullptr  ) {
#pragma unroll 8
    for (int i = 0; i < 32; ++i) { const int kk = 2 * i + (lane >> 5); scr[kk * 33 + (lane & 31)] = W[(size_t)(k0 + kk) * ldw + src_n0 + (lane & 31)]; }
    const int c = lane & 7;
    f32x4 g0 = (f32x4){1.f, 1.f, 1.f, 1.f}, g1 = g0; if (ksc) { g0 = *(const f32x4*)(ksc + k0 + 8 * c); g1 = *(const f32x4*)(ksc + k0 + 8 * c + 4); }
    wave_sync();
#pragma unroll
    for (int j = 0; j < 4; ++j) { const int n = (lane >> 3) + 8 * j; const float* s = scr + (8 * c) * 33 + n;
        u32x4 o; o.x = pk2(s[0 * 33] * g0[0], s[1 * 33] * g0[1]); o.y = pk2(s[2 * 33] * g0[2], s[3 * 33] * g0[3]); o.z = pk2(s[4 * 33] * g1[0], s[5 * 33] * g1[1]); o.w = pk2(s[6 * 33] * g1[2], s[7 * 33] * g1[3]);
        *(u32x4*)(WT + (size_t)(dst_n0 + n) * K + k0 + 8 * c) = o; }
    wave_sync();
}
DEVI void zfold_item(const float* Win, const float* wup, bf16_t* WT, int k0, int zc0  , float* scr, int lane, const float* ksc) {
    const int s = zc0 >> 7, kc = (zc0 & 127) + (lane & 31);
    float wu[16];
#pragma unroll
    for (int r = 0; r < 16; ++r) wu[r] = wup[(s * 16 + r) * 128 + kc];
    for (int i = 0; i < 32; ++i) { const int kk = 2 * i + (lane >> 5); const float* g = Win + (size_t)(k0 + kk) * DIN_SRC + SRC_GLR + s * 16; float a = 0.f;
#pragma unroll
        for (int r = 0; r < 16; ++r) a += g[r] * wu[r];
        scr[kk * 33 + (lane & 31)] = a; }
    const int c = lane & 7;
    const f32x4 g0 = *(const f32x4*)(ksc + k0 + 8 * c), g1 = *(const f32x4*)(ksc + k0 + 8 * c + 4);
    wave_sync();
#pragma unroll
    for (int j = 0; j < 4; ++j) { const int n = (lane >> 3) + 8 * j; const float* sp = scr + (8 * c) * 33 + n;
        u32x4 o; o.x = pk2(sp[0 * 33] * g0[0], sp[1 * 33] * g0[1]); o.y = pk2(sp[2 * 33] * g0[2], sp[3 * 33] * g0[3]); o.z = pk2(sp[4 * 33] * g1[0], sp[5 * 33] * g1[1]); o.w = pk2(sp[6 * 33] * g1[2], sp[7 * 33] * g1[3]);
        *(u32x4*)(WT + (size_t)(C_Z + zc0 + n) * D + k0 + 8 * c) = o; }
    wave_sync();
}
DEVI void rope_entry(int pos, int i, float& c, float& s) {
    const double inv[8] = {1.0, 0.19392274474868576, 0.03760603093086393, 0.007292664737217109, 0.001414213562373095, 0.0002742481756762073, 5.318295896944988e-05, 1.031338537721246e-05};
    double iv = inv[0];
#pragma unroll
    for (int k = 1; k < 8; ++k) iv = (i == k) ? inv[k] : iv;
    double rev = (double)pos * iv * 0.15915494309189535; rev -= __builtin_rint(rev);
    double q4 = rev * 4.0; const double qn = __builtin_rint(q4); const double t = (q4 - qn) * 1.5707963267948966;
    const double t2 = t * t;
    double sp = t * (1.0 + t2 * (-1.0 / 6 + t2 * (1.0 / 120 + t2 * (-1.0 / 5040 + t2 * (1.0 / 362880 + t2 * (-1.0 / 39916800 + t2 * (1.0 / 6227020800.0)))))));
    double cp = 1.0 + t2 * (-0.5 + t2 * (1.0 / 24 + t2 * (-1.0 / 720 + t2 * (1.0 / 40320 + t2 * (-1.0 / 3628800 + t2 * (1.0 / 479001600.0))))));
    const int qi = ((int)qn) & 3;
    const double cs = (qi == 0) ? cp : (qi == 1) ? -sp : (qi == 2) ? -cp : sp;
    const double sn = (qi == 0) ? sp : (qi == 1) ? cp : (qi == 2) ? -sp : -cp;
    c = (float)cs; s = (float)sn;
}
DEVI void phase_wconv(KArgs a, unsigned char* lds, int layer) {
    const int tid = launder_tid(), lane = tid & 63, wave = rfl(tid >> 6);
    float* scr = (float*)(lds + wave * 8448);
    const int gw = blockIdx.x * NWAVES + wave, NGW = gridDim.x * NWAVES;
    const float* Win = a->in[I_WIN] + (size_t)layer * D * DIN_SRC; const float* wup = a->in[I_WUP] + (size_t)layer * 2 * 16 * 128;
    const float* Wbr = a->in[I_WBR] + (size_t)layer * 4 * 256 * D; const float* Wout = a->in[I_WOUT] + (size_t)layer * D * D;
    const float* Wfu = a->in[I_WFU] + (size_t)layer * D * DFF; const float* Wfd = a->in[I_WFD] + (size_t)layer * DFF * D;
    const float* gmix = a->in[I_NMG] + layer * D; const float* gffn = a->in[I_NFG] + layer * D;
    bf16_t* WIN_T = (bf16_t*)(a->ws + OFF_WIN); bf16_t* WBR_T = (bf16_t*)(a->ws + OFF_WBR); bf16_t* WOUT_T = (bf16_t*)(a->ws + OFF_WOUT);
    bf16_t* WUP_T = (bf16_t*)(a->ws + OFF_WUP); bf16_t* WDN_T = (bf16_t*)(a->ws + OFF_WDN);
    constexpr int I_IN = (D / 64) * (NIN / 32), I_BR = 4 * (256 / 64) * (D / 32), I_OUT = (D / 64) * (D / 32), I_UP = (D / 64) * (DFF / 32), I_DN = (DFF / 64) * (D / 32);
    constexpr int NITEMS = I_IN + I_BR + I_OUT + I_UP + I_DN;
    for (int it = gw; it < NITEMS; it += NGW) {
        int r = it;
        if (r < I_IN) { const int nblk = NIN / 32, kb = r / nblk, nb = r % nblk, n0 = nb * 32;
            if (n0 >= C_Z && n0 < C_AQ) zfold_item(Win, wup, WIN_T, kb * 64, n0 - C_Z, scr, lane, gmix);
            else transpose_item(Win, DIN_SRC, D, WIN_T, kb * 64, n0 < C_Z ? n0 : n0 - 224, n0, scr, lane, gmix);
            continue; } r -= I_IN;
        if (r < I_BR) { const int br = r / (I_BR / 4), q = r % (I_BR / 4), nblk = D / 32, kb = q / nblk, nb = q % nblk;
            transpose_item(Wbr + (size_t)br * 256 * D, D, 256, WBR_T + (size_t)br * D * 256, kb * 64, nb * 32, nb * 32, scr, lane); continue; } r -= I_BR;
        if (r < I_OUT) { const int nblk = D / 32, kb = r / nblk, nb = r % nblk; transpose_item(Wout, D, D, WOUT_T, kb * 64, nb * 32, nb * 32, scr, lane); continue; } r -= I_OUT;
        if (r < I_UP) { const int nblk = DFF / 32, kb = r / nblk, nb = r % nblk; transpose_item(Wfu, DFF, D, WUP_T, kb * 64, nb * 32, nb * 32, scr, lane, gffn); continue; } r -= I_UP;
        { const int nblk = D / 32, kb = r / nblk, nb = r % nblk; transpose_item(Wfd, D, DFF, WDN_T, kb * 64, nb * 32, nb * 32, scr, lane); }
    }
    { bf16_t* PWT = (bf16_t*)(a->ws + OFF_PWT); const float* pw = a->in[I_PW] + (size_t)layer * 4 * 64 * 64;
      for (int e = blockIdx.x * NTHREADS + tid; e < 4 * 64 * 64; e += gridDim.x * NTHREADS) { const int g = e >> 12, ee = (e >> 6) & 63, c = e & 63; PWT[e] = (bf16_t)f2bf(pw[(g * 64 + c) * 64 + ee]); } }
    if (layer == 0) { float* rope = (float*)(a->ws + OFF_ROPE);
        for (int e = blockIdx.x * NTHREADS + tid; e < SEQ * 8; e += gridDim.x * NTHREADS) { float c, s; rope_entry(e >> 3, e & 7, c, s); rope[2 * e] = c; rope[2 * e + 1] = s; } }
}

DEVI void phase_x_to_bf16(const float* x, bf16_t* xb, float* part) {
    const int tid = launder_tid(), lane = tid & 63, wave = rfl(tid >> 6);
    const int gw = blockIdx.x * NWAVES + wave, NGW = gridDim.x * NWAVES;
    for (int m = gw; m < M; m += NGW) {
        const f32x4* xr = (const f32x4*)(x + (size_t)m * D) + lane; f32x4 v[4]; float s = 0.f;
#pragma unroll
        for (int j = 0; j < 4; ++j) { v[j] = xr[64 * j]; s += (v[j].x * v[j].x + v[j].y * v[j].y) + (v[j].z * v[j].z + v[j].w * v[j].w); }
        s = wave_sum(s);
        u32x2* o8 = (u32x2*)(xb + (size_t)m * D) + lane;
#pragma unroll
        for (int j = 0; j < 4; ++j) { u32x2 w; w.x = pk2(v[j].x, v[j].y); w.y = pk2(v[j].z, v[j].w); o8[64 * j] = w; }
        if (lane < 16) part[(size_t)m * 16 + lane] = lane == 0 ? s : 0.f;
    }
}
template <class Sched> DEVI void prep_rstd(const Sched& S, const float* part, float* tab) {
    const int tid = launder_tid();
    pg8_unit_fwd u;
    for (int ui = 0; S.next(ui, u); ++ui)
        for (int r = tid; r < 256; r += NTHREADS) { const f32x4* p = (const f32x4*)(part + (size_t)(u.pm * 256 + r) * 16); const f32x4 s = (p[0] + p[1]) + (p[2] + p[3]);
            tab[ui * 256 + r] = rsqf_(((s.x + s.y) + (s.z + s.w)) * (1.f / D) + EPS); }
    __syncthreads();
}
DEVI void phase_rmsnorm_bf16(const float* x, const float* g, bf16_t* out) {
    const int tid = launder_tid(), lane = tid & 63, wave = rfl(tid >> 6);
    const int gw = blockIdx.x * NWAVES + wave, NGW = gridDim.x * NWAVES;
    f32x4 gv[4];
#pragma unroll
    for (int j = 0; j < 4; ++j) gv[j] = *(const f32x4*)(g + 4 * lane + 256 * j);
    for (int m = gw; m < M; m += NGW) {
        const f32x4* xr = (const f32x4*)(x + (size_t)m * D) + lane; f32x4 v[4]; float s = 0.f;
#pragma unroll
        for (int j = 0; j < 4; ++j) { v[j] = xr[64 * j]; s += (v[j].x * v[j].x + v[j].y * v[j].y) + (v[j].z * v[j].z + v[j].w * v[j].w); }
        const float rstd = rsqf_(wave_sum(s) * (1.f / D) + EPS);
        u32x2* o8 = (u32x2*)(out + (size_t)m * D) + lane;
#pragma unroll
        for (int j = 0; j < 4; ++j) { u32x2 w; w.x = pk2(v[j].x * rstd * gv[j].x, v[j].y * rstd * gv[j].y); w.y = pk2(v[j].z * rstd * gv[j].z, v[j].w * rstd * gv[j].w); o8[64 * j] = w; }
    }
}
DEVI void phase_rmsnorm_f32_inplace(float* x, const float* g) {
    const int tid = launder_tid(), lane = tid & 63, wave = rfl(tid >> 6);
    const int gw = blockIdx.x * NWAVES + wave, NGW = gridDim.x * NWAVES;
    f32x4 gv[4];
#pragma unroll
    for (int j = 0; j < 4; ++j) gv[j] = *(const f32x4*)(g + 4 * lane + 256 * j);
    for (int m = gw; m < M; m += NGW) {
        f32x4* xr = (f32x4*)(x + (size_t)m * D) + lane; f32x4 v[4]; float s = 0.f;
#pragma unroll
        for (int j = 0; j < 4; ++j) { v[j] = xr[64 * j]; s += (v[j].x * v[j].x + v[j].y * v[j].y) + (v[j].z * v[j].z + v[j].w * v[j].w); }
        const float rstd = rsqf_(wave_sum(s) * (1.f / D) + EPS);
#pragma unroll
        for (int j = 0; j < 4; ++j) xr[64 * j] = v[j] * rstd * gv[j];
    }
}

DEVI void conv_item(KArgs a, unsigned char* lds, int layer, int item) {
    const int tid = launder_tid(), lane = tid & 63, wave = rfl(tid >> 6), c = tid & 255, hf = tid >> 8;
    const int b = item / (SEQ / 32), t0 = (item % (SEQ / 32)) * 32;
    const bf16_t* HB = (const bf16_t*)(a->ws + OFF_HB); bf16_t* Y = (bf16_t*)(a->ws + OFF_Y);
    float* u = (float*)lds; float* y = u + 62 * 256;
    for (int e = tid; e < 62 * 32; e += NTHREADS) { const int r = e >> 5, c8 = e & 31, t = t0 - 15 + r; f32x4 o0 = {}, o1 = {};
        if (t >= 0 && t < SEQ) { const bf16_t* hp = HB + (size_t)(b * SEQ + t) * NHB + c8 * 8; const u32x4 av = *(const u32x4*)(hp + C_GLUA), gv = *(const u32x4*)(hp + C_GLUG);
            o0 = (f32x4){bflo(av.x) * sigmoidf_(bflo(gv.x)), bfhi(av.x) * sigmoidf_(bfhi(gv.x)), bflo(av.y) * sigmoidf_(bflo(gv.y)), bfhi(av.y) * sigmoidf_(bfhi(gv.y))};
            o1 = (f32x4){bflo(av.z) * sigmoidf_(bflo(gv.z)), bfhi(av.z) * sigmoidf_(bfhi(gv.z)), bflo(av.w) * sigmoidf_(bflo(gv.w)), bfhi(av.w) * sigmoidf_(bfhi(gv.w))}; }
        *(f32x4*)(u + r * 256 + c8 * 8) = o0; *(f32x4*)(u + r * 256 + c8 * 8 + 4) = o1; }
    float w[31];
    const float* cw = a->in[I_CW] + (size_t)layer * 31 * 256;
#pragma unroll
    for (int k = 0; k < 31; ++k) w[k] = cw[k * 256 + c];
    const float bias = a->in[I_CB][layer * 256 + c];
    __syncthreads();
    { float acc[16];
#pragma unroll
      for (int i = 0; i < 16; ++i) acc[i] = bias;
      const float* up = u + hf * 16 * 256 + c;
#pragma unroll
      for (int r = 0; r < 46; ++r) { const float v = up[r * 256];
#pragma unroll
          for (int i = 0; i < 16; ++i) if (r - i >= 0 && r - i <= 30) acc[i] += v * w[r - i]; }
#pragma unroll
      for (int i = 0; i < 16; ++i) y[(hf * 16 + i) * 256 + c] = acc[i]; }
    __syncthreads();
    const f32x4 lg = *(const f32x4*)(a->in[I_CLG] + layer * 256 + 4 * lane), lb = *(const f32x4*)(a->in[I_CLB] + layer * 256 + 4 * lane);
#pragma unroll
    for (int i = 0; i < 4; ++i) { const int tt = wave * 4 + i; f32x4 v = *(const f32x4*)(y + tt * 256 + 4 * lane);
        const float mu = wave_sum((v.x + v.y) + (v.z + v.w)) * (1.f / 256); v = v - mu;
        const float var = wave_sum((v.x * v.x + v.y * v.y) + (v.z * v.z + v.w * v.w)) * (1.f / 256); const float rstd = rsqf_(var + EPS);
        v = v * rstd * lg + lb;
        u32x2 o; o.x = pk2(siluf_(v.x), siluf_(v.y)); o.y = pk2(siluf_(v.z), siluf_(v.w));
        *(u32x2*)(Y + (size_t)(b * SEQ + t0 + tt) * D + 0 + 4 * lane) = o; }
    __syncthreads();
}
constexpr int PD_LD = 264;
DEVI void pool_item(KArgs a, unsigned char* lds, int layer, int item) {
    const int tid = launder_tid(), lane = tid & 63, wave = rfl(tid >> 6), c = tid & 255, hf = tid >> 8;
    const int b = item / (SEQ / 32), t0 = (item % (SEQ / 32)) * 32;
    const bf16_t* HB = (const bf16_t*)(a->ws + OFF_HB); bf16_t* Y = (bf16_t*)(a->ws + OFF_Y);
    float* u = (float*)lds; bf16_t* ds = (bf16_t*)(u + 48 * 256);
    for (int e = tid; e < 48 * 32; e += NTHREADS) { const int r = e >> 5, c8 = e & 31, t = t0 - 8 + r; f32x4 o0 = {}, o1 = {};
        if (t >= 0 && t < SEQ) { const u32x4 v = *(const u32x4*)(HB + (size_t)(b * SEQ + t) * NHB + C_PIN + c8 * 8);
            o0 = (f32x4){bflo(v.x), bfhi(v.x), bflo(v.y), bfhi(v.y)}; o1 = (f32x4){bflo(v.z), bfhi(v.z), bflo(v.w), bfhi(v.w)}; }
        *(f32x4*)(u + r * 256 + c8 * 8) = o0; *(f32x4*)(u + r * 256 + c8 * 8 + 4) = o1; }
    __syncthreads();
    { const int gg = c >> 6, hw = 1 << gg;
      for (int i = 0; i < 16; ++i) { const int tt = hf * 16 + i, t = t0 + tt; const int lo = (t - hw) < 0 ? 0 : (t - hw), hi = (t + hw) > SEQ ? SEQ : (t + hw);
          float s = 0.f; for (int p = lo; p < hi; ++p) s += u[(p - t0 + 8) * 256 + c];
          ds[tt * PD_LD + c] = (bf16_t)f2bf(s / (float)(hi - lo) - u[(tt + 8) * 256 + c]); } }
    __syncthreads();
    { const int g = wave >> 1, et = wave & 1, r32 = lane & 31, hi = lane >> 5; const bf16_t* PWT = (const bf16_t*)(a->ws + OFF_PWT);
      f32x16 acc = {};
#pragma unroll
      for (int ks = 0; ks < 4; ++ks) { const bf16x8 af = *(const bf16x8*)(PWT + (size_t)(g * 64 + et * 32 + r32) * 64 + ks * 16 + hi * 8), bfr = *(const bf16x8*)(ds + r32 * PD_LD + g * 64 + ks * 16 + hi * 8); acc = mfma32(af, bfr, acc); }
      const float* psp = a->in[I_PS] + layer * 256 + g * 64 + et * 32 + 4 * hi; bf16_t* yp = Y + (size_t)(b * SEQ + t0 + r32) * D + 768 + g * 64 + et * 32 + 4 * hi;
#pragma unroll
      for (int g4 = 0; g4 < 4; ++g4) { const f32x4 ps = *(const f32x4*)(psp + 8 * g4); u32x2 w; w.x = pk2(acc[4 * g4] * ps[0], acc[4 * g4 + 1] * ps[1]); w.y = pk2(acc[4 * g4 + 2] * ps[2], acc[4 * g4 + 3] * ps[3]); *(u32x2*)(yp + 8 * g4) = w; } }
    __syncthreads();
}
DEVI int crow(int r, int hi) { return (r & 3) + 8 * (r >> 2) + 4 * hi; }
constexpr int KS_LD = 72, VT_LD = 388;
DEVI void attn_item(KArgs a, unsigned char* lds, int layer, int item) {
    const int tid = launder_tid(), lane = tid & 63, wave = rfl(tid >> 6);
    const int b = item / (2 * NAB), kv = (item / NAB) & 1, n = item % NAB;
    const bf16_t* HB = (const bf16_t*)(a->ws + OFF_HB); bf16_t* Y = (bf16_t*)(a->ws + OFF_Y); const float* rope = (const float*)(a->ws + OFF_ROPE);
    bf16_t* Ks = (bf16_t*)lds; bf16_t* Vt = Ks + 384 * KS_LD;
    const int kbase = n * 128 - 128;
    for (int e = tid; e < 384 * 8; e += NTHREADS) { const int wr = e >> 3, c8 = e & 7, kpos = kbase + wr;
        u32x4 kw = (u32x4){0u, 0u, 0u, 0u}, vw = (u32x4){0u, 0u, 0u, 0u};
        if (kpos >= 0 && kpos < SEQ) { const bf16_t* hp = HB + (size_t)(b * SEQ + kpos) * NHB;
            kw = *(const u32x4*)(hp + C_AK + kv * 64 + c8 * 8); vw = *(const u32x4*)(hp + C_AV + kv * 64 + c8 * 8);
            if (c8 < 2) { const u32x4 pw = *(const u32x4*)(hp + C_AK + kv * 64 + (c8 ^ 1) * 8); const float sg = c8 ? 1.f : -1.f; const float* rp = rope + (size_t)kpos * 16;
                float o[8];
#pragma unroll
                for (int j = 0; j < 4; ++j) { const float m0 = bflo(kw[j]), m1 = bfhi(kw[j]), p0 = bflo(pw[j]), p1 = bfhi(pw[j]);
                    o[2 * j] = m0 * rp[4 * j] + sg * p0 * rp[4 * j + 1]; o[2 * j + 1] = m1 * rp[4 * j + 2] + sg * p1 * rp[4 * j + 3]; }
                kw = (u32x4){pk2(o[0], o[1]), pk2(o[2], o[3]), pk2(o[4], o[5]), pk2(o[6], o[7])}; } }
        *(u32x4*)(Ks + wr * KS_LD + c8 * 8) = kw;
#pragma unroll
        for (int j = 0; j < 4; ++j) { Vt[(c8 * 8 + 2 * j) * VT_LD + wr] = (bf16_t)(vw[j] & 0xffffu); Vt[(c8 * 8 + 2 * j + 1) * VT_LD + wr] = (bf16_t)(vw[j] >> 16); } }
    const int g = wave >> 2, hq = kv * 2 + g, q0l = (wave & 3) * 32, ql = lane & 31, hi = lane >> 5, qpos = n * 128 + q0l + ql;
    bf16x8 qf[4];
    { const bf16_t* qp = HB + (size_t)(b * SEQ + qpos) * NHB + C_AQ + hq * 64 + hi * 8; const float* rp = rope + (size_t)qpos * 16; const float sg = hi ? 1.f : -1.f;
#pragma unroll
      for (int ds = 0; ds < 4; ++ds) { const u32x4 w = *(const u32x4*)(qp + ds * 16); float v[8];
#pragma unroll
          for (int j = 0; j < 4; ++j) { v[2 * j] = bflo(w[j]); v[2 * j + 1] = bfhi(w[j]); }
          if (ds == 0) {
#pragma unroll
              for (int j = 0; j < 8; ++j) { const float p = __shfl_xor(v[j], 32); v[j] = v[j] * rp[2 * j] + sg * p * rp[2 * j + 1]; } }
          u32x4 o = (u32x4){pk2(v[0] * 0.125f, v[1] * 0.125f), pk2(v[2] * 0.125f, v[3] * 0.125f), pk2(v[4] * 0.125f, v[5] * 0.125f), pk2(v[6] * 0.125f, v[7] * 0.125f)};
          qf[ds] = __builtin_bit_cast(bf16x8, o); } }
    __syncthreads();
    float m2 = a->in[I_SINK][layer * 4 + hq] * LOG2E, l_own = hi ? 0.f : 1.f;
    f32x16 o0 = {}, o1 = {};
    for (int kt = 0; kt < 9; ++kt) {
        const int wb = q0l + 32 * kt, kpos0 = kbase + wb;
        if (kpos0 < 0 || kpos0 >= SEQ) continue;
        f32x16 s = {};
#pragma unroll
        for (int ds = 0; ds < 4; ++ds) { const bf16x8 kf = *(const bf16x8*)(Ks + (wb + ql) * KS_LD + ds * 16 + hi * 8); s = mfma32(kf, qf[ds], s); }
        float mt = -INFINITY;
#pragma unroll
        for (int r = 0; r < 16; ++r) { const int kin = crow(r, hi); float v = s[r] * LOG2E;
            if (kt == 0 && kin < ql) v = -INFINITY;
            if (kt == 8 && kin > ql) v = -INFINITY;
            s[r] = v; mt = fmaxf(mt, v); }
        mt = fmaxf(mt, __shfl_xor(mt, 32));
        const float mn = fmaxf(m2, mt), alpha = ex2(m2 - mn); m2 = mn;
        float ps = 0.f;
#pragma unroll
        for (int r = 0; r < 16; ++r) { s[r] = ex2(s[r] - mn); ps += s[r]; }
        l_own = l_own * alpha + ps;
#pragma unroll
        for (int r = 0; r < 16; ++r) { o0[r] *= alpha; o1[r] *= alpha; }
        bf16x8 pb[2];
#pragma unroll
        for (int sI = 0; sI < 2; ++sI) { u32x4 w = (u32x4){pk2(s[8 * sI + 0], s[8 * sI + 1]), pk2(s[8 * sI + 2], s[8 * sI + 3]), pk2(s[8 * sI + 4], s[8 * sI + 5]), pk2(s[8 * sI + 6], s[8 * sI + 7])}; pb[sI] = __builtin_bit_cast(bf16x8, w); }
#pragma unroll
        for (int sI = 0; sI < 2; ++sI) {
            const bf16_t* v0 = Vt + (size_t)ql * VT_LD + wb + 16 * sI + 4 * hi;
            const s16x4 a0 = *(const s16x4*)(v0), a1 = *(const s16x4*)(v0 + 8), c0 = *(const s16x4*)(v0 + 32 * VT_LD), c1 = *(const s16x4*)(v0 + 32 * VT_LD + 8);
            o0 = mfma32((bf16x8){a0[0], a0[1], a0[2], a0[3], a1[0], a1[1], a1[2], a1[3]}, pb[sI], o0);
            o1 = mfma32((bf16x8){c0[0], c0[1], c0[2], c0[3], c1[0], c1[1], c1[2], c1[3]}, pb[sI], o1); }
    }
    const float linv = 1.0f / (l_own + __shfl_xor(l_own, 32));
    bf16_t* yp = Y + (size_t)(b * SEQ + qpos) * D + 512 + hq * 64 + 4 * hi;
#pragma unroll
    for (int g4 = 0; g4 < 4; ++g4) {
        u32x2 w0, w1; w0.x = pk2(o0[4 * g4] * linv, o0[4 * g4 + 1] * linv); w0.y = pk2(o0[4 * g4 + 2] * linv, o0[4 * g4 + 3] * linv);
        w1.x = pk2(o1[4 * g4] * linv, o1[4 * g4 + 1] * linv); w1.y = pk2(o1[4 * g4 + 2] * linv, o1[4 * g4 + 3] * linv);
        *(u32x2*)(yp + 8 * g4) = w0; *(u32x2*)(yp + 32 + 8 * g4) = w1; }
    __syncthreads();
}
DEVI void gla_prep(KArgs a, int layer, const bf16_t* hrow0, int h, int t, bool act, float* tot4  , float (&bcum)[16], float& total) {
    const int d = t & 31, dir = (t >> 5) & 1, seg = t >> 6;
    const float bu = a->in[I_BUP][(size_t)layer * 256 + dir * 128 + h * 32 + d];
    float lg[16];
    const bf16_t* zp = hrow0 + (size_t)(seg * 16) * NHB + C_Z + dir * 128 + h * 32 + d;
#pragma unroll
    for (int jj = 0; jj < 16; ++jj) lg[jj] = act ? logsigf_(bf2f(zp[(size_t)jj * NHB]) + bu) * (1.f / 16.f) : 0.f;
    float acc = 0.f;
    if (dir == 0) {
#pragma unroll
        for (int jj = 0; jj < 16; ++jj) { acc += lg[jj]; bcum[jj] = acc; } }
    else {
#pragma unroll
        for (int jj = 15; jj >= 0; --jj) { acc += lg[jj]; bcum[jj] = acc; } }
    tot4[seg * 64 + dir * 32 + d] = acc;
    __syncthreads();
    const float t0 = tot4[dir * 32 + d], t1 = tot4[64 + dir * 32 + d], t2 = tot4[128 + dir * 32 + d], t3 = tot4[192 + dir * 32 + d];
    total = (t0 + t1) + (t2 + t3);
    float off;
    if (dir == 0) off = (seg > 0 ? t0 : 0.f) + (seg > 1 ? t1 : 0.f) + (seg > 2 ? t2 : 0.f);
    else off = (seg < 3 ? t3 : 0.f) + (seg < 2 ? t2 : 0.f) + (seg < 1 ? t1 : 0.f);
#pragma unroll
    for (int jj = 0; jj < 16; ++jj) bcum[jj] += off;
}
constexpr int GVT_LD = 72, GQ_LD = 40;
DEVI void gla_stage_vt(const bf16_t* hrow0, int h, int t, bool act, bf16_t* Vt) {
    for (int e8 = t; e8 < 512; e8 += 256) { const int j = e8 >> 3, c8 = e8 & 7;
        u32x4 vw = (u32x4){0u, 0u, 0u, 0u}; if (act) vw = *(const u32x4*)(hrow0 + (size_t)j * NHB + C_GV + h * 64 + c8 * 8);
#pragma unroll
        for (int q = 0; q < 4; ++q) { Vt[(c8 * 8 + 2 * q) * GVT_LD + j] = (bf16_t)(vw[q] & 0xffffu); Vt[(c8 * 8 + 2 * q + 1) * GVT_LD + j] = (bf16_t)(vw[q] >> 16); } }
}
constexpr int GX_HALF = 9216 + 9216 + 1024;
DEVI void gla_x_pair(KArgs a, unsigned char* lds, int layer, int pair) {
    const int tid = launder_tid(), lane = tid & 63, wave = rfl(tid >> 6), hf = wave >> 2, t = tid & 255, w4 = wave & 3;
    constexpr int N_GX = BATCH * NCH * 4;
    const int item = pair * 2 + hf; const bool act = item < N_GX; const int it_ = act ? item : 0;
    const int h = it_ & 3, c = (it_ >> 2) % NCH, b = it_ / (4 * NCH);
    const bf16_t* hrow0 = (const bf16_t*)(a->ws + OFF_HB) + (size_t)(b * SEQ + c * 64) * NHB;
    unsigned char* base = lds + hf * GX_HALF;
    bf16_t* Kht = (bf16_t*)base; bf16_t* Vt = (bf16_t*)(base + 9216); float* tot4 = (float*)(base + 18432);
    float bc[16], total;
    gla_stage_vt(hrow0, h, t, act, Vt);
    gla_prep(a, layer, hrow0, h, t, act, tot4, bc, total);
    { const int d = t & 31, dir = (t >> 5) & 1, seg = t >> 6;
      const bf16_t* kp = hrow0 + (size_t)(seg * 16) * NHB + C_GK + h * 32 + d; unsigned w[8];
#pragma unroll
      for (int q = 0; q < 8; ++q) { const float k0 = act ? bf2f(kp[(size_t)(2 * q) * NHB]) : 0.f, k1 = act ? bf2f(kp[(size_t)(2 * q + 1) * NHB]) : 0.f;
          w[q] = pk2(k0 * ex2((total - bc[2 * q]) * LOG2E), k1 * ex2((total - bc[2 * q + 1]) * LOG2E)); }
      u32x4* dst = (u32x4*)(Kht + (dir * 32 + d) * GVT_LD + seg * 16); dst[0] = (u32x4){w[0], w[1], w[2], w[3]}; dst[1] = (u32x4){w[4], w[5], w[6], w[7]};
      if (seg == 0 && act) ((float*)(a->ws + OFF_GD))[((size_t)((b * 4 + h) * 2 + dir) * NCH + c) * 32 + d] = ex2(total * LOG2E); }
    __syncthreads();
    { const int et = w4 & 1, dir = w4 >> 1, r32 = lane & 31, hi = lane >> 5; f32x16 u = {};
#pragma unroll
      for (int ks = 0; ks < 4; ++ks) { const bf16x8 af = *(const bf16x8*)(Vt + (et * 32 + r32) * GVT_LD + ks * 16 + hi * 8), bfr = *(const bf16x8*)(Kht + (dir * 32 + r32) * GVT_LD + ks * 16 + hi * 8); u = mfma32(af, bfr, u); }
      if (act) { float* gu = (float*)(a->ws + OFF_GU) + ((size_t)((b * 4 + h) * 2 + dir) * NCH + c) * 2048;
#pragma unroll
          for (int r = 0; r < 16; ++r) gu[(et * 32 + crow(r, hi)) * 32 + r32] = u[r]; } }
    __syncthreads();
}
DEVI void gla_scan(KArgs a) {
    float* GU = (float*)(a->ws + OFF_GU); const float* GD = (const float*)(a->ws + OFF_GD);
    constexpr int TOTAL = BATCH * 4 * 2 * 2048, UNR = (NCH % 16 == 0) ? 16 : 4;
    const int tid = launder_tid(); if (tid >= 128) return;
    for (int eid = blockIdx.x * 128 + tid; eid < TOTAL; eid += gridDim.x * 128) {
        const int seq = eid >> 11, de = eid & 2047, d = de & 31, dir = seq & 1; float S = 0.f;
        for (int s0 = 0; s0 < NCH; s0 += UNR) { float u[UNR], dc[UNR];
#pragma unroll
            for (int k = 0; k < UNR; ++k) { const int c = dir ? NCH - 1 - (s0 + k) : s0 + k; u[k] = GU[((size_t)seq * NCH + c) * 2048 + de]; dc[k] = GD[((size_t)seq * NCH + c) * 32 + d]; }
#pragma unroll
            for (int k = 0; k < UNR; ++k) { const int c = dir ? NCH - 1 - (s0 + k) : s0 + k; GU[((size_t)seq * NCH + c) * 2048 + de] = S; S = dc[k] * S + u[k]; } }
    }
}
constexpr int GZ_HALF = 10240 + 10240 + 9216 + 10240 + 1024 + 512;
DEVI void gla_z_pair(KArgs a, unsigned char* lds, int layer, int pair) {
    const int tid = launder_tid(), lane = tid & 63, wave = rfl(tid >> 6), hf = wave >> 2, t = tid & 255, w4 = wave & 3;
    constexpr int N_GZ = BATCH * NCH * 4;
    const int item = pair * 2 + hf; const bool act = item < N_GZ; const int it_ = act ? item : 0;
    const int h = it_ & 3, c = (it_ >> 2) % NCH, b = it_ / (4 * NCH);
    const bf16_t* hrow0 = (const bf16_t*)(a->ws + OFF_HB) + (size_t)(b * SEQ + c * 64) * NHB;
    unsigned char* base = lds + hf * GZ_HALF;
    bf16_t* Qs = (bf16_t*)base; bf16_t* Ks = (bf16_t*)(base + 10240); bf16_t* Vt = (bf16_t*)(base + 20480); bf16_t* St = (bf16_t*)(base + 29696);
    float* tot4 = (float*)(base + 39936); float* rsum = (float*)(base + 40960);
    float bc[16], total;
    gla_stage_vt(hrow0, h, t, act, Vt);
    { const float* GU = (const float*)(a->ws + OFF_GU);
      for (int e4 = t; e4 < 1024; e4 += 256) { const int dir = e4 >> 9, ed = (e4 & 511) * 4, e = ed >> 5, d0 = ed & 31;
          f32x4 s = {}; if (act) s = *(const f32x4*)(GU + ((size_t)((b * 4 + h) * 2 + dir) * NCH + c) * 2048 + ed);
          u32x2 w; w.x = pk2(s[0], s[1]); w.y = pk2(s[2], s[3]); *(u32x2*)(St + (dir * 64 + e) * GQ_LD + d0) = w; } }
    gla_prep(a, layer, hrow0, h, t, act, tot4, bc, total);
    { const int d = t & 31, dir = (t >> 5) & 1, seg = t >> 6;
      const bf16_t* qp = hrow0 + (size_t)(seg * 16) * NHB + C_GQ + h * 32 + d; const bf16_t* kp = qp + (C_GK - C_GQ);
#pragma unroll
      for (int jj = 0; jj < 16; ++jj) { const float q = act ? bf2f(qp[(size_t)jj * NHB]) * 0.17677669529663687f : 0.f, k = act ? bf2f(kp[(size_t)jj * NHB]) : 0.f; const float bb = bc[jj] * LOG2E;
          Qs[(dir * 64 + seg * 16 + jj) * GQ_LD + d] = (bf16_t)f2bf(q * ex2(bb)); Ks[(dir * 64 + seg * 16 + jj) * GQ_LD + d] = (bf16_t)f2bf(k * ex2(-bb)); } }
    __syncthreads();
    const int itl = w4 & 1, et = w4 >> 1, r32 = lane & 31, hi = lane >> 5;
    bf16x8 qf[2][2];
#pragma unroll
    for (int dir = 0; dir < 2; ++dir)
#pragma unroll
        for (int ks = 0; ks < 2; ++ks) qf[dir][ks] = *(const bf16x8*)(Qs + (dir * 64 + itl * 32 + r32) * GQ_LD + ks * 16 + hi * 8);
    f32x16 o = {};
#pragma unroll
    for (int jt = 0; jt < 2; ++jt) {
        f32x16 xa = {};
        if (jt == itl) { f32x16 xf = {}, xb = {};
#pragma unroll
            for (int ks = 0; ks < 2; ++ks) { xf = mfma32(*(const bf16x8*)(Ks + (jt * 32 + r32) * GQ_LD + ks * 16 + hi * 8), qf[0][ks], xf);
                                             xb = mfma32(*(const bf16x8*)(Ks + (64 + jt * 32 + r32) * GQ_LD + ks * 16 + hi * 8), qf[1][ks], xb); }
#pragma unroll
            for (int r = 0; r < 16; ++r) { const int jl = crow(r, hi); xa[r] = (jl <= r32 ? xf[r] : 0.f) + (jl >= r32 ? xb[r] : 0.f); } }
        else { const int dir = jt < itl ? 0 : 1;
#pragma unroll
            for (int ks = 0; ks < 2; ++ks) xa = mfma32(*(const bf16x8*)(Ks + (dir * 64 + jt * 32 + r32) * GQ_LD + ks * 16 + hi * 8), qf[dir][ks], xa); }
#pragma unroll
        for (int s = 0; s < 2; ++s) { const u32x4 w = (u32x4){pk2(xa[8 * s + 0], xa[8 * s + 1]), pk2(xa[8 * s + 2], xa[8 * s + 3]), pk2(xa[8 * s + 4], xa[8 * s + 5]), pk2(xa[8 * s + 6], xa[8 * s + 7])};
            const bf16_t* vp = Vt + (et * 32 + r32) * GVT_LD + jt * 32 + 16 * s + 4 * hi; const s16x4 a0 = *(const s16x4*)vp, a1 = *(const s16x4*)(vp + 8);
            o = mfma32((bf16x8){a0[0], a0[1], a0[2], a0[3], a1[0], a1[1], a1[2], a1[3]}, __builtin_bit_cast(bf16x8, w), o); } }
#pragma unroll
    for (int dir = 0; dir < 2; ++dir)
#pragma unroll
        for (int ks = 0; ks < 2; ++ks) o = mfma32(*(const bf16x8*)(St + (dir * 64 + et * 32 + r32) * GQ_LD + ks * 16 + hi * 8), qf[dir][ks], o);
    float ss = 0.f;
#pragma unroll
    for (int r = 0; r < 16; ++r) ss += o[r] * o[r];
    ss += __shfl_xor(ss, 32);
    if (hi == 0) rsum[et * 64 + itl * 32 + r32] = ss;
    __syncthreads();
    if (act) { const int il = itl * 32 + r32; const float rstd = rsqf_((rsum[il] + rsum[64 + il]) * (1.f / 64.f) + EPS);
        const bf16_t* grp = hrow0 + (size_t)il * NHB + C_GR + h * 64 + et * 32 + 4 * hi; const float* ngp = a->in[I_GNG] + layer * 256 + h * 64 + et * 32 + 4 * hi;
        bf16_t* yp = (bf16_t*)(a->ws + OFF_Y) + (size_t)(b * SEQ + c * 64 + il) * D + 256 + h * 64 + et * 32 + 4 * hi;
#pragma unroll
        for (int g4 = 0; g4 < 4; ++g4) { const u32x2 gw = *(const u32x2*)(grp + 8 * g4); const f32x4 ng = *(const f32x4*)(ngp + 8 * g4);
            u32x2 w; w.x = pk2(o[4 * g4] * rstd * ng[0] * siluf_(bflo(gw.x)), o[4 * g4 + 1] * rstd * ng[1] * siluf_(bfhi(gw.x)));
            w.y = pk2(o[4 * g4 + 2] * rstd * ng[2] * siluf_(bflo(gw.y)), o[4 * g4 + 3] * rstd * ng[3] * siluf_(bfhi(gw.y)));
            *(u32x2*)(yp + 8 * g4) = w; } }
    __syncthreads();
}
DEVI void phase_mix1(KArgs a, unsigned char* lds, int layer) {
    constexpr int N_ATT = BATCH * 2 * NAB, N_CONV = BATCH * (SEQ / 32), N_POOL = N_CONV, N_GXP = BATCH * NCH * 4 / 2, N_ALL = N_ATT + N_CONV + N_POOL + N_GXP;
    for (int it = blockIdx.x; it < N_ALL; it += gridDim.x) { int r = it;
        if (r < N_ATT) { for (int q_ = 0; q_ < (REP_ITEM == 0 ? 2 : 1); ++q_) attn_item(a, lds, layer, r); continue; } r -= N_ATT;
        if (r < N_CONV) { for (int q_ = 0; q_ < (REP_ITEM == 1 ? 2 : 1); ++q_) conv_item(a, lds, layer, r); continue; } r -= N_CONV;
        if (r < N_POOL) { for (int q_ = 0; q_ < (REP_ITEM == 2 ? 2 : 1); ++q_) pool_item(a, lds, layer, r); continue; } r -= N_POOL;
        for (int q_ = 0; q_ < (REP_ITEM == 3 ? 2 : 1); ++q_) gla_x_pair(a, lds, layer, r); }
}
DEVI void phase_mix3(KArgs a, unsigned char* lds, int layer) {
    constexpr int N_GZP = BATCH * NCH * 4 / 2;
    for (int it = blockIdx.x; it < N_GZP; it += gridDim.x) for (int q_ = 0; q_ < (REP_ITEM == 4 ? 2 : 1); ++q_) gla_z_pair(a, lds, layer, it);
}

namespace pg8 {
constexpr int BM = 256, BK = 64, HALF = 128, HTB = HALF * BK * 2, STAGE_BYTES = 8 * HTB, NXCD = 8, WGM = 8;
DEVI int lds_byte(int r, int c) { const int st = (r >> 4) * 2 + (c >> 5), rr = r & 15, cc = c & 31, ob = rr * 64 + cc * 2; return st * 1024 + (ob ^ (((ob >> 9) & 1) << 5)); }
DEVI void stage_rc(int b, int& R, int& C) { const int st = b / 1024, sb = b % 1024, swz = sb ^ (((sb >> 9) & 1) << 5); R = (st >> 1) * 16 + swz / 64; C = (st & 1) * 32 + (swz % 64) / 2; }
DEVI int perm32(int rho) { const int n = rho >> 4, i = rho & 15; return 8 * (i >> 2) + 4 * n + (i & 3); }
typedef pg8_unit_fwd Unit;
struct Gemm { const bf16_t* A; const bf16_t* Bt; int K, lda, ldb; size_t a_br, b_br; };
struct StaticOrder {
    int nM, nN, nwg, G, c;
    DEVM void init(int Mr, int N, int G_, int c_) { nM = Mr / BM; nN = N / BM; nwg = nM * nN; G = G_; c = c_; }
    DEVM bool tile(long L, Unit& u) const {
        if (L >= nwg) return false;
        int wgid = (int)L; { const int q = nwg / NXCD, r = nwg % NXCD, xcd = wgid % NXCD, off = wgid / NXCD; wgid = (xcd < r ? xcd * (q + 1) : r * (q + 1) + (xcd - r) * q) + off; }
        const int nig = WGM * nN, gid = wgid / nig, fm = gid * WGM, gsz = (nM - fm) < WGM ? (nM - fm) : WGM;
        u.pm = fm + ((wgid % nig) % gsz); u.pn = (wgid % nig) / gsz; u.br = 0; return true;
    }
    typedef Unit unit_t;
    DEVM bool next(int i, Unit& u) const { u.ui = i; return tile((long)i * G + c, u); }
};
struct BranchOrder : StaticOrder {
    DEVM bool next(int i, Unit& u) const { u.ui = i; if (!tile((long)(i >> 2) * G + c, u)) return false; u.br = i & 3; return true; }
};
template <int ACT  > struct EpiBf16 {
    static constexpr bool PERM = true;
    bf16_t* O; int ldc; const float* tab;
    DEVM void operator()(const f32x4 (&acc)[2][2][4][2], const Unit& u, int wr, int wc, int fr, int fq) const {
        const int row0 = u.pm * BM + wr * 64 + fr, col0 = u.pn * BM + wc * 32 + 8 * fq;
#pragma unroll
        for (int ai = 0; ai < 2; ++ai)
#pragma unroll
            for (int m = 0; m < 4; ++m) { bf16_t* rowp = O + (size_t)(row0 + ai * HALF + m * 16) * ldc + col0; const float rs = tab[u.ui * 256 + ai * HALF + wr * 64 + m * 16 + fr];
#pragma unroll
                for (int bj = 0; bj < 2; ++bj) { f32x4 v0 = acc[ai][bj][m][0] * rs, v1 = acc[ai][bj][m][1] * rs;
                    if (ACT == 1) {
#pragma unroll
                        for (int q = 0; q < 4; ++q) { v0[q] = sigmoidf_(v0[q]); v1[q] = sigmoidf_(v1[q]); } }
                    if (ACT == 2) {
#pragma unroll
                        for (int q = 0; q < 4; ++q) { const float r0 = fmaxf(v0[q], 0.f), r1 = fmaxf(v1[q], 0.f); v0[q] = r0 * r0; v1[q] = r1 * r1; } }
                    u32x4 w; w.x = pk2(v0[0], v0[1]); w.y = pk2(v0[2], v0[3]); w.z = pk2(v1[0], v1[1]); w.w = pk2(v1[2], v1[3]);
                    *(u32x4*)(rowp + bj * HALF) = w; } }
    }
};
struct EpiMerge {
    static constexpr bool PERM = true;
    bf16_t* O; const bf16_t* G;
    DEVM void operator()(const f32x4 (&acc)[2][2][4][2], const Unit& u, int wr, int wc, int fr, int fq) const {
        const int row0 = u.pm * BM + wr * 64 + fr, col0 = u.pn * BM + wc * 32 + 8 * fq;
#pragma unroll
        for (int ai = 0; ai < 2; ++ai)
#pragma unroll
            for (int m = 0; m < 4; ++m) { const size_t row = (size_t)(row0 + ai * HALF + m * 16); bf16_t* rowp = O + row * D + col0; const bf16_t* gp = G + row * NGATE + u.br * D + col0;
#pragma unroll
                for (int bj = 0; bj < 2; ++bj) { const f32x4 v0 = acc[ai][bj][m][0], v1 = acc[ai][bj][m][1];
                    const u32x4 gw = *(const u32x4*)(gp + bj * HALF);
                    float o[8] = {v0[0] * bflo(gw.x), v0[1] * bfhi(gw.x), v0[2] * bflo(gw.y), v0[3] * bfhi(gw.y), v1[0] * bflo(gw.z), v1[1] * bfhi(gw.z), v1[2] * bflo(gw.w), v1[3] * bfhi(gw.w)};
                    if (u.br != 0) { const u32x4 pw = *(const u32x4*)(rowp + bj * HALF);
                        o[0] += bflo(pw.x); o[1] += bfhi(pw.x); o[2] += bflo(pw.y); o[3] += bfhi(pw.y); o[4] += bflo(pw.z); o[5] += bfhi(pw.z); o[6] += bflo(pw.w); o[7] += bfhi(pw.w); }
                    u32x4 w; w.x = pk2(o[0], o[1]); w.y = pk2(o[2], o[3]); w.z = pk2(o[4], o[5]); w.w = pk2(o[6], o[7]);
                    *(u32x4*)(rowp + bj * HALF) = w; }
#ifndef CPU_EMU
                asm volatile("" ::: "memory");
#endif
            }
    }
};
struct EpiResNorm {
    static constexpr bool PERM = false;
    const float* base; float* out; bf16_t* xb; float* part;
    DEVM void operator()(const f32x4 (&acc)[2][2][4][2], const Unit& u, int wr, int wc, int fr, int fq) const {
        const int row0 = u.pm * BM + wr * 64 + fr, col0 = u.pn * BM + wc * 32 + 4 * fq;
#pragma unroll
        for (int ai = 0; ai < 2; ++ai)
#pragma unroll
            for (int m = 0; m < 4; ++m) { const size_t row = (size_t)(row0 + ai * HALF + m * 16), off = row * D + col0; float ss = 0.f;
#pragma unroll
                for (int bj = 0; bj < 2; ++bj)
#pragma unroll
                    for (int n = 0; n < 2; ++n) { const f32x4 x = *(const f32x4*)(base + off + bj * HALF + n * 16) + acc[ai][bj][m][n]; *(f32x4*)(out + off + bj * HALF + n * 16) = x;
                        u32x2 w; w.x = pk2(x[0], x[1]); w.y = pk2(x[2], x[3]); *(u32x2*)(xb + off + bj * HALF + n * 16) = w; ss += (x[0] * x[0] + x[1] * x[1]) + (x[2] * x[2] + x[3] * x[3]); }
                ss += __shfl_xor(ss, 16); ss += __shfl_xor(ss, 32);
                if (fq == 0) part[row * 16 + u.pn * 4 + wc] = ss; }
    }
};
struct EpiResF32 {
    static constexpr bool PERM = false;
    const float* base; float* out;
    DEVM void operator()(const f32x4 (&acc)[2][2][4][2], const Unit& u, int wr, int wc, int fr, int fq) const {
        const int row0 = u.pm * BM + wr * 64 + fr, col0 = u.pn * BM + wc * 32 + 4 * fq;
#pragma unroll
        for (int ai = 0; ai < 2; ++ai)
#pragma unroll
            for (int m = 0; m < 4; ++m) { const size_t off = (size_t)(row0 + ai * HALF + m * 16) * D + col0;
#pragma unroll
                for (int bj = 0; bj < 2; ++bj)
#pragma unroll
                    for (int n = 0; n < 2; ++n) { const f32x4 bs = *(const f32x4*)(base + off + bj * HALF + n * 16); *(f32x4*)(out + off + bj * HALF + n * 16) = bs + acc[ai][bj][m][n]; } }
    }
};
#ifndef CPU_EMU
#define PG8_LAS __attribute__((address_space(3)))
template <class Epi, class Sched, bool ALIGN_EPI = true>
__device__ __forceinline__ void gemm_phase(PG8_LAS unsigned char* lds, const Gemm g, const Sched& S, const Epi& E) {
    int tid_ = threadIdx.x; asm volatile("" : "+v"(tid_));
    const int tid = tid_, wid = __builtin_amdgcn_readfirstlane(tid >> 6), lane = tid & 63, wr = wid >> 2, wc = wid & 3, fr = lane & 15, fq = lane >> 4;
    const int K = g.K, nt = K / BK;
    unsigned voffA[2], voffB[2];
#pragma unroll
    for (int i = 0; i < 2; ++i) { int R, C; stage_rc(tid * 16 + i * 8192, R, C); const int Rb = Epi::PERM ? ((R & ~31) + perm32(R & 31)) : R;
        voffA[i] = (unsigned)(R * g.lda + C) * 2u; voffB[i] = (unsigned)(Rb * g.ldb + C) * 2u; }
    const size_t kstep = (size_t)(BK * 2);
    const size_t hstepA = (size_t)HALF * g.lda * 2, hstepB = (size_t)HALF * g.ldb * 2;
    const size_t tstepA = 2 * hstepA, tstepB = 2 * hstepB;
    const unsigned ldsw = (unsigned)wid * 1024u;
    const int aoff = lds_byte(wr * 64 + fr, fq * 8), boff = lds_byte(wc * 32 + fr, fq * 8);
#define PG8_SA(b, h) (((b) * 2 + (h)) * HTB)
#define PG8_SB(b, h) ((4 + (b) * 2 + (h)) * HTB)
#define PG8_STAGE(bufoff, gbase, voff) do { _Pragma("unroll") for (int _i = 0; _i < 2; ++_i) \
        __builtin_amdgcn_global_load_lds((const unsigned*)((const char*)(gbase) + (voff)[_i]), (PG8_LAS unsigned*)(lds + (bufoff) + ldsw + _i * 8192), 16, 0, 0); } while (0)
#define PG8_LDA(dst, b, h) do { _Pragma("unroll") for (int m = 0; m < 4; ++m) _Pragma("unroll") for (int k = 0; k < 2; ++k) dst[m][k] = *(const PG8_LAS bf16x8*)(lds + PG8_SA(b, h) + aoff + m * 2048 + k * 1024); } while (0)
#define PG8_LDB(dst, b, h) do { _Pragma("unroll") for (int n = 0; n < 2; ++n) _Pragma("unroll") for (int k = 0; k < 2; ++k) dst[n][k] = *(const PG8_LAS bf16x8*)(lds + PG8_SB(b, h) + boff + n * 2048 + k * 1024); } while (0)
#define PG8_MMA(ai, bj, At, Bt) do { __builtin_amdgcn_s_setprio(1); _Pragma("unroll") for (int m = 0; m < 4; ++m) _Pragma("unroll") for (int n = 0; n < 2; ++n) _Pragma("unroll") for (int k = 0; k < 2; ++k) \
        acc[ai][bj][m][n] = __builtin_amdgcn_mfma_f32_16x16x32_bf16(Bt[n][k], At[m][k], acc[ai][bj][m][n], 0, 0, 0); __builtin_amdgcn_s_setprio(0); } while (0)
#define PG8_WAIT_V(n) asm volatile("s_waitcnt vmcnt(" #n ")" ::: "memory")
#define PG8_WAIT_L(n) asm volatile("s_waitcnt lgkmcnt(" #n ")" ::: "memory")
#define PG8_BAR __builtin_amdgcn_s_barrier()
#define PG8_SCHED __builtin_amdgcn_sched_barrier(0)
#define PG8_ABASE(u) ((const char*)(g.A + (size_t)(u).br * g.a_br) + (size_t)(u).pm * tstepA)
#define PG8_BBASE(u) ((const char*)(g.Bt + (size_t)(u).br * g.b_br) + (size_t)(u).pn * tstepB)
    Unit cur, nxt; int ui = 0;
    if (!S.next(0, cur)) return;
    f32x4 acc[2][2][4][2];
#pragma unroll
    for (int a = 0; a < 2; ++a)
#pragma unroll
        for (int b = 0; b < 2; ++b)
#pragma unroll
            for (int m = 0; m < 4; ++m)
#pragma unroll
                for (int n = 0; n < 2; ++n) acc[a][b][m][n] = (f32x4){0.f, 0.f, 0.f, 0.f};
    bf16x8 At[4][2], B0[2][2], B1[2][2];
    const char* cA = PG8_ABASE(cur); const char* cB = PG8_BBASE(cur);
    PG8_STAGE(PG8_SB(0, 0), cB, voffB); PG8_STAGE(PG8_SB(0, 1), cB + hstepB, voffB); PG8_STAGE(PG8_SA(0, 0), cA, voffA); PG8_STAGE(PG8_SA(0, 1), cA + hstepA, voffA);
    if (wr == 1) PG8_BAR;
    PG8_WAIT_V(2); PG8_BAR;
    PG8_STAGE(PG8_SB(1, 0), cB + kstep, voffB); PG8_STAGE(PG8_SA(1, 0), cA + kstep, voffA); PG8_STAGE(PG8_SB(1, 1), cB + hstepB + kstep, voffB);
    PG8_WAIT_V(6); PG8_BAR;
    for (;;) {
        const bool has_next = S.next(ui + 1, nxt);
        const char* nA = has_next ? PG8_ABASE(nxt) : cA; const char* nB = has_next ? PG8_BBASE(nxt) : cB;
#pragma nounroll
        for (int t = 0; t < nt; t += 2) {
            const bool last = (t == nt - 2);
            const char* a1 = cA + (size_t)(t + 1) * kstep;
            const char* a2 = last ? nA : cA + (size_t)(t + 2) * kstep; const char* b2 = last ? nB : cB + (size_t)(t + 2) * kstep;
            const char* a3 = a2 + kstep; const char* b3 = b2 + kstep;
            PG8_LDB(B0, 0, 0); PG8_LDB(B1, 0, 1); PG8_SCHED; PG8_LDA(At, 0, 0); PG8_STAGE(PG8_SA(1, 1), a1 + hstepA, voffA);
            PG8_WAIT_V(8); PG8_WAIT_L(0); PG8_BAR; PG8_MMA(0, 0, At, B0); PG8_MMA(0, 1, At, B1); PG8_BAR; PG8_SCHED;
            PG8_LDA(At, 0, 1); PG8_STAGE(PG8_SB(0, 0), b2, voffB); PG8_STAGE(PG8_SB(0, 1), b2 + hstepB, voffB); PG8_STAGE(PG8_SA(0, 0), a2, voffA);
            PG8_WAIT_V(8); PG8_WAIT_L(0); PG8_BAR; PG8_MMA(1, 0, At, B0); PG8_MMA(1, 1, At, B1); PG8_BAR; PG8_SCHED;
            PG8_LDB(B0, 1, 0); PG8_LDB(B1, 1, 1); PG8_SCHED; PG8_LDA(At, 1, 0); PG8_STAGE(PG8_SA(0, 1), a2 + hstepA, voffA);
            PG8_WAIT_V(8); PG8_WAIT_L(0); PG8_BAR; PG8_MMA(0, 0, At, B0); PG8_MMA(0, 1, At, B1); PG8_BAR; PG8_SCHED;
            PG8_LDA(At, 1, 1); PG8_STAGE(PG8_SB(1, 0), b3, voffB); PG8_STAGE(PG8_SB(1, 1), b3 + hstepB, voffB); PG8_STAGE(PG8_SA(1, 0), a3, voffA);
            PG8_WAIT_V(8); PG8_WAIT_L(0); PG8_BAR; PG8_MMA(1, 0, At, B0); PG8_MMA(1, 1, At, B1); PG8_BAR; PG8_SCHED;
        }
        if constexpr (ALIGN_EPI) { if (wr == 0) PG8_BAR; }
        E(acc, cur, wr, wc, fr, fq);
        if (!has_next) break;
#pragma unroll
        for (int a = 0; a < 2; ++a)
#pragma unroll
            for (int b = 0; b < 2; ++b)
#pragma unroll
                for (int m = 0; m < 4; ++m)
#pragma unroll
                    for (int n = 0; n < 2; ++n) acc[a][b][m][n] = (f32x4){0.f, 0.f, 0.f, 0.f};
        cur = nxt; cA = nA; cB = nB; ++ui;
        if constexpr (ALIGN_EPI) { if (wr == 1) PG8_BAR; }
    }
    PG8_WAIT_V(0);
    if constexpr (!ALIGN_EPI) { if (wr == 0) PG8_BAR; }
    PG8_BAR;
#undef PG8_SA
#undef PG8_SB
#undef PG8_STAGE
#undef PG8_LDA
#undef PG8_LDB
#undef PG8_MMA
#undef PG8_WAIT_V
#undef PG8_WAIT_L
#undef PG8_BAR
#undef PG8_SCHED
#undef PG8_ABASE
#undef PG8_BBASE
}
#endif
}

#ifndef CPU_EMU
#define LAS __attribute__((address_space(3)))
#define XB_TMO      128
#define XB_XCNT(j)  (256  + 64 * (j))
#define XB_XSUB(j)  (1280 + 64 * (j))
#define XB_XGEN(j)  (2304 + 64 * (j))
#define XB_TOP      3328
#define XB_TOPGEN   3392
#define XCD_BAR_WORDS 3456
#define XB_SPIN_CAP (1u << 20)
__device__ __forceinline__ unsigned xb_ld(unsigned* p)              { return __hip_atomic_load(p, __ATOMIC_RELAXED, __HIP_MEMORY_SCOPE_AGENT); }
__device__ __forceinline__ unsigned xb_add(unsigned* p, unsigned v) { return __hip_atomic_fetch_add(p, v, __ATOMIC_RELAXED, __HIP_MEMORY_SCOPE_AGENT); }
__device__ __forceinline__ unsigned xb_xcc_id() { return (unsigned)__builtin_amdgcn_s_getreg((3 << 11) | 20) & 0xFu; }
#define XB_SPIN(cond, bar) do { unsigned _sp = 0; while (cond) { __builtin_amdgcn_s_sleep(1); \
    if ((++_sp & 255u) == 0u) { if (xb_ld(&(bar)[XB_TMO])) break; if (_sp > XB_SPIN_CAP) { atomicAdd(&(bar)[XB_TMO], 1u); break; } } } } while (0)
struct XcdBarrier { unsigned* bar; unsigned x; volatile LAS unsigned* st; };
__device__ __forceinline__ XcdBarrier xcd_barrier_post(unsigned* bar, volatile LAS unsigned* st) {
    XcdBarrier b; b.bar = bar; b.x = xb_xcc_id(); b.st = st;
    if (threadIdx.x == 0) (void)xb_add(&bar[XB_XCNT(b.x)], 1u);
    return b;
}
__device__ __forceinline__ void xcd_barrier_complete(unsigned* bar, unsigned x, unsigned& nloc, unsigned& nx) {
    const unsigned G = gridDim.x * gridDim.y * gridDim.z;
    unsigned sum, cnt, mine, sp = 0u;
    for (;;) {
        sum = 0u; cnt = 0u; mine = 0u;
#pragma unroll
        for (unsigned j = 0; j < 16; ++j) { const unsigned c = xb_ld(&bar[XB_XCNT(j)]); sum += c; cnt += (c > 0u) ? 1u : 0u; mine = (j == x) ? c : mine; }
        if (sum == G) break;
        __builtin_amdgcn_s_sleep(1);
        if ((++sp & 255u) == 0u) { if (xb_ld(&bar[XB_TMO])) break; if (sp > XB_SPIN_CAP) { atomicAdd(&bar[XB_TMO], 1u); break; } }
    }
    nloc = mine > 0u ? mine : 1u; nx = cnt > 0u ? cnt : 1u;
}
__device__ __forceinline__ void xcd_barrier(const XcdBarrier& b) {
    asm volatile("s_waitcnt vmcnt(0)" ::: "memory");
    __syncthreads();
    if (threadIdx.x == 0) {
        unsigned* bar = b.bar;
        __builtin_amdgcn_s_waitcnt(0);
        unsigned nloc = b.st[0], nx = b.st[1];
        if (nloc == 0u) { xcd_barrier_complete(bar, b.x, nloc, nx); b.st[0] = nloc; b.st[1] = nx; }
        const unsigned old = xb_add(&bar[XB_XSUB(b.x)], 1u);
        const unsigned gen = old / nloc;
        if (old + 1u == (gen + 1u) * nloc) {
            __builtin_amdgcn_fence(__ATOMIC_RELEASE, "agent");
            asm volatile("s_waitcnt vmcnt(0)" ::: "memory");
            const unsigned og = xb_add(&bar[XB_TOP], 1u);
            const unsigned tg = og / nx;
            if (og + 1u == (tg + 1u) * nx) xb_add(&bar[XB_TOPGEN], 1u);
            else XB_SPIN(xb_ld(&bar[XB_TOPGEN]) == tg, bar);
            __builtin_amdgcn_fence(__ATOMIC_ACQUIRE, "agent");
            xb_add(&bar[XB_XGEN(b.x)], 1u);
            asm volatile("s_waitcnt vmcnt(0)" ::: "memory");
        } else {
            XB_SPIN(xb_ld(&bar[XB_XGEN(b.x)]) == gen, bar);
            __builtin_amdgcn_fence(__ATOMIC_ACQUIRE, "agent");
            asm volatile("s_waitcnt vmcnt(0)" ::: "memory");
        }
    }
    __syncthreads();
}
constexpr int LDS_BYTES = 147456;
constexpr int RTAB_OFF = 131072 + 1024;
constexpr int LDSCTL_OFF = 131072 + 320;
__global__ void __launch_bounds__(NTHREADS, 2) mega_fwd(Args a_) {
    extern __shared__ __attribute__((aligned(16))) unsigned char lds[];
    __attribute__((address_space(3))) unsigned char* lds3 = (__attribute__((address_space(3))) unsigned char*)lds;
    const int G = gridDim.x, bid = blockIdx.x;
    const int lo = a_.ph_lo, hi = a_.ph_hi;
    volatile LAS unsigned* MISC = (volatile LAS unsigned*)(lds3 + LDSCTL_OFF);
    if (threadIdx.x < 16) MISC[threadIdx.x] = 0u;
    __syncthreads();
    XcdBarrier bar; { KArgs a = kargs(); unsigned* bw = (unsigned*)(a->ws + OFF_CTL) + 4096; bar.bar = bw; bar.x = 0; bar.st = nullptr;
        if (hi - lo > 1) bar = xcd_barrier_post(bw, MISC + 8); }
#define SEAM(p) do { if (lo <= (p) && (p) + 1 < hi) xcd_barrier(bar); } while (0)
#define IN_PH(p) ((((PH_MASK) >> ((p) % PH_PER_LAYER + ((p) == PH_FINAL ? PH_PER_LAYER : 0))) & 1) && lo <= (p) && (p) < hi)
#define REPS(k) for (int rep_ = 0; rep_ < (REP_KIND == (k) ? 2 : 1); ++rep_)
#define WSP(T, off) ((T*)(a->ws + (off)))
    float* rtab = (float*)(lds + RTAB_OFF);
#pragma unroll
    for (int layer = 0; layer < NLAYER; ++layer) {
        const int pb = layer * PH_PER_LAYER;
        REPS(PH_WCONV) if (IN_PH(pb + PH_WCONV)) { KArgs a = kargs(); phase_wconv(a, lds, layer); if (layer == 0) phase_x_to_bf16(a->in[I_X], WSP(bf16_t, OFF_XN), WSP(float, OFF_PART)); }
        SEAM(pb + PH_WCONV);
        REPS(PH_GEMM_IN) if (IN_PH(pb + PH_GEMM_IN)) { KArgs a = kargs(); pg8::Gemm g{WSP(bf16_t, OFF_XN), WSP(bf16_t, OFF_WIN), D, D, D, 0, 0}; pg8::StaticOrder S; S.init(M, NHB, G, bid); pg8::EpiBf16<0> E{WSP(bf16_t, OFF_HB), NHB, rtab};
            prep_rstd(S, WSP(float, OFF_PART), rtab); pg8::gemm_phase<pg8::EpiBf16<0>, pg8::StaticOrder>(lds3, g, S, E); }
        SEAM(pb + PH_GEMM_IN);
        REPS(PH_MIX1) if (IN_PH(pb + PH_MIX1)) phase_mix1(kargs(), lds, layer);
        SEAM(pb + PH_MIX1);
        if (IN_PH(pb + PH_MIX2)) gla_scan(kargs());
        SEAM(pb + PH_MIX2);
        REPS(PH_MIX3) if (IN_PH(pb + PH_MIX3)) phase_mix3(kargs(), lds, layer);
        SEAM(pb + PH_MIX3);
        REPS(PH_GEMM_G) if (IN_PH(pb + PH_GEMM_G)) { KArgs a = kargs(); pg8::Gemm g{WSP(bf16_t, OFF_XN), WSP(bf16_t, OFF_WIN) + (size_t)NHB * D, D, D, D, 0, 0}; pg8::StaticOrder S; S.init(M, NGATE, G, bid); pg8::EpiBf16<1> E{WSP(bf16_t, OFF_G), NGATE, rtab};
            prep_rstd(S, WSP(float, OFF_PART), rtab); pg8::gemm_phase<pg8::EpiBf16<1>, pg8::StaticOrder>(lds3, g, S, E); }
        SEAM(pb + PH_GEMM_G);
        REPS(PH_GEMM_M) if (IN_PH(pb + PH_GEMM_M)) { KArgs a = kargs(); pg8::Gemm g{WSP(bf16_t, OFF_Y), WSP(bf16_t, OFF_WBR), 256, D, 256, 256, (size_t)D * 256}; pg8::BranchOrder S; S.init(M, D, G, bid); pg8::EpiMerge E{WSP(bf16_t, OFF_XN), WSP(bf16_t, OFF_G)};
            pg8::gemm_phase<pg8::EpiMerge, pg8::BranchOrder>(lds3, g, S, E); }
        SEAM(pb + PH_GEMM_M);
        for (int rep_ = 0; rep_ < ((REP_KIND == PH_GEMM_O && layer == 0) ? 3 : 1); ++rep_) if (IN_PH(pb + PH_GEMM_O)) { KArgs a = kargs(); pg8::Gemm g{WSP(bf16_t, OFF_XN), WSP(bf16_t, OFF_WOUT), D, D, D, 0, 0}; pg8::StaticOrder S; S.init(M, D, G, bid);
            pg8::EpiResNorm E{layer == 0 ? a->in[I_X] : a->out, a->out, WSP(bf16_t, OFF_Y), WSP(float, OFF_PART)};
            pg8::gemm_phase<pg8::EpiResNorm, pg8::StaticOrder>(lds3, g, S, E); }
        SEAM(pb + PH_GEMM_O);
        REPS(PH_GEMM_U) if (IN_PH(pb + PH_GEMM_U)) { KArgs a = kargs(); pg8::Gemm g{WSP(bf16_t, OFF_Y), WSP(bf16_t, OFF_WUP), D, D, D, 0, 0}; pg8::StaticOrder S; S.init(M, DFF, G, bid); pg8::EpiBf16<2> E{WSP(bf16_t, OFF_UP), DFF, rtab};
            prep_rstd(S, WSP(float, OFF_PART), rtab); pg8::gemm_phase<pg8::EpiBf16<2>, pg8::StaticOrder>(lds3, g, S, E); }
        SEAM(pb + PH_GEMM_U);
        if (IN_PH(pb + PH_GEMM_D)) { KArgs a = kargs(); pg8::Gemm g{WSP(bf16_t, OFF_UP), WSP(bf16_t, OFF_WDN), DFF, DFF, DFF, 0, 0}; pg8::StaticOrder S; S.init(M, D, G, bid);
            pg8::EpiResNorm E{a->out, a->out, WSP(bf16_t, OFF_XN), WSP(float, OFF_PART)};
            pg8::gemm_phase<pg8::EpiResNorm, pg8::StaticOrder>(lds3, g, S, E); }
        SEAM(pb + PH_GEMM_D);
    }
    if (IN_PH(PH_FINAL)) { KArgs a = kargs(); phase_rmsnorm_f32_inplace(a->out, a->in[I_FNG]); }
#undef IN_PH
#undef REPS
#undef WSP
#undef SEAM
}

extern "C" void kernel_launch(void* const* d_in, const int* in_sizes, int n_in, void* d_out, int out_size, void* d_ws, size_t ws_size, hipStream_t stream) {
    static int grid = 0;
    if (grid == 0) {
        if (n_in != N_INPUTS || out_size != M * D || ws_size < WS_END) { fprintf(stderr, "kernel_launch: unexpected shapes (n_in %d out %d ws %zu)\n", n_in, out_size, ws_size); grid = -1; return; }
        int dev = 0, cus = 0;
        if (hipGetDevice(&dev) != hipSuccess || hipDeviceGetAttribute(&cus, hipDeviceAttributeMultiprocessorCount, dev) != hipSuccess) { grid = -1; return; }
        if (hipFuncSetAttribute((const void*)mega_fwd, hipFuncAttributeMaxDynamicSharedMemorySize, LDS_BYTES) != hipSuccess) { fprintf(stderr, "kernel_launch: hipFuncSetAttribute failed\n"); grid = -1; return; }
        grid = cus;
    }
    if (grid < 0) return;
    Args a{};
    for (int i = 0; i < N_INPUTS; ++i) a.in[i] = (const float*)d_in[i];
    a.out = (float*)d_out; a.ws = (unsigned char*)d_ws;
#if N_LAUNCH_MODE == 0
    for (int ph = 0; ph < N_PHASES; ++ph) { a.ph_lo = ph; a.ph_hi = ph + 1; hipLaunchKernelGGL(mega_fwd, dim3(grid), dim3(NTHREADS), LDS_BYTES, stream, a); }
#else
    if (hipMemsetAsync((char*)d_ws + OFF_CTL, 0, 65536, stream) != hipSuccess) { fprintf(stderr, "kernel_launch: memset failed\n"); return; }
    a.ph_lo = 0; a.ph_hi = N_PHASES;
    hipLaunchKernelGGL(mega_fwd, dim3(grid), dim3(NTHREADS), LDS_BYTES, stream, a);
#endif
}
#endif
```

```cpp
#ifndef CPU_EMU
#include <hip/hip_runtime.h>
#include <cstdio>
#include <cstdint>
#endif
#ifndef SEQ_T
#define SEQ_T 8192
#endif
#ifndef PH_MASK
#define PH_MASK 0xffff
#endif
#ifndef TIME_PH
#define TIME_PH -1
#endif
#ifndef TIME_SEC
#define TIME_SEC -1
#endif
#ifndef BAR_REPS
#define BAR_REPS 1
#endif
#ifndef REP_ITEM
#define REP_ITEM -1
#endif
#ifndef REP_KIND
#define REP_KIND -1
#endif
#ifndef N_LAUNCH_MODE
#define N_LAUNCH_MODE 1
#endif

typedef unsigned short bf16_t;
typedef short bf16x8 __attribute__((ext_vector_type(8)));
typedef short s16x4 __attribute__((ext_vector_type(4)));
typedef float f32x4 __attribute__((ext_vector_type(4)));
typedef float f32x16 __attribute__((ext_vector_type(16)));
typedef unsigned u32x4 __attribute__((ext_vector_type(4)));
typedef unsigned u32x2 __attribute__((ext_vector_type(2)));
#ifdef CPU_EMU
#define DEVI static inline
#define DEVM inline
DEVI float ex2(float x) { return exp2f(x); }
DEVI float lg2(float x) { return log2f(x); }
DEVI float rcpf_(float x) { return 1.0f / x; }
DEVI float rsqf_(float x) { return 1.0f / sqrtf(x); }
DEVI f32x16 mfma32(bf16x8 a, bf16x8 b, f32x16 c) { return emu_mfma32(a, b, c); }
DEVI void wave_sync() { emu_wave->bar.wait(); }
DEVI void lds_barrier() { __syncthreads(); }
DEVI bool wave_any(bool p) { unsigned v = p ? 1u : 0u; for (int o = 1; o < 64; o <<= 1) v |= __shfl_xor(v, o); return v != 0u; }
DEVI int rfl(int x) { return x; }
#else
#define DEVI __device__ __forceinline__
#define DEVM __device__ __forceinline__
DEVI float ex2(float x) { return __builtin_amdgcn_exp2f(x); }
DEVI float lg2(float x) { return __builtin_amdgcn_logf(x); }
DEVI float rcpf_(float x) { return __builtin_amdgcn_rcpf(x); }
DEVI float rsqf_(float x) { return __builtin_amdgcn_rsqf(x); }
DEVI f32x16 mfma32(bf16x8 a, bf16x8 b, f32x16 c) { return __builtin_amdgcn_mfma_f32_32x32x16_bf16(a, b, c, 0, 0, 0); }
DEVI void wave_sync() { asm volatile("s_waitcnt lgkmcnt(0)" ::: "memory"); }
DEVI void lds_barrier() { asm volatile("s_waitcnt lgkmcnt(0)\n\ts_barrier" ::: "memory"); }
DEVI bool wave_any(bool p) { return __builtin_amdgcn_ballot_w64(p) != 0ull; }
DEVI int rfl(int x) { return __builtin_amdgcn_readfirstlane(x); }
#endif
#ifdef CPU_EMU
DEVI int launder_tid() { return (int)threadIdx.x; }
#else
DEVI int launder_tid() { int t = threadIdx.x; asm volatile("" : "+v"(t)); return t; }
#endif
#ifdef CPU_EMU
DEVI unsigned f2bf(float f) { unsigned u = __builtin_bit_cast(unsigned, f); return (u + 0x7fffu + ((u >> 16) & 1u)) >> 16; }
DEVI unsigned pk2(float lo, float hi) { return f2bf(lo) | (f2bf(hi) << 16); }
#else
typedef __bf16 bf16x2_hw __attribute__((ext_vector_type(2))); typedef float f32x2_hw __attribute__((ext_vector_type(2)));
DEVI unsigned pk2(float lo, float hi) { const f32x2_hw v = {lo, hi}; return __builtin_bit_cast(unsigned, __builtin_convertvector(v, bf16x2_hw)); }
DEVI unsigned f2bf(float f) { return pk2(f, 0.f) & 0xffffu; }
#endif
DEVI float bf2f(unsigned h) { return __builtin_bit_cast(float, h << 16); }
DEVI float bflo(unsigned w) { return __builtin_bit_cast(float, w << 16); }
DEVI float bfhi(unsigned w) { return __builtin_bit_cast(float, w & 0xffff0000u); }
struct pg8_unit_fwd { int pm, pn, br, ui; };
constexpr float LOG2E = 1.4426950408889634f, LN2 = 0.6931471805599453f;
DEVI float sigmoidf_(float x) { return rcpf_(1.0f + ex2(-x * LOG2E)); }
DEVI float siluf_(float x) { return x * sigmoidf_(x); }
DEVI float logsigf_(float z) { const float a = fabsf(z); return fminf(z, 0.f) - LN2 * lg2(1.0f + ex2(-a * LOG2E)); }
DEVI float wave_sum(float v) {
#pragma unroll
    for (int o = 1; o < 64; o <<= 1) v += __shfl_xor(v, o);
    return v;
}

constexpr int BATCH = 2, SEQ = SEQ_T, M = BATCH * SEQ, D = 1024, DFF = 4096, NLAYER = 2;
constexpr int DIN_SRC = 6176;
constexpr int NHB = 2304, NGATE = 4096, NIN = NHB + NGATE;
constexpr int C_GLUA = 0, C_GLUG = 256, C_GQ = 512, C_GK = 640, C_GV = 768, C_GR = 1024, C_Z = 1280, C_AQ = 1536, C_AK = 1792, C_AV = 1920, C_PIN = 2048;
constexpr int SRC_GLR = 1280;
constexpr int NCH = SEQ / 64;
constexpr int NAB = SEQ / 128;
constexpr float EPS = 1e-6f;
constexpr int NTHREADS = 512, NWAVES = 8;
enum { I_X = 0, I_NMG, I_WIN, I_CW, I_CB, I_CLG, I_CLB, I_WUP, I_BUP, I_GNG, I_SINK, I_PW, I_PS, I_WBR, I_WOUT, I_NFG, I_WFU, I_WFD, I_FNG, N_INPUTS };
constexpr size_t al256(size_t x) { return (x + 255) & ~(size_t)255; }
constexpr size_t OFF_CTL = 0, CTL_BYTES = 1u << 20;
constexpr size_t SZ_WIN = (size_t)NIN * D * 2, SZ_WBR = (size_t)4 * D * 256 * 2, SZ_WOUT = (size_t)D * D * 2, SZ_WUP = (size_t)DFF * D * 2, SZ_WDN = (size_t)D * DFF * 2;
constexpr size_t OFF_WIN = OFF_CTL + CTL_BYTES, OFF_WBR = OFF_WIN + SZ_WIN, OFF_WOUT = OFF_WBR + SZ_WBR, OFF_WUP = OFF_WOUT + SZ_WOUT, OFF_WDN = OFF_WUP + SZ_WUP;
constexpr size_t OFF_ROPE = OFF_WDN + SZ_WDN, SZ_ROPE = al256((size_t)SEQ * 8 * 8);
constexpr size_t OFF_PWT = OFF_ROPE + SZ_ROPE, SZ_PWT = 4 * 64 * 64 * 2;
constexpr size_t OFF_PART = OFF_PWT + SZ_PWT, SZ_PART = al256((size_t)M * 16 * 4);
constexpr size_t OFF_XN = OFF_PART + SZ_PART, SZ_ACT = al256((size_t)M * D * 2);
constexpr size_t OFF_Y = OFF_XN + SZ_ACT;
constexpr size_t OFF_BIG = OFF_Y + SZ_ACT;
constexpr size_t OFF_HB = OFF_BIG, SZ_HB = al256((size_t)M * NHB * 2);
constexpr size_t OFF_GU = OFF_HB + SZ_HB, SZ_GU = al256((size_t)BATCH * 4 * 2 * NCH * 2048 * 4);
constexpr size_t OFF_GD = OFF_GU + SZ_GU, SZ_GD = al256((size_t)BATCH * 4 * 2 * NCH * 32 * 4);
constexpr size_t OFF_G = OFF_BIG, SZ_G = al256((size_t)M * NGATE * 2);
constexpr size_t OFF_UP = OFF_BIG;
constexpr size_t WS_END = OFF_BIG + (SZ_G > SZ_HB + SZ_GU + SZ_GD ? SZ_G : SZ_HB + SZ_GU + SZ_GD);
static_assert(WS_END <= 268435456, "workspace map exceeds 256 MiB");

struct Args { const float* in[N_INPUTS]; float* out; unsigned char* ws; int ph_lo, ph_hi; };
#ifdef CPU_EMU
#define TSEC(a, id, sgn) do {} while (0)
typedef const Args* KArgs;
#else
typedef const Args __attribute__((address_space(4)))* KArgs;
#ifndef CPU_EMU
#define TSEC(a, id, sgn) do { if (TIME_SEC == (id) && blockIdx.x == 0 && threadIdx.x == 0) { const unsigned long long t_ = __builtin_amdgcn_s_memrealtime(); \
    __hip_atomic_fetch_add((unsigned long long*)((a)->ws + OFF_CTL + 32768), (sgn) > 0 ? t_ : (0ull - t_), __ATOMIC_RELAXED, __HIP_MEMORY_SCOPE_AGENT); } } while (0)
#endif
DEVI KArgs kargs() { KArgs p = (KArgs)__builtin_amdgcn_kernarg_segment_ptr(); asm volatile("" : "+s"(p)); return p; }
#endif

enum { PH_WCONV = 0, PH_GEMM_IN, PH_MIX1, PH_MIX2, PH_MIX3, PH_GEMM_G, PH_GEMM_M, PH_GEMM_O, PH_GEMM_U, PH_GEMM_D, PH_PER_LAYER };
constexpr int PH_FINAL = NLAYER * PH_PER_LAYER, N_PHASES = PH_FINAL + 1;

DEVI void transpose_item(const float* W, int ldw, int K, bf16_t* WT, int k0, int src_n0, int dst_n0, float* scr, int lane, const float* ksc = nullptr  , int src_col = -1, int ksrc0 = -1) {
    const int sc_ = src_col >= 0 ? src_col : src_n0 + (lane & 31), ks_ = ksrc0 >= 0 ? ksrc0 : k0;
    { float tv[32]; const float* wp = W + (size_t)(ks_ + (lane >> 5)) * ldw + sc_;
#pragma unroll
      for (int i = 0; i < 32; ++i) tv[i] = wp[(size_t)(2 * i) * ldw];
#pragma unroll
      for (int i = 0; i < 32; ++i) scr[(2 * i + (lane >> 5)) * 33 + (lane & 31)] = tv[i]; }
    const int c = lane & 7;
    f32x4 g0 = (f32x4){1.f, 1.f, 1.f, 1.f}, g1 = g0; if (ksc) { g0 = *(const f32x4*)(ksc + k0 + 8 * c); g1 = *(const f32x4*)(ksc + k0 + 8 * c + 4); }
    wave_sync();
#pragma unroll
    for (int j = 0; j < 4; ++j) { const int n = (lane >> 3) + 8 * j; const float* s = scr + (8 * c) * 33 + n;
        u32x4 o; o.x = pk2(s[0 * 33] * g0[0], s[1 * 33] * g0[1]); o.y = pk2(s[2 * 33] * g0[2], s[3 * 33] * g0[3]); o.z = pk2(s[4 * 33] * g1[0], s[5 * 33] * g1[1]); o.w = pk2(s[6 * 33] * g1[2], s[7 * 33] * g1[3]);
        *(u32x4*)(WT + (size_t)(dst_n0 + n) * K + k0 + 8 * c) = o; }
    wave_sync();
}
DEVI void zfold_item(const float* Win, const float* wup, bf16_t* WT, int k0, int zc0  , float* scr, int lane, const float* ksc) {
    const int s = zc0 >> 7, kc = (zc0 & 127) + (lane & 31);
    float wu[16];
#pragma unroll
    for (int r = 0; r < 16; ++r) wu[r] = wup[(s * 16 + r) * 128 + kc];
    for (int i = 0; i < 32; ++i) { const int kk = 2 * i + (lane >> 5); const float* g = Win + (size_t)(k0 + kk) * DIN_SRC + SRC_GLR + s * 16; float a = 0.f;
#pragma unroll
        for (int r = 0; r < 16; ++r) a += g[r] * wu[r];
        scr[kk * 33 + (lane & 31)] = a; }
    const int c = lane & 7;
    const f32x4 g0 = *(const f32x4*)(ksc + k0 + 8 * c), g1 = *(const f32x4*)(ksc + k0 + 8 * c + 4);
    wave_sync();
#pragma unroll
    for (int j = 0; j < 4; ++j) { const int n = (lane >> 3) + 8 * j; const float* sp = scr + (8 * c) * 33 + n;
        u32x4 o; o.x = pk2(sp[0 * 33] * g0[0], sp[1 * 33] * g0[1]); o.y = pk2(sp[2 * 33] * g0[2], sp[3 * 33] * g0[3]); o.z = pk2(sp[4 * 33] * g1[0], sp[5 * 33] * g1[1]); o.w = pk2(sp[6 * 33] * g1[2], sp[7 * 33] * g1[3]);
        *(u32x4*)(WT + (size_t)(C_Z + zc0 + n) * D + k0 + 8 * c) = o; }
    wave_sync();
}
DEVI void rope_entry(int pos, int i, float& c, float& s) {
    const double inv[8] = {1.0, 0.19392274474868576, 0.03760603093086393, 0.007292664737217109, 0.001414213562373095, 0.0002742481756762073, 5.318295896944988e-05, 1.031338537721246e-05};
    double iv = inv[0];
#pragma unroll
    for (int k = 1; k < 8; ++k) iv = (i == k) ? inv[k] : iv;
    double rev = (double)pos * iv * 0.15915494309189535; rev -= __builtin_rint(rev);
    double q4 = rev * 4.0; const double qn = __builtin_rint(q4); const double t = (q4 - qn) * 1.5707963267948966;
    const double t2 = t * t;
    double sp = t * (1.0 + t2 * (-1.0 / 6 + t2 * (1.0 / 120 + t2 * (-1.0 / 5040 + t2 * (1.0 / 362880 + t2 * (-1.0 / 39916800 + t2 * (1.0 / 6227020800.0)))))));
    double cp = 1.0 + t2 * (-0.5 + t2 * (1.0 / 24 + t2 * (-1.0 / 720 + t2 * (1.0 / 40320 + t2 * (-1.0 / 3628800 + t2 * (1.0 / 479001600.0))))));
    const int qi = ((int)qn) & 3;
    const double cs = (qi == 0) ? cp : (qi == 1) ? -sp : (qi == 2) ? -cp : sp;
    const double sn = (qi == 0) ? sp : (qi == 1) ? cp : (qi == 2) ? -sp : -cp;
    c = (float)cs; s = (float)sn;
}
DEVI int gate_src_col(int cp) { const int pn = cp >> 8, cl = cp & 255, bj = cl >> 7, wc = (cl >> 5) & 3, fq = (cl >> 3) & 3, np = (cl >> 2) & 1, q = cl & 3;
    return 2080 + (2 * bj + np) * D + 64 * pn + 16 * wc + 4 * fq + q; }
DEVI void phase_wconv(KArgs a, unsigned char* lds, int layer, int part, int wg, int nwg) {
    const int tid = launder_tid(), lane = tid & 63, wave = rfl(tid >> 6);
    float* scr = (float*)(lds + wave * 8448);
    const int gw = wg * NWAVES + wave, NGW = nwg * NWAVES;
    const float* Win = a->in[I_WIN] + (size_t)layer * D * DIN_SRC; const float* wup = a->in[I_WUP] + (size_t)layer * 2 * 16 * 128;
    const float* Wbr = a->in[I_WBR] + (size_t)layer * 4 * 256 * D; const float* Wout = a->in[I_WOUT] + (size_t)layer * D * D;
    const float* Wfu = a->in[I_WFU] + (size_t)layer * D * DFF; const float* Wfd = a->in[I_WFD] + (size_t)layer * DFF * D;
    const float* gmix = a->in[I_NMG] + layer * D; const float* gffn = a->in[I_NFG] + layer * D;
    bf16_t* WIN_T = (bf16_t*)(a->ws + OFF_WIN); bf16_t* WBR_T = (bf16_t*)(a->ws + OFF_WBR); bf16_t* WOUT_T = (bf16_t*)(a->ws + OFF_WOUT);
    bf16_t* WUP_T = (bf16_t*)(a->ws + OFF_WUP); bf16_t* WDN_T = (bf16_t*)(a->ws + OFF_WDN);
    constexpr int I_IN = (D / 64) * (NIN / 32), I_BR = 4 * (256 / 64) * (D / 32), I_OUT = (D / 64) * (D / 32), I_UP = (D / 64) * (DFF / 32), I_DN = (DFF / 64) * (D / 32);
    constexpr int NITEMS = I_IN + I_BR + I_OUT + I_UP + I_DN;
    for (int it = gw + (part ? I_IN : 0); it < (part ? NITEMS : I_IN); it += NGW) {
        int r = it;
        if (r < I_IN) { const int nblk = NIN / 32, kb = r / nblk, nb = r % nblk, n0 = nb * 32;
            if (n0 >= C_Z && n0 < C_AQ) zfold_item(Win, wup, WIN_T, kb * 64, n0 - C_Z, scr, lane, gmix);
            else if (n0 < NHB) transpose_item(Win, DIN_SRC, D, WIN_T, kb * 64, n0 < C_Z ? n0 : n0 - 224, n0, scr, lane, gmix);
            else transpose_item(Win, DIN_SRC, D, WIN_T, kb * 64, 0, n0, scr, lane, gmix, gate_src_col(n0 - NHB + (lane & 31)));
            continue; } r -= I_IN;
        if (r < I_BR) { const int br = r / (I_BR / 4), q = r % (I_BR / 4), nblk = D / 32, kb = q / nblk, nb = q % nblk;
            transpose_item(Wbr + (size_t)br * 256 * D, D, D  , WBR_T, br * 256 + kb * 64, nb * 32, nb * 32, scr, lane, nullptr, -1, kb * 64); continue; } r -= I_BR;
        if (r < I_OUT) { const int nblk = D / 32, kb = r / nblk, nb = r % nblk; transpose_item(Wout, D, D, WOUT_T, kb * 64, nb * 32, nb * 32, scr, lane); continue; } r -= I_OUT;
        if (r < I_UP) { const int nblk = DFF / 32, kb = r / nblk, nb = r % nblk; transpose_item(Wfu, DFF, D, WUP_T, kb * 64, nb * 32, nb * 32, scr, lane, gffn); continue; } r -= I_UP;
        { const int nblk = D / 32, kb = r / nblk, nb = r % nblk; transpose_item(Wfd, D, DFF, WDN_T, kb * 64, nb * 32, nb * 32, scr, lane); }
    }
    if (part) return;
    { bf16_t* PWT = (bf16_t*)(a->ws + OFF_PWT); const float* pw = a->in[I_PW] + (size_t)layer * 4 * 64 * 64;
      for (int e = blockIdx.x * NTHREADS + tid; e < 4 * 64 * 64; e += gridDim.x * NTHREADS) { const int g = e >> 12, ee = (e >> 6) & 63, c = e & 63; PWT[e] = (bf16_t)f2bf(pw[(g * 64 + c) * 64 + ee]); } }
    if (layer == 0) { float* rope = (float*)(a->ws + OFF_ROPE);
        for (int e = blockIdx.x * NTHREADS + tid; e < SEQ * 8; e += gridDim.x * NTHREADS) { float c, s; rope_entry(e >> 3, e & 7, c, s); rope[2 * e] = c; rope[2 * e + 1] = s; } }
}

DEVI void phase_x_to_bf16(const float* x, bf16_t* xb, float* part) {
    const int tid = launder_tid(), lane = tid & 63, wave = rfl(tid >> 6);
    const int gw = blockIdx.x * NWAVES + wave, NGW = gridDim.x * NWAVES;
    for (int m = gw; m < M; m += NGW) {
        const f32x4* xr = (const f32x4*)(x + (size_t)m * D) + lane; f32x4 v[4]; float s = 0.f;
#pragma unroll
        for (int j = 0; j < 4; ++j) { v[j] = xr[64 * j]; s += (v[j].x * v[j].x + v[j].y * v[j].y) + (v[j].z * v[j].z + v[j].w * v[j].w); }
        s = wave_sum(s);
        u32x2* o8 = (u32x2*)(xb + (size_t)m * D) + lane;
#pragma unroll
        for (int j = 0; j < 4; ++j) { u32x2 w; w.x = pk2(v[j].x, v[j].y); w.y = pk2(v[j].z, v[j].w); o8[64 * j] = w; }
        if (lane < 16) part[(size_t)m * 16 + lane] = lane == 0 ? s : 0.f;
    }
}
DEVI void phase_final_norm(const bf16_t* xb, const float* g, float* out) {
    const int tid = launder_tid(), lane = tid & 63, wave = rfl(tid >> 6);
    const int gw = blockIdx.x * NWAVES + wave, NGW = gridDim.x * NWAVES;
    f32x4 gv[4];
#pragma unroll
    for (int j = 0; j < 4; ++j) gv[j] = *(const f32x4*)(g + 8 * lane + 512 * (j >> 1) + 4 * (j & 1));
    for (int m = gw; m < M; m += NGW) {
        const u32x4* xr = (const u32x4*)(xb + (size_t)m * D) + lane; f32x4 v[4]; float s = 0.f;
#pragma unroll
        for (int h = 0; h < 2; ++h) { const u32x4 w = xr[64 * h]; v[2 * h] = (f32x4){bflo(w.x), bfhi(w.x), bflo(w.y), bfhi(w.y)}; v[2 * h + 1] = (f32x4){bflo(w.z), bfhi(w.z), bflo(w.w), bfhi(w.w)}; }
#pragma unroll
        for (int j = 0; j < 4; ++j) s += (v[j].x * v[j].x + v[j].y * v[j].y) + (v[j].z * v[j].z + v[j].w * v[j].w);
        const float rstd = rsqf_(wave_sum(s) * (1.f / D) + EPS);
        f32x4* o = (f32x4*)(out + (size_t)m * D) + 2 * lane;
#pragma unroll
        for (int j = 0; j < 4; ++j) o[128 * (j >> 1) + (j & 1)] = v[j] * rstd * gv[j];
    }
}
struct ConvLd { u32x4 av[6], gv[6]; };
DEVI void conv_load(KArgs a, int item, ConvLd& L) {
    const int tid = launder_tid(); const int b = item / (SEQ / 64), t0 = (item % (SEQ / 64)) * 64;
    const bf16_t* HB = (const bf16_t*)(a->ws + OFF_HB);
#pragma unroll
    for (int e_ = 0; e_ < 6; ++e_) { const int e = tid + NTHREADS * e_, ec = e < 94 * 32 ? e : 94 * 32 - 1; const int r = ec >> 5, c8 = ec & 31, t = t0 - 15 + r; const int tc = t < 0 ? 0 : (t >= SEQ ? SEQ - 1 : t);
        const bf16_t* hp = HB + (size_t)(b * SEQ + tc) * NHB + c8 * 8; L.av[e_] = *(const u32x4*)(hp + C_GLUA); L.gv[e_] = *(const u32x4*)(hp + C_GLUG); }
}
template <class Hook> DEVI void conv_compute(KArgs a, unsigned char* lds, int layer, int item, const ConvLd& L, Hook&& hook) {
    const int tid = launder_tid(), lane = tid & 63, wave = rfl(tid >> 6), c = tid & 255, hf = tid >> 8;
    const int b = item / (SEQ / 64), t0 = (item % (SEQ / 64)) * 64;
    bf16_t* Y = (bf16_t*)(a->ws + OFF_Y);
    float* u = (float*)lds;
#pragma unroll
    for (int e_ = 0; e_ < 6; ++e_) { const int e = tid + NTHREADS * e_, ec = e < 94 * 32 ? e : 94 * 32 - 1; const int r = ec >> 5, c8 = ec & 31, t = t0 - 15 + r; const bool inr = t >= 0 && t < SEQ;
        const u32x4 av = L.av[e_], gv = L.gv[e_];
        f32x4 o0 = (f32x4){bflo(av.x) * sigmoidf_(bflo(gv.x)), bfhi(av.x) * sigmoidf_(bfhi(gv.x)), bflo(av.y) * sigmoidf_(bflo(gv.y)), bfhi(av.y) * sigmoidf_(bfhi(gv.y))};
        f32x4 o1 = (f32x4){bflo(av.z) * sigmoidf_(bflo(gv.z)), bfhi(av.z) * sigmoidf_(bfhi(gv.z)), bflo(av.w) * sigmoidf_(bflo(gv.w)), bfhi(av.w) * sigmoidf_(bfhi(gv.w))};
        if (!inr) { o0 = (f32x4){0.f, 0.f, 0.f, 0.f}; o1 = o0; }
        if (e < 94 * 32) { *(f32x4*)(u + r * 256 + c8 * 8) = o0; *(f32x4*)(u + r * 256 + c8 * 8 + 4) = o1; } }
    hook();
    float w[31];
    const float* cw = a->in[I_CW] + (size_t)layer * 31 * 256;
#pragma unroll
    for (int k = 0; k < 31; ++k) w[k] = cw[k * 256 + c];
    const float bias = a->in[I_CB][layer * 256 + c];
    lds_barrier();
    { float acc[32];
#pragma unroll
      for (int i = 0; i < 32; ++i) acc[i] = bias;
      const float* up = u + hf * 32 * 256 + c;
#pragma unroll
      for (int r = 0; r < 62; ++r) { const float v = up[r * 256];
#pragma unroll
          for (int i = 0; i < 32; ++i) if (r - i >= 0 && r - i <= 30) acc[i] += v * w[r - i]; }
      lds_barrier();
#pragma unroll
      for (int i = 0; i < 32; ++i) u[(hf * 32 + i) * 256 + c] = acc[i]; }
    lds_barrier();
    const f32x4 lg = *(const f32x4*)(a->in[I_CLG] + layer * 256 + 4 * lane), lb = *(const f32x4*)(a->in[I_CLB] + layer * 256 + 4 * lane);
#pragma unroll
    for (int bt = 0; bt < 2; ++bt) { f32x4 v[4]; float s[4];
#pragma unroll
      for (int i = 0; i < 4; ++i) { v[i] = *(const f32x4*)(u + (wave * 8 + bt * 4 + i) * 256 + 4 * lane); s[i] = (v[i].x + v[i].y) + (v[i].z + v[i].w); }
#pragma unroll
      for (int o = 1; o < 64; o <<= 1) {
#pragma unroll
          for (int i = 0; i < 4; ++i) s[i] += __shfl_xor(s[i], o); }
#pragma unroll
      for (int i = 0; i < 4; ++i) { v[i] = v[i] - s[i] * (1.f / 256); s[i] = (v[i].x * v[i].x + v[i].y * v[i].y) + (v[i].z * v[i].z + v[i].w * v[i].w); }
#pragma unroll
      for (int o = 1; o < 64; o <<= 1) {
#pragma unroll
          for (int i = 0; i < 4; ++i) s[i] += __shfl_xor(s[i], o); }
#pragma unroll
      for (int i = 0; i < 4; ++i) { const float rstd = rsqf_(s[i] * (1.f / 256) + EPS); const f32x4 ww = v[i] * rstd * lg + lb;
          u32x2 o; o.x = pk2(siluf_(ww.x), siluf_(ww.y)); o.y = pk2(siluf_(ww.z), siluf_(ww.w));
          *(u32x2*)(Y + (size_t)(b * SEQ + t0 + wave * 8 + bt * 4 + i) * D + 0 + 4 * lane) = o; } }
    lds_barrier();
}
constexpr int PD_LD = 264;
struct PoolLd { u32x4 v[5]; };
DEVI void pool_load(KArgs a, int item, PoolLd& L) {
    const int tid = launder_tid(); const int b = item / (SEQ / 64), t0 = (item % (SEQ / 64)) * 64;
    const bf16_t* HB = (const bf16_t*)(a->ws + OFF_HB);
#pragma unroll
    for (int e_ = 0; e_ < 5; ++e_) { const int e = tid + NTHREADS * e_, r = e >> 5, c8 = e & 31, t = t0 - 8 + r; const int tc = t < 0 ? 0 : (t >= SEQ ? SEQ - 1 : t);
        L.v[e_] = *(const u32x4*)(HB + (size_t)(b * SEQ + tc) * NHB + C_PIN + c8 * 8); }
}
template <class Hook> DEVI void pool_compute(KArgs a, unsigned char* lds, int layer, int item, const PoolLd& L, Hook&& hook) {
    const int tid = launder_tid(), lane = tid & 63, wave = rfl(tid >> 6), c = tid & 255, hf = tid >> 8;
    const int b = item / (SEQ / 64), t0 = (item % (SEQ / 64)) * 64;
    bf16_t* Y = (bf16_t*)(a->ws + OFF_Y);
    float* u = (float*)lds; bf16_t* ds = (bf16_t*)(u + 80 * 256);
#pragma unroll
    for (int e_ = 0; e_ < 5; ++e_) { const int e = tid + NTHREADS * e_, r = e >> 5, c8 = e & 31, t = t0 - 8 + r; const bool inr = t >= 0 && t < SEQ; const u32x4 v = L.v[e_];
        f32x4 o0 = (f32x4){bflo(v.x), bfhi(v.x), bflo(v.y), bfhi(v.y)}, o1 = (f32x4){bflo(v.z), bfhi(v.z), bflo(v.w), bfhi(v.w)};
        if (!inr) { o0 = (f32x4){0.f, 0.f, 0.f, 0.f}; o1 = o0; }
        *(f32x4*)(u + r * 256 + c8 * 8) = o0; *(f32x4*)(u + r * 256 + c8 * 8 + 4) = o1; }
    hook();
    lds_barrier();
    { const int gg = c >> 6;
      float uu[48];
      const float* up = u + (hf * 32) * 256 + c;
#pragma unroll
      for (int r = 0; r < 48; ++r) uu[r] = up[r * 256];
      float sm[32];
#pragma unroll
      for (int i = 0; i < 32; ++i) sm[i] = uu[8 + i - 1] + uu[8 + i];
      if (gg >= 1) {
#pragma unroll
          for (int i = 0; i < 32; ++i) sm[i] += uu[8 + i - 2] + uu[8 + i + 1]; }
      if (gg >= 2) {
#pragma unroll
          for (int i = 0; i < 32; ++i) sm[i] += (uu[8 + i - 4] + uu[8 + i - 3]) + (uu[8 + i + 2] + uu[8 + i + 3]); }
      if (gg >= 3) {
#pragma unroll
          for (int i = 0; i < 32; ++i) sm[i] += ((uu[8 + i - 8] + uu[8 + i - 7]) + (uu[8 + i - 6] + uu[8 + i - 5])) + ((uu[8 + i + 4] + uu[8 + i + 5]) + (uu[8 + i + 6] + uu[8 + i + 7])); }
      const int hw = 1 << gg;
#pragma unroll
      for (int i = 0; i < 32; ++i) { const int tt = hf * 32 + i, t = t0 + tt; const int lo = (t - hw) < 0 ? 0 : (t - hw), hi = (t + hw) > SEQ ? SEQ : (t + hw);
          ds[tt * PD_LD + c] = (bf16_t)f2bf(sm[i] / (float)(hi - lo) - uu[8 + i]); } }
    lds_barrier();
    { const int g = wave >> 1, et = wave & 1, r32 = lane & 31, hi = lane >> 5; const bf16_t* PWT = (const bf16_t*)(a->ws + OFF_PWT);
      f32x16 acc0 = {}, acc1 = {};
#pragma unroll
      for (int ks = 0; ks < 4; ++ks) { const bf16x8 af = *(const bf16x8*)(PWT + (size_t)(g * 64 + et * 32 + r32) * 64 + ks * 16 + hi * 8);
          acc0 = mfma32(af, *(const bf16x8*)(ds + r32 * PD_LD + g * 64 + ks * 16 + hi * 8), acc0); acc1 = mfma32(af, *(const bf16x8*)(ds + (32 + r32) * PD_LD + g * 64 + ks * 16 + hi * 8), acc1); }
      const float* psp = a->in[I_PS] + layer * 256 + g * 64 + et * 32 + 4 * hi; bf16_t* yp = Y + (size_t)(b * SEQ + t0 + r32) * D + 768 + g * 64 + et * 32 + 4 * hi;
#pragma unroll
      for (int g4 = 0; g4 < 4; ++g4) { const f32x4 ps = *(const f32x4*)(psp + 8 * g4); u32x2 w0, w1;
          w0.x = pk2(acc0[4 * g4] * ps[0], acc0[4 * g4 + 1] * ps[1]); w0.y = pk2(acc0[4 * g4 + 2] * ps[2], acc0[4 * g4 + 3] * ps[3]); *(u32x2*)(yp + 8 * g4) = w0;
          w1.x = pk2(acc1[4 * g4] * ps[0], acc1[4 * g4 + 1] * ps[1]); w1.y = pk2(acc1[4 * g4 + 2] * ps[2], acc1[4 * g4 + 3] * ps[3]); *(u32x2*)(yp + (size_t)32 * D + 8 * g4) = w1; } }
    lds_barrier();
}
DEVI int crow(int r, int hi) { return (r & 3) + 8 * (r >> 2) + 4 * hi; }
constexpr int KS_LD = 72, VT_LD = 388;
template <class Hook> DEVI void attn_item(KArgs a, unsigned char* lds, int layer, int item, Hook&& hook) {
    const int tid = launder_tid(), lane = tid & 63, wave = rfl(tid >> 6);
    const int b = item / (2 * NAB), kv = (item / NAB) & 1, n = item % NAB;
    const bf16_t* HB = (const bf16_t*)(a->ws + OFF_HB); bf16_t* Y = (bf16_t*)(a->ws + OFF_Y); const float* rope = (const float*)(a->ws + OFF_ROPE);
    bf16_t* Ks = (bf16_t*)lds; bf16_t* Vt = Ks + 384 * KS_LD;
    const int kbase = n * 128 - 128;
    { u32x4 kw[6], vw[6];
#pragma unroll
      for (int e_ = 0; e_ < 6; ++e_) { const int e = tid + NTHREADS * e_, wr = e >> 3, c8 = e & 7, kpos = kbase + wr; const int kc = kpos < 0 ? 0 : (kpos >= SEQ ? SEQ - 1 : kpos);
          const bf16_t* hp = HB + (size_t)(b * SEQ + kc) * NHB; kw[e_] = *(const u32x4*)(hp + C_AK + kv * 64 + c8 * 8); vw[e_] = *(const u32x4*)(hp + C_AV + kv * 64 + c8 * 8); }
      const int rw = tid < 384 ? tid : 383, rpos = kbase + rw, rc = rpos < 0 ? 0 : (rpos >= SEQ ? SEQ - 1 : rpos);
      const bf16_t* rhp = HB + (size_t)(b * SEQ + rc) * NHB + C_AK + kv * 64; const u32x4 x1 = *(const u32x4*)rhp, x2 = *(const u32x4*)(rhp + 8);
      const float* rp = rope + (size_t)rc * 16; const f32x4 r0 = *(const f32x4*)(rp), r1 = *(const f32x4*)(rp + 4), r2 = *(const f32x4*)(rp + 8), r3 = *(const f32x4*)(rp + 12);
#pragma unroll
      for (int e_ = 0; e_ < 6; ++e_) { const int e = tid + NTHREADS * e_, wr = e >> 3, c8 = e & 7, kpos = kbase + wr; const bool inr = kpos >= 0 && kpos < SEQ;
          if (!inr) { kw[e_] = (u32x4){0u, 0u, 0u, 0u}; vw[e_] = kw[e_]; }
          if (c8 >= 2) *(u32x4*)(Ks + wr * KS_LD + c8 * 8) = kw[e_];
#pragma unroll
          for (int j = 0; j < 4; ++j) { Vt[(c8 * 8 + 2 * j) * VT_LD + wr] = (bf16_t)(vw[e_][j] & 0xffffu); Vt[(c8 * 8 + 2 * j + 1) * VT_LD + wr] = (bf16_t)(vw[e_][j] >> 16); } }
      if (tid < 384) { const bool inr = rpos >= 0 && rpos < SEQ; const float rr[16] = {r0[0], r0[1], r0[2], r0[3], r1[0], r1[1], r1[2], r1[3], r2[0], r2[1], r2[2], r2[3], r3[0], r3[1], r3[2], r3[3]};
          float o1[8], o2[8];
#pragma unroll
          for (int j = 0; j < 4; ++j) { const float a0 = bflo(x1[j]), a1 = bfhi(x1[j]), b0 = bflo(x2[j]), b1 = bfhi(x2[j]);
              o1[2 * j] = a0 * rr[4 * j] - b0 * rr[4 * j + 1]; o1[2 * j + 1] = a1 * rr[4 * j + 2] - b1 * rr[4 * j + 3];
              o2[2 * j] = b0 * rr[4 * j] + a0 * rr[4 * j + 1]; o2[2 * j + 1] = b1 * rr[4 * j + 2] + a1 * rr[4 * j + 3]; }
          u32x4 w1 = (u32x4){pk2(o1[0], o1[1]), pk2(o1[2], o1[3]), pk2(o1[4], o1[5]), pk2(o1[6], o1[7])}, w2 = (u32x4){pk2(o2[0], o2[1]), pk2(o2[2], o2[3]), pk2(o2[4], o2[5]), pk2(o2[6], o2[7])};
          if (!inr) { w1 = (u32x4){0u, 0u, 0u, 0u}; w2 = w1; }
          *(u32x4*)(Ks + rw * KS_LD) = w1; *(u32x4*)(Ks + rw * KS_LD + 8) = w2; } }
    const int g = wave >> 2, hq = kv * 2 + g, q0l = (wave & 3) * 32, ql = lane & 31, hi = lane >> 5, qpos = n * 128 + q0l + ql;
    bf16x8 qf[4];
    { const bf16_t* qp = HB + (size_t)(b * SEQ + qpos) * NHB + C_AQ + hq * 64 + hi * 8; const float* rp = rope + (size_t)qpos * 16; const float sg = hi ? 1.f : -1.f;
#pragma unroll
      for (int ds = 0; ds < 4; ++ds) { const u32x4 w = *(const u32x4*)(qp + ds * 16); float v[8];
#pragma unroll
          for (int j = 0; j < 4; ++j) { v[2 * j] = bflo(w[j]); v[2 * j + 1] = bfhi(w[j]); }
          if (ds == 0) {
#pragma unroll
              for (int j = 0; j < 8; ++j) { const float p = __shfl_xor(v[j], 32); v[j] = v[j] * rp[2 * j] + sg * p * rp[2 * j + 1]; } }
          constexpr float QS = 0.125f * LOG2E;
          u32x4 o = (u32x4){pk2(v[0] * QS, v[1] * QS), pk2(v[2] * QS, v[3] * QS), pk2(v[4] * QS, v[5] * QS), pk2(v[6] * QS, v[7] * QS)};
          qf[ds] = __builtin_bit_cast(bf16x8, o); } }
    lds_barrier();
    hook();
    float m2 = a->in[I_SINK][layer * 4 + hq] * LOG2E, l_own = hi ? 0.f : 1.f;
    f32x16 o0 = {}, o1 = {};
    for (int kt = 0; kt < 9; ++kt) {
        const int wb = q0l + 32 * kt, kpos0 = kbase + wb;
        if (kpos0 < 0 || kpos0 >= SEQ) continue;
        f32x16 s = {};
#pragma unroll
        for (int ds = 0; ds < 4; ++ds) { const bf16x8 kf = *(const bf16x8*)(Ks + (wb + ql) * KS_LD + ds * 16 + hi * 8); s = mfma32(kf, qf[ds], s); }
        if (kt == 0) {
#pragma unroll
            for (int r = 0; r < 16; ++r) if (crow(r, hi) < ql) s[r] = -INFINITY; }
        if (kt == 8) {
#pragma unroll
            for (int r = 0; r < 16; ++r) if (crow(r, hi) > ql) s[r] = -INFINITY; }
        float mt = fmaxf(s[0], s[1]);
#pragma unroll
        for (int r = 2; r < 16; ++r) mt = fmaxf(mt, s[r]);
        mt = fmaxf(mt, __shfl_xor(mt, 32));
        const float mn = fmaxf(m2, mt), alpha = ex2(m2 - mn); const bool grew = mn > m2; m2 = mn;
        float ps = 0.f;
#pragma unroll
        for (int r = 0; r < 16; ++r) { s[r] = ex2(s[r] - mn); ps += s[r]; }
        l_own = l_own * alpha + ps;
        if (wave_any(grew)) {
#pragma unroll
            for (int r = 0; r < 16; ++r) { o0[r] *= alpha; o1[r] *= alpha; } }
        bf16x8 pb[2];
#pragma unroll
        for (int sI = 0; sI < 2; ++sI) { u32x4 w = (u32x4){pk2(s[8 * sI + 0], s[8 * sI + 1]), pk2(s[8 * sI + 2], s[8 * sI + 3]), pk2(s[8 * sI + 4], s[8 * sI + 5]), pk2(s[8 * sI + 6], s[8 * sI + 7])}; pb[sI] = __builtin_bit_cast(bf16x8, w); }
#pragma unroll
        for (int sI = 0; sI < 2; ++sI) {
            const bf16_t* v0 = Vt + (size_t)ql * VT_LD + wb + 16 * sI + 4 * hi;
            const s16x4 a0 = *(const s16x4*)(v0), a1 = *(const s16x4*)(v0 + 8), c0 = *(const s16x4*)(v0 + 32 * VT_LD), c1 = *(const s16x4*)(v0 + 32 * VT_LD + 8);
            o0 = mfma32((bf16x8){a0[0], a0[1], a0[2], a0[3], a1[0], a1[1], a1[2], a1[3]}, pb[sI], o0);
            o1 = mfma32((bf16x8){c0[0], c0[1], c0[2], c0[3], c1[0], c1[1], c1[2], c1[3]}, pb[sI], o1); }
    }
    const float linv = 1.0f / (l_own + __shfl_xor(l_own, 32));
    bf16_t* yp = Y + (size_t)(b * SEQ + qpos) * D + 512 + hq * 64 + 4 * hi;
#pragma unroll
    for (int g4 = 0; g4 < 4; ++g4) {
        u32x2 w0, w1; w0.x = pk2(o0[4 * g4] * linv, o0[4 * g4 + 1] * linv); w0.y = pk2(o0[4 * g4 + 2] * linv, o0[4 * g4 + 3] * linv);
        w1.x = pk2(o1[4 * g4] * linv, o1[4 * g4 + 1] * linv); w1.y = pk2(o1[4 * g4 + 2] * linv, o1[4 * g4 + 3] * linv);
        *(u32x2*)(yp + 8 * g4) = w0; *(u32x2*)(yp + 32 + 8 * g4) = w1; }
    lds_barrier();
}
DEVI void gla_ld16(const bf16_t* p, unsigned (&r)[16]) {
#pragma unroll
    for (int jj = 0; jj < 16; ++jj) r[jj] = p[(size_t)jj * NHB];
}
DEVI void gla_prep(const unsigned (&zraw)[16], float bu, int t, float* tot4  , float (&bcum)[16], float& total) {
    const int d = t & 31, dir = (t >> 5) & 1, seg = t >> 6;
    float lg[16];
#pragma unroll
    for (int jj = 0; jj < 16; ++jj) lg[jj] = logsigf_(bf2f(zraw[jj]) + bu) * (1.f / 16.f);
    float acc = 0.f;
    if (dir == 0) {
#pragma unroll
        for (int jj = 0; jj < 16; ++jj) { acc += lg[jj]; bcum[jj] = acc; } }
    else {
#pragma unroll
        for (int jj = 15; jj >= 0; --jj) { acc += lg[jj]; bcum[jj] = acc; } }
    tot4[seg * 64 + dir * 32 + d] = acc;
    lds_barrier();
    const float t0 = tot4[dir * 32 + d], t1 = tot4[64 + dir * 32 + d], t2 = tot4[128 + dir * 32 + d], t3 = tot4[192 + dir * 32 + d];
    total = (t0 + t1) + (t2 + t3);
    float off;
    if (dir == 0) off = (seg > 0 ? t0 : 0.f) + (seg > 1 ? t1 : 0.f) + (seg > 2 ? t2 : 0.f);
    else off = (seg < 3 ? t3 : 0.f) + (seg < 2 ? t2 : 0.f) + (seg < 1 ? t1 : 0.f);
#pragma unroll
    for (int jj = 0; jj < 16; ++jj) bcum[jj] += off;
}
constexpr int GVT_LD = 72, GQ_LD = 40;
DEVI void gla_load_v(const bf16_t* hrow0, int h, int t, u32x4 (&vw)[2]) {
#pragma unroll
    for (int e8_ = 0; e8_ < 2; ++e8_) { const int e8 = t + 256 * e8_, j = e8 >> 3, c8 = e8 & 7; vw[e8_] = *(const u32x4*)(hrow0 + (size_t)j * NHB + C_GV + h * 64 + c8 * 8); }
}
DEVI void gla_stage_vt(const u32x4 (&vw)[2], int t, bf16_t* Vt) {
#pragma unroll
    for (int e8_ = 0; e8_ < 2; ++e8_) { const int e8 = t + 256 * e8_, j = e8 >> 3, c8 = e8 & 7;
#pragma unroll
        for (int q = 0; q < 4; ++q) { Vt[(c8 * 8 + 2 * q) * GVT_LD + j] = (bf16_t)(vw[e8_][q] & 0xffffu); Vt[(c8 * 8 + 2 * q + 1) * GVT_LD + j] = (bf16_t)(vw[e8_][q] >> 16); } }
}
constexpr int GX_HALF = 9216 + 9216 + 1024;
struct GxLd { unsigned z[16], k[16]; u32x4 vw[2]; float bu; };
DEVI void gla_x_load(KArgs a, int layer, int pair, GxLd& L) {
    const int tid = launder_tid(), wave = rfl(tid >> 6), hf = wave >> 2, t = tid & 255;
    constexpr int N_GX = BATCH * NCH * 4;
    const int item = pair * 2 + hf; const int it_ = item < N_GX ? item : 0;
    const int h = it_ & 3, c = (it_ >> 2) % NCH, b = it_ / (4 * NCH);
    const bf16_t* hrow0 = (const bf16_t*)(a->ws + OFF_HB) + (size_t)(b * SEQ + c * 64) * NHB;
    const int d = t & 31, dir = (t >> 5) & 1, seg = t >> 6; const bf16_t* rp = hrow0 + (size_t)(seg * 16) * NHB + h * 32 + d;
    gla_ld16(rp + C_Z + dir * 128, L.z); gla_ld16(rp + C_GK, L.k); gla_load_v(hrow0, h, t, L.vw);
    L.bu = a->in[I_BUP][(size_t)layer * 256 + dir * 128 + h * 32 + d];
}
DEVI void gla_x_compute(KArgs a, unsigned char* lds, int layer, int pair, const GxLd& L) {
    const int tid = launder_tid(), lane = tid & 63, wave = rfl(tid >> 6), hf = wave >> 2, t = tid & 255, w4 = wave & 3;
    constexpr int N_GX = BATCH * NCH * 4;
    const int item = pair * 2 + hf; const bool act = item < N_GX; const int it_ = act ? item : 0;
    const int h = it_ & 3, c = (it_ >> 2) % NCH, b = it_ / (4 * NCH);
    unsigned char* base = lds + hf * GX_HALF;
    bf16_t* Kht = (bf16_t*)base; bf16_t* Vt = (bf16_t*)(base + 9216); float* tot4 = (float*)(base + 18432);
    float bc[16], total;
    gla_stage_vt(L.vw, t, Vt);
    gla_prep(L.z, L.bu, t, tot4, bc, total);
    { const int d = t & 31, dir = (t >> 5) & 1, seg = t >> 6;
      unsigned w[8];
#pragma unroll
      for (int q = 0; q < 8; ++q) { const float k0 = bf2f(L.k[2 * q]), k1 = bf2f(L.k[2 * q + 1]);
          w[q] = pk2(k0 * ex2((total - bc[2 * q]) * LOG2E), k1 * ex2((total - bc[2 * q + 1]) * LOG2E)); }
      u32x4* dst = (u32x4*)(Kht + (dir * 32 + d) * GVT_LD + seg * 16); dst[0] = (u32x4){w[0], w[1], w[2], w[3]}; dst[1] = (u32x4){w[4], w[5], w[6], w[7]};
      if (seg == 0 && act) ((float*)(a->ws + OFF_GD))[((size_t)((b * 4 + h) * 2 + dir) * NCH + c) * 32 + d] = ex2(total * LOG2E); }
    lds_barrier();
    { const int et = w4 & 1, dir = w4 >> 1, r32 = lane & 31, hi = lane >> 5; f32x16 u = {};
#pragma unroll
      for (int ks = 0; ks < 4; ++ks) { const bf16x8 af = *(const bf16x8*)(Vt + (et * 32 + r32) * GVT_LD + ks * 16 + hi * 8), bfr = *(const bf16x8*)(Kht + (dir * 32 + r32) * GVT_LD + ks * 16 + hi * 8); u = mfma32(af, bfr, u); }
      if (act) { float* gu = (float*)(a->ws + OFF_GU) + ((size_t)((b * 4 + h) * 2 + dir) * NCH + c) * 2048;
#pragma unroll
          for (int r = 0; r < 16; ++r) gu[(et * 32 + crow(r, hi)) * 32 + r32] = u[r]; } }
    lds_barrier();
}
DEVI void gla_scan(KArgs a) {
    float* GU = (float*)(a->ws + OFF_GU); const float* GD = (const float*)(a->ws + OFF_GD);
    constexpr int TOTAL = BATCH * 4 * 2 * 2048, UNR = (NCH % 16 == 0) ? 16 : 4;
    const int tid = launder_tid(); if (tid >= 128) return;
    for (int eid = blockIdx.x * 128 + tid; eid < TOTAL; eid += gridDim.x * 128) {
        const int seq = eid >> 11, de = eid & 2047, d = de & 31, dir = seq & 1; float S = 0.f;
        for (int s0 = 0; s0 < NCH; s0 += UNR) { float u[UNR], dc[UNR];
#pragma unroll
            for (int k = 0; k < UNR; ++k) { const int c = dir ? NCH - 1 - (s0 + k) : s0 + k; u[k] = GU[((size_t)seq * NCH + c) * 2048 + de]; dc[k] = GD[((size_t)seq * NCH + c) * 32 + d]; }
#pragma unroll
            for (int k = 0; k < UNR; ++k) { const int c = dir ? NCH - 1 - (s0 + k) : s0 + k; GU[((size_t)seq * NCH + c) * 2048 + de] = S; S = dc[k] * S + u[k]; } }
    }
}
constexpr int GZ_HALF = 10240 + 10240 + 9216 + 10240 + 1024 + 512;
struct GzLd { unsigned z[16], q[16], k[16]; u32x4 vw[2]; f32x4 s[4]; float bu; };
DEVI void gla_z_load(KArgs a, int layer, int pair, GzLd& L) {
    const int tid = launder_tid(), wave = rfl(tid >> 6), hf = wave >> 2, t = tid & 255;
    constexpr int N_GZ = BATCH * NCH * 4;
    const int item = pair * 2 + hf; const int it_ = item < N_GZ ? item : 0;
    const int h = it_ & 3, c = (it_ >> 2) % NCH, b = it_ / (4 * NCH);
    const bf16_t* hrow0 = (const bf16_t*)(a->ws + OFF_HB) + (size_t)(b * SEQ + c * 64) * NHB;
    const int d = t & 31, dir = (t >> 5) & 1, seg = t >> 6; const bf16_t* rp = hrow0 + (size_t)(seg * 16) * NHB + h * 32 + d;
    gla_ld16(rp + C_Z + dir * 128, L.z); gla_ld16(rp + C_GQ, L.q); gla_ld16(rp + C_GK, L.k); gla_load_v(hrow0, h, t, L.vw);
    L.bu = a->in[I_BUP][(size_t)layer * 256 + dir * 128 + h * 32 + d];
    const float* GU = (const float*)(a->ws + OFF_GU);
#pragma unroll
    for (int e4_ = 0; e4_ < 4; ++e4_) { const int e4 = t + 256 * e4_, dr = e4 >> 9, ed = (e4 & 511) * 4; L.s[e4_] = *(const f32x4*)(GU + ((size_t)((b * 4 + h) * 2 + dr) * NCH + c) * 2048 + ed); }
}
DEVI void gla_z_compute(KArgs a, unsigned char* lds, int layer, int pair, const GzLd& L) {
    const int tid = launder_tid(), lane = tid & 63, wave = rfl(tid >> 6), hf = wave >> 2, t = tid & 255, w4 = wave & 3;
    constexpr int N_GZ = BATCH * NCH * 4;
    const int item = pair * 2 + hf; const bool act = item < N_GZ; const int it_ = act ? item : 0;
    const int h = it_ & 3, c = (it_ >> 2) % NCH, b = it_ / (4 * NCH);
    const bf16_t* hrow0 = (const bf16_t*)(a->ws + OFF_HB) + (size_t)(b * SEQ + c * 64) * NHB;
    unsigned char* base = lds + hf * GZ_HALF;
    bf16_t* Qs = (bf16_t*)base; bf16_t* Ks = (bf16_t*)(base + 10240); bf16_t* Vt = (bf16_t*)(base + 20480); bf16_t* St = (bf16_t*)(base + 29696);
    float* tot4 = (float*)(base + 39936); float* rsum = (float*)(base + 40960);
    float bc[16], total;
    gla_stage_vt(L.vw, t, Vt);
#pragma unroll
    for (int e4_ = 0; e4_ < 4; ++e4_) { const int e4 = t + 256 * e4_, dir = e4 >> 9, ed = (e4 & 511) * 4, e = ed >> 5, d0 = ed & 31;
        u32x2 w; w.x = pk2(L.s[e4_][0], L.s[e4_][1]); w.y = pk2(L.s[e4_][2], L.s[e4_][3]); *(u32x2*)(St + (dir * 64 + e) * GQ_LD + d0) = w; }
    gla_prep(L.z, L.bu, t, tot4, bc, total);
    { const int d = t & 31, dir = (t >> 5) & 1, seg = t >> 6;
#pragma unroll
      for (int jj = 0; jj < 16; ++jj) { const float q = bf2f(L.q[jj]) * 0.17677669529663687f, k = bf2f(L.k[jj]); const float bb = bc[jj] * LOG2E;
          Qs[(dir * 64 + seg * 16 + jj) * GQ_LD + d] = (bf16_t)f2bf(q * ex2(bb)); Ks[(dir * 64 + seg * 16 + jj) * GQ_LD + d] = (bf16_t)f2bf(k * ex2(-bb)); } }
    lds_barrier();
    const int itl = w4 & 1, et = w4 >> 1, r32 = lane & 31, hi = lane >> 5;
    bf16x8 qf[2][2];
#pragma unroll
    for (int dir = 0; dir < 2; ++dir)
#pragma unroll
        for (int ks = 0; ks < 2; ++ks) qf[dir][ks] = *(const bf16x8*)(Qs + (dir * 64 + itl * 32 + r32) * GQ_LD + ks * 16 + hi * 8);
    f32x16 o = {};
#pragma unroll
    for (int jt = 0; jt < 2; ++jt) {
        f32x16 xa = {};
        if (jt == itl) { f32x16 xf = {}, xb = {};
#pragma unroll
            for (int ks = 0; ks < 2; ++ks) { xf = mfma32(*(const bf16x8*)(Ks + (jt * 32 + r32) * GQ_LD + ks * 16 + hi * 8), qf[0][ks], xf);
                                             xb = mfma32(*(const bf16x8*)(Ks + (64 + jt * 32 + r32) * GQ_LD + ks * 16 + hi * 8), qf[1][ks], xb); }
#pragma unroll
            for (int r = 0; r < 16; ++r) { const int jl = crow(r, hi); xa[r] = (jl <= r32 ? xf[r] : 0.f) + (jl >= r32 ? xb[r] : 0.f); } }
        else { const int dir = jt < itl ? 0 : 1;
#pragma unroll
            for (int ks = 0; ks < 2; ++ks) xa = mfma32(*(const bf16x8*)(Ks + (dir * 64 + jt * 32 + r32) * GQ_LD + ks * 16 + hi * 8), qf[dir][ks], xa); }
#pragma unroll
        for (int s = 0; s < 2; ++s) { const u32x4 w = (u32x4){pk2(xa[8 * s + 0], xa[8 * s + 1]), pk2(xa[8 * s + 2], xa[8 * s + 3]), pk2(xa[8 * s + 4], xa[8 * s + 5]), pk2(xa[8 * s + 6], xa[8 * s + 7])};
            const bf16_t* vp = Vt + (et * 32 + r32) * GVT_LD + jt * 32 + 16 * s + 4 * hi; const s16x4 a0 = *(const s16x4*)vp, a1 = *(const s16x4*)(vp + 8);
            o = mfma32((bf16x8){a0[0], a0[1], a0[2], a0[3], a1[0], a1[1], a1[2], a1[3]}, __builtin_bit_cast(bf16x8, w), o); } }
#pragma unroll
    for (int dir = 0; dir < 2; ++dir)
#pragma unroll
        for (int ks = 0; ks < 2; ++ks) o = mfma32(*(const bf16x8*)(St + (dir * 64 + et * 32 + r32) * GQ_LD + ks * 16 + hi * 8), qf[dir][ks], o);
    float ss = 0.f;
#pragma unroll
    for (int r = 0; r < 16; ++r) ss += o[r] * o[r];
    ss += __shfl_xor(ss, 32);
    if (hi == 0) rsum[et * 64 + itl * 32 + r32] = ss;
    lds_barrier();
    if (act) { const int il = itl * 32 + r32; const float rstd = rsqf_((rsum[il] + rsum[64 + il]) * (1.f / 64.f) + EPS);
        const bf16_t* grp = hrow0 + (size_t)il * NHB + C_GR + h * 64 + et * 32 + 4 * hi; const float* ngp = a->in[I_GNG] + layer * 256 + h * 64 + et * 32 + 4 * hi;
        bf16_t* yp = (bf16_t*)(a->ws + OFF_Y) + (size_t)(b * SEQ + c * 64 + il) * D + 256 + h * 64 + et * 32 + 4 * hi;
#pragma unroll
        for (int g4 = 0; g4 < 4; ++g4) { const u32x2 gw = *(const u32x2*)(grp + 8 * g4); const f32x4 ng = *(const f32x4*)(ngp + 8 * g4);
            u32x2 w; w.x = pk2(o[4 * g4] * rstd * ng[0] * siluf_(bflo(gw.x)), o[4 * g4 + 1] * rstd * ng[1] * siluf_(bfhi(gw.x)));
            w.y = pk2(o[4 * g4 + 2] * rstd * ng[2] * siluf_(bflo(gw.y)), o[4 * g4 + 3] * rstd * ng[3] * siluf_(bfhi(gw.y)));
            *(u32x2*)(yp + 8 * g4) = w; } }
    lds_barrier();
}
DEVI void phase_mix1(KArgs a, unsigned char* lds, int layer) {
    constexpr int N_RND = BATCH * 2 * NAB, N_GXP = BATCH * NCH * 4 / 2;
    static_assert(BATCH * (SEQ / 64) == N_RND && N_GXP == 2 * N_RND, "one conv tile, one pool tile and two GLA pairs per attention block");
    for (int r = blockIdx.x; r < N_RND; r += gridDim.x) {
        ConvLd lc; PoolLd lp; GxLd lx0, lx1;
        attn_item(a, lds, layer, r, [&] { conv_load(a, r, lc); });
        conv_compute(a, lds, layer, r, lc, [&] { pool_load(a, r, lp); });
        pool_compute(a, lds, layer, r, lp, [&] { gla_x_load(a, layer, r, lx0); });
        gla_x_load(a, layer, r + N_RND, lx1);
        gla_x_compute(a, lds, layer, r, lx0); gla_x_compute(a, lds, layer, r + N_RND, lx1); }
}
DEVI void phase_mix3(KArgs a, unsigned char* lds, int layer) {
    constexpr int N_GZP = BATCH * NCH * 4 / 2;
    for (int it = blockIdx.x; it < N_GZP; it += 2 * gridDim.x) { const int it2 = it + gridDim.x; GzLd L0, L1;
        gla_z_load(a, layer, it, L0); if (it2 < N_GZP) gla_z_load(a, layer, it2, L1);
        gla_z_compute(a, lds, layer, it, L0); if (it2 < N_GZP) gla_z_compute(a, lds, layer, it2, L1); }
}

namespace pg8 {
constexpr int BM = 256, BK = 64, HALF = 128, HTB = HALF * BK * 2, STAGE_BYTES = 8 * HTB, NXCD = 8, WGM = 8;
DEVI int lds_byte(int r, int c) { const int st = (r >> 4) * 2 + (c >> 5), rr = r & 15, cc = c & 31, ob = rr * 64 + cc * 2; return st * 1024 + (ob ^ (((ob >> 9) & 1) << 5)); }
DEVI void stage_rc(int b, int& R, int& C) { const int st = b / 1024, sb = b % 1024, swz = sb ^ (((sb >> 9) & 1) << 5); R = (st >> 1) * 16 + swz / 64; C = (st & 1) * 32 + (swz % 64) / 2; }
DEVI int perm32(int rho) { const int n = rho >> 4, i = rho & 15; return 8 * (i >> 2) + 4 * n + (i & 3); }
typedef pg8_unit_fwd Unit;
struct Gemm { const bf16_t* A; const bf16_t* Bt; };
struct StaticOrder {
    int nM, nN, nwg, G, c;
    DEVM void init(int Mr, int N, int G_, int c_) { nM = Mr / BM; nN = N / BM; nwg = nM * nN; G = G_; c = c_; }
    DEVM bool tile(long L, Unit& u) const {
        if (L >= nwg) return false;
        int wgid = (int)L; { const int q = nwg / NXCD, r = nwg % NXCD, xcd = wgid % NXCD, off = wgid / NXCD; wgid = (xcd < r ? xcd * (q + 1) : r * (q + 1) + (xcd - r) * q) + off; }
        const int nig = WGM * nN, gid = wgid / nig, fm = gid * WGM, gsz = (nM - fm) < WGM ? (nM - fm) : WGM;
        u.pm = fm + ((wgid % nig) % gsz); u.pn = (wgid % nig) / gsz; u.br = 0; return true;
    }
    typedef Unit unit_t;
    DEVM bool next(int i, Unit& u) const { u.ui = i; return tile((long)i * G + c, u); }
};
template <class Sched> DEVM void fill_rstd(const Sched& S, const float* part, float* tab) {
    const int tid = threadIdx.x; Unit u;
    if (tid < 256) for (int ui = 0; S.next(ui, u); ++ui) { const f32x4* p = (const f32x4*)(part + (size_t)(u.pm * 256 + tid) * 16); const f32x4 s = (p[0] + p[1]) + (p[2] + p[3]);
        tab[ui * 256 + tid] = rsqf_(((s.x + s.y) + (s.z + s.w)) * (1.f / D) + EPS); }
}
template <int ACT  > struct EpiBf16 {
    static constexpr bool PERM = true, HAS_MID = false, HAS_INIT = false;
    bf16_t* O; int ldc; float* tab; const float* part;
    template <class Sched> DEVM void pre(const Sched& S) const { fill_rstd(S, part, tab); }
    DEVM void operator()(const f32x4 (&acc)[2][2][4][2], const Unit& u, int wr, int wc, int fr, int fq) const {
        const int row0 = u.pm * BM + wr * 64 + fr, col0 = u.pn * BM + wc * 32 + 8 * fq;
#pragma unroll
        for (int ai = 0; ai < 2; ++ai)
#pragma unroll
            for (int m = 0; m < 4; ++m) { bf16_t* rowp = O + (size_t)(row0 + ai * HALF + m * 16) * ldc + col0; const float rs = tab[u.ui * 256 + ai * HALF + wr * 64 + m * 16 + fr];
#pragma unroll
                for (int bj = 0; bj < 2; ++bj) { f32x4 v0 = acc[ai][bj][m][0] * rs, v1 = acc[ai][bj][m][1] * rs;
                    if (ACT == 1) {
#pragma unroll
                        for (int q = 0; q < 4; ++q) { v0[q] = sigmoidf_(v0[q]); v1[q] = sigmoidf_(v1[q]); } }
                    if (ACT == 2) {
#pragma unroll
                        for (int q = 0; q < 4; ++q) { const float r0 = fmaxf(v0[q], 0.f), r1 = fmaxf(v1[q], 0.f); v0[q] = r0 * r0; v1[q] = r1 * r1; } }
                    u32x4 w; w.x = pk2(v0[0], v0[1]); w.y = pk2(v0[2], v0[3]); w.z = pk2(v1[0], v1[1]); w.w = pk2(v1[2], v1[3]);
                    *(u32x4*)(rowp + bj * HALF) = w; } }
    }
};
struct EpiGate {
    static constexpr bool PERM = true, HAS_MID = false, HAS_INIT = false;
    bf16_t* R; float* tab; const float* part;
    template <class Sched> DEVM void pre(const Sched& S) const { fill_rstd(S, part, tab); }
    DEVM void operator()(const f32x4 (&acc)[2][2][4][2], const Unit& u, int wr, int wc, int fr, int fq) const {
        const int row0 = u.pm * BM + wr * 64 + fr, d0 = u.pn * 64 + wc * 16 + 4 * fq;
#pragma unroll
        for (int ai = 0; ai < 2; ++ai)
#pragma unroll
            for (int m = 0; m < 4; ++m) { bf16_t* rowp = R + (size_t)(row0 + ai * HALF + m * 16) * NGATE + d0; const float rs = tab[u.ui * 256 + ai * HALF + wr * 64 + m * 16 + fr] * LOG2E;
                float r[4][4];
#pragma unroll
                for (int q = 0; q < 4; ++q) { float den[4];
#pragma unroll
                    for (int b = 0; b < 4; ++b) den[b] = 1.0f + ex2(-acc[ai][b >> 1][m][b & 1][q] * rs);
                    const float i0 = rcpf_(den[0]), i1 = rcpf_(den[1]), i2 = rcpf_(den[2]), i3 = rcpf_(den[3]);
                    r[0][q] = den[1] * i0; r[1][q] = den[2] * i1; r[2][q] = den[3] * i2; r[3][q] = i3; }
#pragma unroll
                for (int b = 0; b < 4; ++b) { u32x2 w; w.x = pk2(r[b][0], r[b][1]); w.y = pk2(r[b][2], r[b][3]); *(u32x2*)(rowp + b * D) = w; } }
    }
};
struct EpiMerge {
    static constexpr bool PERM = true, HAS_MID = true, HAS_INIT = false;
    bf16_t* O; const bf16_t* R;
    template <class Sched> DEVM void pre(const Sched&) const {}
    DEVM void scale(f32x4 (&acc)[2][2][4][2], const Unit& u, int b, int wr, int wc, int fr, int fq) const {
        const int row0 = u.pm * BM + wr * 64 + fr, col0 = u.pn * BM + wc * 32 + 8 * fq;
#pragma unroll
        for (int ai = 0; ai < 2; ++ai)
#pragma unroll
            for (int m = 0; m < 4; ++m) { const unsigned go = ((unsigned)(row0 + ai * HALF + m * 16) * NGATE + b * D + col0) * 2u;
#pragma unroll
                for (int bj = 0; bj < 2; ++bj) { const u32x4 gw = *(const u32x4*)((const char*)R + go + bj * HALF * 2);
                    acc[ai][bj][m][0] *= (f32x4){bflo(gw.x), bfhi(gw.x), bflo(gw.y), bfhi(gw.y)}; acc[ai][bj][m][1] *= (f32x4){bflo(gw.z), bfhi(gw.z), bflo(gw.w), bfhi(gw.w)}; }
#ifndef CPU_EMU
                if (m == 3) asm volatile("" ::: "memory");
#endif
            }
    }
    DEVM void mid(f32x4 (&acc)[2][2][4][2], const Unit& u, int b, int wr, int wc, int fr, int fq) const { scale(acc, u, b, wr, wc, fr, fq); }
    DEVM void operator()(f32x4 (&acc)[2][2][4][2], const Unit& u, int wr, int wc, int fr, int fq) const {
        scale(acc, u, 3, wr, wc, fr, fq);
        const int row0 = u.pm * BM + wr * 64 + fr, col0 = u.pn * BM + wc * 32 + 8 * fq;
#pragma unroll
        for (int ai = 0; ai < 2; ++ai)
#pragma unroll
            for (int m = 0; m < 4; ++m) { bf16_t* rowp = O + (size_t)(row0 + ai * HALF + m * 16) * D + col0;
#pragma unroll
                for (int bj = 0; bj < 2; ++bj) { const f32x4 v0 = acc[ai][bj][m][0], v1 = acc[ai][bj][m][1];
                    u32x4 w; w.x = pk2(v0[0], v0[1]); w.y = pk2(v0[2], v0[3]); w.z = pk2(v1[0], v1[1]); w.w = pk2(v1[2], v1[3]); *(u32x4*)(rowp + bj * HALF) = w; } }
    }
};
struct EpiResNorm {
    static constexpr bool PERM = true, HAS_MID = false, HAS_INIT = true;
    const bf16_t* base; bf16_t* xb; float* part;
    template <class Sched> DEVM void pre(const Sched&) const {}
    DEVM void init(f32x4 (&acc)[2][2][4][2], const Unit& u, int wr, int wc, int fr, int fq) const {
        const int row0 = u.pm * BM + wr * 64 + fr, col0 = u.pn * BM + wc * 32 + 8 * fq;
#pragma unroll
        for (int ai = 0; ai < 2; ++ai)
#pragma unroll
            for (int m = 0; m < 4; ++m) { const unsigned off = ((unsigned)(row0 + ai * HALF + m * 16) * D + col0) * 2u;
#pragma unroll
                for (int bj = 0; bj < 2; ++bj) { const u32x4 bw = *(const u32x4*)((const char*)base + off + bj * HALF * 2);
                    acc[ai][bj][m][0] = (f32x4){bflo(bw.x), bfhi(bw.x), bflo(bw.y), bfhi(bw.y)}; acc[ai][bj][m][1] = (f32x4){bflo(bw.z), bfhi(bw.z), bflo(bw.w), bfhi(bw.w)}; } }
    }
    DEVM void operator()(const f32x4 (&acc)[2][2][4][2], const Unit& u, int wr, int wc, int fr, int fq) const {
        const int row0 = u.pm * BM + wr * 64 + fr, col0 = u.pn * BM + wc * 32 + 8 * fq;
#pragma unroll
        for (int ai = 0; ai < 2; ++ai)
#pragma unroll
            for (int m = 0; m < 4; ++m) { const unsigned row = (unsigned)(row0 + ai * HALF + m * 16), off = (row * D + col0) * 2u; float ss = 0.f;
#pragma unroll
                for (int bj = 0; bj < 2; ++bj) { const f32x4 v0 = acc[ai][bj][m][0], v1 = acc[ai][bj][m][1];
                    u32x4 w; w.x = pk2(v0[0], v0[1]); w.y = pk2(v0[2], v0[3]); w.z = pk2(v1[0], v1[1]); w.w = pk2(v1[2], v1[3]);
                    *(u32x4*)((char*)xb + off + bj * HALF * 2) = w;
                    const float x0 = bflo(w.x), x1 = bfhi(w.x), x2 = bflo(w.y), x3 = bfhi(w.y), x4 = bflo(w.z), x5 = bfhi(w.z), x6 = bflo(w.w), x7 = bfhi(w.w);
                    ss += ((x0 * x0 + x1 * x1) + (x2 * x2 + x3 * x3)) + ((x4 * x4 + x5 * x5) + (x6 * x6 + x7 * x7)); }
                ss += __shfl_xor(ss, 16); ss += __shfl_xor(ss, 32);
                if (fq == 0) part[(size_t)row * 16 + u.pn * 4 + wc] = ss; }
    }
};
#ifndef CPU_EMU
#define PG8_LAS __attribute__((address_space(3)))
template <class Epi, class Sched, int KDIM, bool ALIGN_EPI = true>
__device__ __forceinline__ void gemm_phase(PG8_LAS unsigned char* lds, const Gemm g, const Sched& S, const Epi& E) {
    int tid_ = threadIdx.x; asm volatile("" : "+v"(tid_));
    const int tid = tid_, wid = __builtin_amdgcn_readfirstlane(tid >> 6), lane = tid & 63, wr = wid >> 2, wc = wid & 3, fr = lane & 15, fq = lane >> 4;
    constexpr int nt = KDIM / BK;
    unsigned voffA[2], voffB[2];
#pragma unroll
    for (int i = 0; i < 2; ++i) { int R, C; stage_rc(tid * 16 + i * 8192, R, C); const int Rb = Epi::PERM ? ((R & ~31) + perm32(R & 31)) : R;
        voffA[i] = (unsigned)(R * KDIM + C) * 2u; voffB[i] = (unsigned)(Rb * KDIM + C) * 2u; }
    constexpr size_t kstep = (size_t)(BK * 2);
    constexpr size_t hstepA = (size_t)HALF * KDIM * 2, hstepB = hstepA;
    constexpr size_t tstepA = 2 * hstepA, tstepB = 2 * hstepB;
    const unsigned ldsw = (unsigned)wid * 1024u;
    const int aoff = lds_byte(wr * 64 + fr, fq * 8), boff = lds_byte(wc * 32 + fr, fq * 8);
#define PG8_SA(b, h) (((b) * 2 + (h)) * HTB)
#define PG8_SB(b, h) ((4 + (b) * 2 + (h)) * HTB)
#define PG8_STAGE(bufoff, gbase, voff) do { _Pragma("unroll") for (int _i = 0; _i < 2; ++_i) \
        __builtin_amdgcn_global_load_lds((const unsigned*)((const char*)(gbase) + (voff)[_i]), (PG8_LAS unsigned*)(lds + (bufoff) + ldsw + _i * 8192), 16, 0, 0); } while (0)
#define PG8_LDA(dst, b, h) do { _Pragma("unroll") for (int m = 0; m < 4; ++m) _Pragma("unroll") for (int k = 0; k < 2; ++k) dst[m][k] = *(const PG8_LAS bf16x8*)(lds + PG8_SA(b, h) + aoff + m * 2048 + k * 1024); } while (0)
#define PG8_LDB(dst, b, h) do { _Pragma("unroll") for (int n = 0; n < 2; ++n) _Pragma("unroll") for (int k = 0; k < 2; ++k) dst[n][k] = *(const PG8_LAS bf16x8*)(lds + PG8_SB(b, h) + boff + n * 2048 + k * 1024); } while (0)
#define PG8_MMA(ai, bj, At, Bt) do { __builtin_amdgcn_s_setprio(1); _Pragma("unroll") for (int m = 0; m < 4; ++m) _Pragma("unroll") for (int n = 0; n < 2; ++n) _Pragma("unroll") for (int k = 0; k < 2; ++k) \
        acc[ai][bj][m][n] = __builtin_amdgcn_mfma_f32_16x16x32_bf16(Bt[n][k], At[m][k], acc[ai][bj][m][n], 0, 0, 0); __builtin_amdgcn_s_setprio(0); } while (0)
#define PG8_WAIT_V(n) asm volatile("s_waitcnt vmcnt(" #n ")" ::: "memory")
#define PG8_WAIT_L(n) asm volatile("s_waitcnt lgkmcnt(" #n ")" ::: "memory")
#define PG8_BAR __builtin_amdgcn_s_barrier()
#define PG8_SCHED __builtin_amdgcn_sched_barrier(0)
#define PG8_ABASE(u) ((const char*)g.A + (size_t)(u).pm * tstepA)
#define PG8_BBASE(u) ((const char*)g.Bt + (size_t)(u).pn * tstepB)
    Unit cur, nxt; int ui = 0;
    if (!S.next(0, cur)) return;
    f32x4 acc[2][2][4][2];
#pragma unroll
    for (int a = 0; a < 2; ++a)
#pragma unroll
        for (int b = 0; b < 2; ++b)
#pragma unroll
            for (int m = 0; m < 4; ++m)
#pragma unroll
                for (int n = 0; n < 2; ++n) acc[a][b][m][n] = (f32x4){0.f, 0.f, 0.f, 0.f};
    if constexpr (Epi::HAS_INIT) E.init(acc, cur, wr, wc, fr, fq);
    bf16x8 At[4][2], B0[2][2], B1[2][2];
    const char* cA = PG8_ABASE(cur); const char* cB = PG8_BBASE(cur);
    PG8_STAGE(PG8_SB(0, 0), cB, voffB); PG8_STAGE(PG8_SB(0, 1), cB + hstepB, voffB); PG8_STAGE(PG8_SA(0, 0), cA, voffA); PG8_STAGE(PG8_SA(0, 1), cA + hstepA, voffA);
    E.pre(S);
    if (wr == 1) PG8_BAR;
    PG8_WAIT_V(2); PG8_BAR;
    PG8_STAGE(PG8_SB(1, 0), cB + kstep, voffB); PG8_STAGE(PG8_SA(1, 0), cA + kstep, voffA); PG8_STAGE(PG8_SB(1, 1), cB + hstepB + kstep, voffB);
    PG8_WAIT_V(6); PG8_BAR;
    for (;;) {
        const bool has_next = S.next(ui + 1, nxt);
        const char* nA = has_next ? PG8_ABASE(nxt) : cA; const char* nB = has_next ? PG8_BBASE(nxt) : cB;
#pragma nounroll
        for (int t = 0; t < nt; t += 2) {
            const bool last = (t == nt - 2);
            const char* a1 = cA + (size_t)(t + 1) * kstep;
            const char* a2 = last ? nA : cA + (size_t)(t + 2) * kstep; const char* b2 = last ? nB : cB + (size_t)(t + 2) * kstep;
            const char* a3 = a2 + kstep; const char* b3 = b2 + kstep;
            PG8_LDB(B0, 0, 0); PG8_LDB(B1, 0, 1); PG8_SCHED; PG8_LDA(At, 0, 0); PG8_STAGE(PG8_SA(1, 1), a1 + hstepA, voffA);
            PG8_WAIT_V(8); PG8_WAIT_L(0); PG8_BAR; PG8_MMA(0, 0, At, B0); PG8_MMA(0, 1, At, B1); PG8_BAR; PG8_SCHED;
            PG8_LDA(At, 0, 1); PG8_STAGE(PG8_SB(0, 0), b2, voffB); PG8_STAGE(PG8_SB(0, 1), b2 + hstepB, voffB); PG8_STAGE(PG8_SA(0, 0), a2, voffA);
            PG8_WAIT_V(8); PG8_WAIT_L(0); PG8_BAR; PG8_MMA(1, 0, At, B0); PG8_MMA(1, 1, At, B1); PG8_BAR; PG8_SCHED;
            PG8_LDB(B0, 1, 0); PG8_LDB(B1, 1, 1); PG8_SCHED; PG8_LDA(At, 1, 0); PG8_STAGE(PG8_SA(0, 1), a2 + hstepA, voffA);
            PG8_WAIT_V(8); PG8_WAIT_L(0); PG8_BAR; PG8_MMA(0, 0, At, B0); PG8_MMA(0, 1, At, B1); PG8_BAR; PG8_SCHED;
            PG8_LDA(At, 1, 1); PG8_STAGE(PG8_SB(1, 0), b3, voffB); PG8_STAGE(PG8_SB(1, 1), b3 + hstepB, voffB); PG8_STAGE(PG8_SA(1, 0), a3, voffA);
            PG8_WAIT_V(8); PG8_WAIT_L(0); PG8_BAR; PG8_MMA(1, 0, At, B0); PG8_MMA(1, 1, At, B1); PG8_BAR; PG8_SCHED;
            if constexpr (Epi::HAS_MID) { if (((t + 2) & 3) == 0 && !last) { E.mid(acc, cur, ((t + 2) >> 2) - 1, wr, wc, fr, fq); PG8_SCHED; } }
        }
        if constexpr (ALIGN_EPI) { if (wr == 0) PG8_BAR; }
        E(acc, cur, wr, wc, fr, fq);
        if (!has_next) break;
#pragma unroll
        for (int a = 0; a < 2; ++a)
#pragma unroll
            for (int b = 0; b < 2; ++b)
#pragma unroll
                for (int m = 0; m < 4; ++m)
#pragma unroll
                    for (int n = 0; n < 2; ++n) acc[a][b][m][n] = (f32x4){0.f, 0.f, 0.f, 0.f};
        cur = nxt; cA = nA; cB = nB; ++ui;
        if constexpr (Epi::HAS_INIT) E.init(acc, cur, wr, wc, fr, fq);
        if constexpr (ALIGN_EPI) { if (wr == 1) PG8_BAR; }
    }
    PG8_WAIT_V(0);
    if constexpr (!ALIGN_EPI) { if (wr == 0) PG8_BAR; }
    PG8_BAR;
#undef PG8_SA
#undef PG8_SB
#undef PG8_STAGE
#undef PG8_LDA
#undef PG8_LDB
#undef PG8_MMA
#undef PG8_WAIT_V
#undef PG8_WAIT_L
#undef PG8_BAR
#undef PG8_SCHED
#undef PG8_ABASE
#undef PG8_BBASE
}
#endif
}

#ifndef CPU_EMU
#define LAS __attribute__((address_space(3)))
#define XB_TMO      128
#define XB_XCNT(j)  (256  + 64 * (j))
#define XB_XSUB(j)  (1280 + 64 * (j))
#define XB_XGEN(j)  (2304 + 64 * (j))
#define XB_TOP      3328
#define XB_TOPGEN   3392
#define XCD_BAR_WORDS 3456
#define XB_SPIN_CAP (1u << 20)
__device__ __forceinline__ unsigned xb_ld(unsigned* p)              { return __hip_atomic_load(p, __ATOMIC_RELAXED, __HIP_MEMORY_SCOPE_AGENT); }
__device__ __forceinline__ unsigned xb_add(unsigned* p, unsigned v) { return __hip_atomic_fetch_add(p, v, __ATOMIC_RELAXED, __HIP_MEMORY_SCOPE_AGENT); }
__device__ __forceinline__ unsigned xb_xcc_id() { return (unsigned)__builtin_amdgcn_s_getreg((3 << 11) | 20) & 0xFu; }
#define XB_SPIN(cond, bar) do { unsigned _sp = 0; while (cond) { __builtin_amdgcn_s_sleep(1); \
    if ((++_sp & 255u) == 0u) { if (xb_ld(&(bar)[XB_TMO])) break; if (_sp > XB_SPIN_CAP) { atomicAdd(&(bar)[XB_TMO], 1u); break; } } } } while (0)
struct XcdBarrier { unsigned* bar; unsigned x; volatile LAS unsigned* st; };
__device__ __forceinline__ XcdBarrier xcd_barrier_post(unsigned* bar, volatile LAS unsigned* st) {
    XcdBarrier b; b.bar = bar; b.x = xb_xcc_id(); b.st = st;
    if (threadIdx.x == 0) (void)xb_add(&bar[XB_XCNT(b.x)], 1u);
    return b;
}
__device__ __forceinline__ void xcd_barrier_complete(unsigned* bar, unsigned x, unsigned& nloc, unsigned& nx) {
    const unsigned G = gridDim.x * gridDim.y * gridDim.z;
    unsigned sum, cnt, mine, sp = 0u;
    for (;;) {
        sum = 0u; cnt = 0u; mine = 0u;
#pragma unroll
        for (unsigned j = 0; j < 16; ++j) { const unsigned c = xb_ld(&bar[XB_XCNT(j)]); sum += c; cnt += (c > 0u) ? 1u : 0u; mine = (j == x) ? c : mine; }
        if (sum == G) break;
        __builtin_amdgcn_s_sleep(1);
        if ((++sp & 255u) == 0u) { if (xb_ld(&bar[XB_TMO])) break; if (sp > XB_SPIN_CAP) { atomicAdd(&bar[XB_TMO], 1u); break; } }
    }
    nloc = mine > 0u ? mine : 1u; nx = cnt > 0u ? cnt : 1u;
}
__device__ __forceinline__ void xcd_barrier(const XcdBarrier& b) {
    asm volatile("s_waitcnt vmcnt(0)" ::: "memory");
    __syncthreads();
    if (threadIdx.x == 0) {
        unsigned* bar = b.bar; asm volatile("" : "+s"(bar));
        __builtin_amdgcn_s_waitcnt(0);
        unsigned nloc = b.st[0], nx = b.st[1];
        if (nloc == 0u) { xcd_barrier_complete(bar, b.x, nloc, nx); b.st[0] = nloc; b.st[1] = nx; }
        const unsigned old = xb_add(&bar[XB_XSUB(b.x)], 1u);
        const unsigned gen = old / nloc;
        if (old + 1u == (gen + 1u) * nloc) {
            __builtin_amdgcn_fence(__ATOMIC_RELEASE, "agent");
            asm volatile("s_waitcnt vmcnt(0)" ::: "memory");
            const unsigned og = xb_add(&bar[XB_TOP], 1u);
            const unsigned tg = og / nx;
            if (og + 1u == (tg + 1u) * nx) xb_add(&bar[XB_TOPGEN], 1u);
            else XB_SPIN(xb_ld(&bar[XB_TOPGEN]) == tg, bar);
            xb_add(&bar[XB_XGEN(b.x)], 1u);
            __builtin_amdgcn_fence(__ATOMIC_ACQUIRE, "agent");
            asm volatile("s_waitcnt vmcnt(0)" ::: "memory");
        } else {
            XB_SPIN(xb_ld(&bar[XB_XGEN(b.x)]) == gen, bar);
            __builtin_amdgcn_fence(__ATOMIC_ACQUIRE, "agent");
            asm volatile("s_waitcnt vmcnt(0)" ::: "memory");
        }
    }
    __syncthreads();
}
constexpr int LDS_BYTES = 147456;
constexpr int RTAB_OFF = 131072 + 1024;
constexpr int LDSCTL_OFF = 131072 + 320;
__global__ void __launch_bounds__(NTHREADS, 2) mega_fwd(Args a_) {
    extern __shared__ __attribute__((aligned(16))) unsigned char lds[];
    __attribute__((address_space(3))) unsigned char* lds3 = (__attribute__((address_space(3))) unsigned char*)lds;
    const int G = gridDim.x, bid = blockIdx.x;
    const int lo = a_.ph_lo, hi = a_.ph_hi;
    volatile LAS unsigned* MISC = (volatile LAS unsigned*)(lds3 + LDSCTL_OFF);
    if (threadIdx.x < 16) MISC[threadIdx.x] = 0u;
    __syncthreads();
    XcdBarrier bar; { KArgs a = kargs(); unsigned* bw = (unsigned*)(a->ws + OFF_CTL) + 4096; bar.bar = bw; bar.x = 0; bar.st = nullptr;
        if (hi - lo > 1) bar = xcd_barrier_post(bw, MISC + 8); }
    unsigned long long tp0 = 0, tp1 = 0;
#define SEAM(p) do { if (lo <= (p) && (p) + 1 < hi) for (int br_ = 0; br_ < BAR_REPS; ++br_) xcd_barrier(bar); if (TIME_PH >= 0) { if ((p) + 1 == TIME_PH) tp0 = __builtin_amdgcn_s_memrealtime(); if ((p) == TIME_PH) tp1 = __builtin_amdgcn_s_memrealtime(); } } while (0)
#define IN_PH(p) ((((PH_MASK) >> ((p) % PH_PER_LAYER + ((p) == PH_FINAL ? PH_PER_LAYER : 0))) & 1) && lo <= (p) && (p) < hi)
#define REPS(k) for (int rep_ = 0; rep_ < (REP_KIND == (k) ? 2 : 1); ++rep_)
#define WSP(T, off) ((T*)(a->ws + (off)))
    float* rtab = (float*)(lds + RTAB_OFF);
#define LAYER_PHASES(layer) { constexpr int pb = (layer) * PH_PER_LAYER; \
        REPS(PH_WCONV) if (IN_PH(pb + PH_WCONV)) { KArgs a = kargs(); phase_wconv(a, lds, layer, 0, bid, G); if (layer == 0) phase_x_to_bf16(a->in[I_X], WSP(bf16_t, OFF_XN), WSP(float, OFF_PART)); } \
        SEAM(pb + PH_WCONV); \
        REPS(PH_GEMM_IN) if (IN_PH(pb + PH_GEMM_IN)) { KArgs a = kargs(); pg8::Gemm g{WSP(bf16_t, OFF_XN), WSP(bf16_t, OFF_WIN)}; pg8::StaticOrder S; S.init(M, NHB, G, bid); pg8::EpiBf16<0> E{WSP(bf16_t, OFF_HB), NHB, rtab, WSP(float, OFF_PART)}; \
            pg8::gemm_phase<pg8::EpiBf16<0>, pg8::StaticOrder, D>(lds3, g, S, E); \
            { constexpr int NU = (M / 256) * (NHB / 256); const int rem = NU % G; if (rem == 0) phase_wconv(kargs(), lds, layer, 1, bid, G); else if (bid >= rem) phase_wconv(kargs(), lds, layer, 1, bid - rem, G - rem); } } \
        SEAM(pb + PH_GEMM_IN); \
        REPS(PH_MIX1) if (IN_PH(pb + PH_MIX1)) phase_mix1(kargs(), lds, layer); \
        SEAM(pb + PH_MIX1); \
        if (IN_PH(pb + PH_MIX2)) gla_scan(kargs()); \
        SEAM(pb + PH_MIX2); \
        REPS(PH_MIX3) if (IN_PH(pb + PH_MIX3)) phase_mix3(kargs(), lds, layer); \
        SEAM(pb + PH_MIX3); \
        REPS(PH_GEMM_G) if (IN_PH(pb + PH_GEMM_G)) { KArgs a = kargs(); pg8::Gemm g{WSP(bf16_t, OFF_XN), WSP(bf16_t, OFF_WIN) + (size_t)NHB * D}; pg8::StaticOrder S; S.init(M, NGATE, G, bid); pg8::EpiGate E{WSP(bf16_t, OFF_G), rtab, WSP(float, OFF_PART)}; \
            pg8::gemm_phase<pg8::EpiGate, pg8::StaticOrder, D>(lds3, g, S, E); } \
        SEAM(pb + PH_GEMM_G); \
        REPS(PH_GEMM_M) if (IN_PH(pb + PH_GEMM_M)) { KArgs a = kargs(); pg8::Gemm g{WSP(bf16_t, OFF_Y), WSP(bf16_t, OFF_WBR)}; pg8::StaticOrder S; S.init(M, D, G, bid); pg8::EpiMerge E{(bf16_t*)a->out  , WSP(bf16_t, OFF_G)}; \
            pg8::gemm_phase<pg8::EpiMerge, pg8::StaticOrder, D>(lds3, g, S, E); } \
        SEAM(pb + PH_GEMM_M); \
        for (int rep_ = 0; rep_ < ((REP_KIND == PH_GEMM_O && layer == 0) ? 3 : 1); ++rep_) if (IN_PH(pb + PH_GEMM_O)) { KArgs a = kargs(); pg8::Gemm g{(const bf16_t*)a->out, WSP(bf16_t, OFF_WOUT)}; pg8::StaticOrder S; S.init(M, D, G, bid); \
            pg8::EpiResNorm E{WSP(bf16_t, OFF_XN), WSP(bf16_t, OFF_Y), WSP(float, OFF_PART)}; \
            pg8::gemm_phase<pg8::EpiResNorm, pg8::StaticOrder, D>(lds3, g, S, E); } \
        SEAM(pb + PH_GEMM_O); \
        REPS(PH_GEMM_U) if (IN_PH(pb + PH_GEMM_U)) { KArgs a = kargs(); pg8::Gemm g{WSP(bf16_t, OFF_Y), WSP(bf16_t, OFF_WUP)}; pg8::StaticOrder S; S.init(M, DFF, G, bid); pg8::EpiBf16<2> E{WSP(bf16_t, OFF_UP), DFF, rtab, WSP(float, OFF_PART)}; \
            pg8::gemm_phase<pg8::EpiBf16<2>, pg8::StaticOrder, D>(lds3, g, S, E); } \
        SEAM(pb + PH_GEMM_U); \
        if (IN_PH(pb + PH_GEMM_D)) { KArgs a = kargs(); pg8::Gemm g{WSP(bf16_t, OFF_UP), WSP(bf16_t, OFF_WDN)}; pg8::StaticOrder S; S.init(M, D, G, bid); \
            pg8::EpiResNorm E{WSP(bf16_t, OFF_Y), WSP(bf16_t, OFF_XN), WSP(float, OFF_PART)}; \
            pg8::gemm_phase<pg8::EpiResNorm, pg8::StaticOrder, DFF>(lds3, g, S, E); } \
        SEAM(pb + PH_GEMM_D); \
    }
    LAYER_PHASES(0)
    LAYER_PHASES(1)
#undef LAYER_PHASES
    if (IN_PH(PH_FINAL)) { KArgs a = kargs(); phase_final_norm(WSP(bf16_t, OFF_XN), a->in[I_FNG], a->out); }
    if (TIME_SEC >= 0 && blockIdx.x == 0) { KArgs a = kargs(); __syncthreads(); const unsigned long long acc_ = __hip_atomic_load((unsigned long long*)(a->ws + OFF_CTL + 32768), __ATOMIC_RELAXED, __HIP_MEMORY_SCOPE_AGENT);
        const unsigned long long te = __builtin_amdgcn_s_memrealtime(), span = acc_ * 32ull; while (__builtin_amdgcn_s_memrealtime() - te < span) __builtin_amdgcn_s_sleep(8); }
    if (TIME_PH >= 0 && blockIdx.x == 0) { if (TIME_PH == PH_FINAL) tp1 = __builtin_amdgcn_s_memrealtime(); if (TIME_PH == 0) tp0 = tp1 - 1;
        const unsigned long long te = __builtin_amdgcn_s_memrealtime(), span = (tp1 - tp0) * 8ull; while (__builtin_amdgcn_s_memrealtime() - te < span) __builtin_amdgcn_s_sleep(8); }
#undef IN_PH
#undef REPS
#undef WSP
#undef SEAM
}

extern "C" void kernel_launch(void* const* d_in, const int* in_sizes, int n_in, void* d_out, int out_size, void* d_ws, size_t ws_size, hipStream_t stream) {
    static int grid = 0;
    if (grid == 0) {
        if (n_in != N_INPUTS || out_size != M * D || ws_size < WS_END) { fprintf(stderr, "kernel_launch: unexpected shapes (n_in %d out %d ws %zu)\n", n_in, out_size, ws_size); grid = -1; return; }
        int dev = 0, cus = 0;
        if (hipGetDevice(&dev) != hipSuccess || hipDeviceGetAttribute(&cus, hipDeviceAttributeMultiprocessorCount, dev) != hipSuccess) { grid = -1; return; }
        if (hipFuncSetAttribute((const void*)mega_fwd, hipFuncAttributeMaxDynamicSharedMemorySize, LDS_BYTES) != hipSuccess) { fprintf(stderr, "kernel_launch: hipFuncSetAttribute failed\n"); grid = -1; return; }
        grid = cus;
    }
    if (grid < 0) return;
    Args a{};
    for (int i = 0; i < N_INPUTS; ++i) a.in[i] = (const float*)d_in[i];
    a.out = (float*)d_out; a.ws = (unsigned char*)d_ws;
#if N_LAUNCH_MODE == 0
    for (int ph = 0; ph < N_PHASES; ++ph) { a.ph_lo = ph; a.ph_hi = ph + 1; hipLaunchKernelGGL(mega_fwd, dim3(grid), dim3(NTHREADS), LDS_BYTES, stream, a); }
#else
    if (hipMemsetAsync((char*)d_ws + OFF_CTL, 0, 65536, stream) != hipSuccess) { fprintf(stderr, "kernel_launch: memset failed\n"); return; }
    a.ph_lo = 0; a.ph_hi = N_PHASES;
    hipLaunchKernelGGL(mega_fwd, dim3(grid), dim3(NTHREADS), LDS_BYTES, stream, a);
#endif
}
#endif
```

```cpp
#ifndef CPU_EMU
#include <hip/hip_runtime.h>
#include <cstdio>
#include <cstdint>
#endif
#ifndef SEQ_T
#define SEQ_T 8192
#endif
#ifndef PH_MASK
#define PH_MASK 0xffff
#endif
#ifndef TIME_PH
#define TIME_PH -1
#endif
#ifndef TIME_SEC
#define TIME_SEC -1
#endif
#ifndef BAR_REPS
#define BAR_REPS 1
#endif
#ifndef REP_ITEM
#define REP_ITEM -1
#endif
#ifndef REP_KIND
#define REP_KIND -1
#endif
#ifndef N_LAUNCH_MODE
#define N_LAUNCH_MODE 1
#endif

typedef unsigned short bf16_t;
typedef short bf16x8 __attribute__((ext_vector_type(8)));
typedef short s16x4 __attribute__((ext_vector_type(4)));
typedef float f32x4 __attribute__((ext_vector_type(4)));
typedef float f32x16 __attribute__((ext_vector_type(16)));
typedef unsigned u32x4 __attribute__((ext_vector_type(4)));
typedef unsigned u32x2 __attribute__((ext_vector_type(2)));
#ifdef CPU_EMU
#define DEVI static inline
#define DEVM inline
DEVI float ex2(float x) { return exp2f(x); }
DEVI float lg2(float x) { return log2f(x); }
DEVI float rcpf_(float x) { return 1.0f / x; }
DEVI float rsqf_(float x) { return 1.0f / sqrtf(x); }
DEVI f32x16 mfma32(bf16x8 a, bf16x8 b, f32x16 c) { return emu_mfma32(a, b, c); }
DEVI void wave_sync() { emu_wave->bar.wait(); }
DEVI void lds_barrier() { __syncthreads(); }
DEVI bool wave_any(bool p) { unsigned v = p ? 1u : 0u; for (int o = 1; o < 64; o <<= 1) v |= __shfl_xor(v, o); return v != 0u; }
DEVI int rfl(int x) { return x; }
#else
#define DEVI __device__ __forceinline__
#define DEVM __device__ __forceinline__
DEVI float ex2(float x) { return __builtin_amdgcn_exp2f(x); }
DEVI float lg2(float x) { return __builtin_amdgcn_logf(x); }
DEVI float rcpf_(float x) { return __builtin_amdgcn_rcpf(x); }
DEVI float rsqf_(float x) { return __builtin_amdgcn_rsqf(x); }
DEVI f32x16 mfma32(bf16x8 a, bf16x8 b, f32x16 c) { return __builtin_amdgcn_mfma_f32_32x32x16_bf16(a, b, c, 0, 0, 0); }
DEVI void wave_sync() { asm volatile("s_waitcnt lgkmcnt(0)" ::: "memory"); }
DEVI void lds_barrier() { asm volatile("s_waitcnt lgkmcnt(0)\n\ts_barrier" ::: "memory"); }
DEVI bool wave_any(bool p) { return __builtin_amdgcn_ballot_w64(p) != 0ull; }
DEVI int rfl(int x) { return __builtin_amdgcn_readfirstlane(x); }
#endif
#ifdef CPU_EMU
DEVI int launder_tid() { return (int)threadIdx.x; }
#else
DEVI int launder_tid() { int t = threadIdx.x; asm volatile("" : "+v"(t)); return t; }
#endif
#ifdef CPU_EMU
DEVI unsigned f2bf(float f) { unsigned u = __builtin_bit_cast(unsigned, f); return (u + 0x7fffu + ((u >> 16) & 1u)) >> 16; }
DEVI unsigned pk2(float lo, float hi) { return f2bf(lo) | (f2bf(hi) << 16); }
#else
typedef __bf16 bf16x2_hw __attribute__((ext_vector_type(2))); typedef float f32x2_hw __attribute__((ext_vector_type(2)));
DEVI unsigned pk2(float lo, float hi) { const f32x2_hw v = {lo, hi}; return __builtin_bit_cast(unsigned, __builtin_convertvector(v, bf16x2_hw)); }
DEVI unsigned f2bf(float f) { return pk2(f, 0.f) & 0xffffu; }
#endif
DEVI float bf2f(unsigned h) { return __builtin_bit_cast(float, h << 16); }
DEVI float bflo(unsigned w) { return __builtin_bit_cast(float, w << 16); }
DEVI float bfhi(unsigned w) { return __builtin_bit_cast(float, w & 0xffff0000u); }
struct pg8_unit_fwd { int pm, pn, br, ui; };
constexpr float LOG2E = 1.4426950408889634f, LN2 = 0.6931471805599453f;
DEVI float sigmoidf_(float x) { return rcpf_(1.0f + ex2(-x * LOG2E)); }
DEVI float siluf_(float x) { return x * sigmoidf_(x); }
DEVI float logsigf_(float z) { const float a = fabsf(z); return fminf(z, 0.f) - LN2 * lg2(1.0f + ex2(-a * LOG2E)); }
DEVI float wave_sum(float v) {
#pragma unroll
    for (int o = 1; o < 64; o <<= 1) v += __shfl_xor(v, o);
    return v;
}

constexpr int BATCH = 2, SEQ = SEQ_T, M = BATCH * SEQ, D = 1024, DFF = 4096, NLAYER = 2;
constexpr int DIN_SRC = 6176;
constexpr int NHB = 2304, NGATE = 4096, NIN = NHB + NGATE;
constexpr int C_GLUA = 0, C_GLUG = 256, C_GQ = 512, C_GK = 640, C_GV = 768, C_GR = 1024, C_Z = 1280, C_AQ = 1536, C_AK = 1792, C_AV = 1920, C_PIN = 2048;
constexpr int SRC_GLR = 1280;
constexpr int NCH = SEQ / 64;
constexpr int NAB = SEQ / 128;
constexpr float EPS = 1e-6f;
constexpr int NTHREADS = 512, NWAVES = 8;
enum { I_X = 0, I_NMG, I_WIN, I_CW, I_CB, I_CLG, I_CLB, I_WUP, I_BUP, I_GNG, I_SINK, I_PW, I_PS, I_WBR, I_WOUT, I_NFG, I_WFU, I_WFD, I_FNG, N_INPUTS };
constexpr size_t al256(size_t x) { return (x + 255) & ~(size_t)255; }
constexpr size_t OFF_CTL = 0, CTL_BYTES = 1u << 20;
constexpr size_t SZ_WIN = (size_t)NIN * D * 2, SZ_WBR = (size_t)4 * D * 256 * 2, SZ_WOUT = (size_t)D * D * 2, SZ_WUP = (size_t)DFF * D * 2, SZ_WDN = (size_t)D * DFF * 2;
constexpr size_t OFF_WIN = OFF_CTL + CTL_BYTES, OFF_WBR = OFF_WIN + SZ_WIN, OFF_WOUT = OFF_WBR + SZ_WBR, OFF_WUP = OFF_WOUT + SZ_WOUT, OFF_WDN = OFF_WUP + SZ_WUP;
constexpr size_t OFF_ROPE = OFF_WDN + SZ_WDN, SZ_ROPE = al256((size_t)SEQ * 8 * 8);
constexpr size_t OFF_PWT = OFF_ROPE + SZ_ROPE, SZ_PWT = 4 * 64 * 64 * 2;
constexpr size_t OFF_PART = OFF_PWT + SZ_PWT, SZ_PART = al256((size_t)M * 16 * 4);
constexpr size_t OFF_XN = OFF_PART + SZ_PART, SZ_ACT = al256((size_t)M * D * 2);
constexpr size_t OFF_Y = OFF_XN + SZ_ACT;
constexpr size_t OFF_BIG = OFF_Y + SZ_ACT;
constexpr size_t OFF_HB = OFF_BIG, SZ_HB = al256((size_t)M * NHB * 2);
constexpr size_t OFF_GU = OFF_HB + SZ_HB, SZ_GU = al256((size_t)BATCH * 4 * 2 * NCH * 2048 * 4);
constexpr size_t OFF_GD = OFF_GU + SZ_GU, SZ_GD = al256((size_t)BATCH * 4 * 2 * NCH * 32 * 4);
constexpr size_t OFF_G = OFF_BIG, SZ_G = al256((size_t)M * NGATE * 2);
constexpr size_t OFF_UP = OFF_BIG;
constexpr size_t WS_END = OFF_BIG + (SZ_G > SZ_HB + SZ_GU + SZ_GD ? SZ_G : SZ_HB + SZ_GU + SZ_GD);
static_assert(WS_END <= 268435456, "workspace map exceeds 256 MiB");

struct Args { const float* in[N_INPUTS]; float* out; unsigned char* ws; int ph_lo, ph_hi; };
#ifdef CPU_EMU
#define TSEC(a, id, sgn) do {} while (0)
typedef const Args* KArgs;
#else
typedef const Args __attribute__((address_space(4)))* KArgs;
#ifndef CPU_EMU
#define TSEC(a, id, sgn) do { if (TIME_SEC == (id) && blockIdx.x == 0 && threadIdx.x == 0) { const unsigned long long t_ = __builtin_amdgcn_s_memrealtime(); \
    __hip_atomic_fetch_add((unsigned long long*)((a)->ws + OFF_CTL + 32768), (sgn) > 0 ? t_ : (0ull - t_), __ATOMIC_RELAXED, __HIP_MEMORY_SCOPE_AGENT); } } while (0)
#endif
DEVI KArgs kargs() { KArgs p = (KArgs)__builtin_amdgcn_kernarg_segment_ptr(); asm volatile("" : "+s"(p)); return p; }
#endif

enum { PH_WCONV = 0, PH_GEMM_IN, PH_MIX1, PH_MIX2, PH_MIX3, PH_GEMM_G, PH_GEMM_M, PH_GEMM_O, PH_GEMM_U, PH_GEMM_D, PH_PER_LAYER };
constexpr int PH_FINAL = NLAYER * PH_PER_LAYER, N_PHASES = PH_FINAL + 1;

DEVI void transpose_item(const float* W, int ldw, int K, bf16_t* WT, int k0, int src_n0, int dst_n0, float* scr, int lane, const float* ksc = nullptr  , int src_col = -1, int ksrc0 = -1) {
    const int sc_ = src_col >= 0 ? src_col : src_n0 + (lane & 31), ks_ = ksrc0 >= 0 ? ksrc0 : k0;
    { float tv[32]; const float* wp = W + (size_t)(ks_ + (lane >> 5)) * ldw + sc_;
#pragma unroll
      for (int i = 0; i < 32; ++i) tv[i] = wp[(size_t)(2 * i) * ldw];
#pragma unroll
      for (int i = 0; i < 32; ++i) scr[(2 * i + (lane >> 5)) * 33 + (lane & 31)] = tv[i]; }
    const int c = lane & 7;
    f32x4 g0 = (f32x4){1.f, 1.f, 1.f, 1.f}, g1 = g0; if (ksc) { g0 = *(const f32x4*)(ksc + k0 + 8 * c); g1 = *(const f32x4*)(ksc + k0 + 8 * c + 4); }
    wave_sync();
#pragma unroll
    for (int j = 0; j < 4; ++j) { const int n = (lane >> 3) + 8 * j; const float* s = scr + (8 * c) * 33 + n;
        u32x4 o; o.x = pk2(s[0 * 33] * g0[0], s[1 * 33] * g0[1]); o.y = pk2(s[2 * 33] * g0[2], s[3 * 33] * g0[3]); o.z = pk2(s[4 * 33] * g1[0], s[5 * 33] * g1[1]); o.w = pk2(s[6 * 33] * g1[2], s[7 * 33] * g1[3]);
        *(u32x4*)(WT + (size_t)(dst_n0 + n) * K + k0 + 8 * c) = o; }
    wave_sync();
}
DEVI void zfold_item(const float* Win, const float* wup, bf16_t* WT, int k0, int zc0  , float* scr, int lane, const float* ksc) {
    const int s = zc0 >> 7, kc = (zc0 & 127) + (lane & 31);
    float wu[16];
#pragma unroll
    for (int r = 0; r < 16; ++r) wu[r] = wup[(s * 16 + r) * 128 + kc];
    for (int i = 0; i < 32; ++i) { const int kk = 2 * i + (lane >> 5); const float* g = Win + (size_t)(k0 + kk) * DIN_SRC + SRC_GLR + s * 16; float a = 0.f;
#pragma unroll
        for (int r = 0; r < 16; ++r) a += g[r] * wu[r];
        scr[kk * 33 + (lane & 31)] = a; }
    const int c = lane & 7;
    const f32x4 g0 = *(const f32x4*)(ksc + k0 + 8 * c), g1 = *(const f32x4*)(ksc + k0 + 8 * c + 4);
    wave_sync();
#pragma unroll
    for (int j = 0; j < 4; ++j) { const int n = (lane >> 3) + 8 * j; const float* sp = scr + (8 * c) * 33 + n;
        u32x4 o; o.x = pk2(sp[0 * 33] * g0[0], sp[1 * 33] * g0[1]); o.y = pk2(sp[2 * 33] * g0[2], sp[3 * 33] * g0[3]); o.z = pk2(sp[4 * 33] * g1[0], sp[5 * 33] * g1[1]); o.w = pk2(sp[6 * 33] * g1[2], sp[7 * 33] * g1[3]);
        *(u32x4*)(WT + (size_t)(C_Z + zc0 + n) * D + k0 + 8 * c) = o; }
    wave_sync();
}
DEVI void rope_entry(int pos, int i, float& c, float& s) {
    const double inv[8] = {1.0, 0.19392274474868576, 0.03760603093086393, 0.007292664737217109, 0.001414213562373095, 0.0002742481756762073, 5.318295896944988e-05, 1.031338537721246e-05};
    double iv = inv[0];
#pragma unroll
    for (int k = 1; k < 8; ++k) iv = (i == k) ? inv[k] : iv;
    double rev = (double)pos * iv * 0.15915494309189535; rev -= __builtin_rint(rev);
    double q4 = rev * 4.0; const double qn = __builtin_rint(q4); const double t = (q4 - qn) * 1.5707963267948966;
    const double t2 = t * t;
    double sp = t * (1.0 + t2 * (-1.0 / 6 + t2 * (1.0 / 120 + t2 * (-1.0 / 5040 + t2 * (1.0 / 362880 + t2 * (-1.0 / 39916800 + t2 * (1.0 / 6227020800.0)))))));
    double cp = 1.0 + t2 * (-0.5 + t2 * (1.0 / 24 + t2 * (-1.0 / 720 + t2 * (1.0 / 40320 + t2 * (-1.0 / 3628800 + t2 * (1.0 / 479001600.0))))));
    const int qi = ((int)qn) & 3;
    const double cs = (qi == 0) ? cp : (qi == 1) ? -sp : (qi == 2) ? -cp : sp;
    const double sn = (qi == 0) ? sp : (qi == 1) ? cp : (qi == 2) ? -sp : -cp;
    c = (float)cs; s = (float)sn;
}
DEVI int gate_src_col(int cp) { const int pn = cp >> 8, cl = cp & 255, bj = cl >> 7, wc = (cl >> 5) & 3, fq = (cl >> 3) & 3, np = (cl >> 2) & 1, q = cl & 3;
    return 2080 + (2 * bj + np) * D + 64 * pn + 16 * wc + 4 * fq + q; }
DEVI void phase_wconv(KArgs a, unsigned char* lds, int layer, int part, int wg, int nwg) {
    const int tid = launder_tid(), lane = tid & 63, wave = rfl(tid >> 6);
    float* scr = (float*)(lds + wave * 8448);
    const int gw = wg * NWAVES + wave, NGW = nwg * NWAVES;
    const float* Win = a->in[I_WIN] + (size_t)layer * D * DIN_SRC; const float* wup = a->in[I_WUP] + (size_t)layer * 2 * 16 * 128;
    const float* Wbr = a->in[I_WBR] + (size_t)layer * 4 * 256 * D; const float* Wout = a->in[I_WOUT] + (size_t)layer * D * D;
    const float* Wfu = a->in[I_WFU] + (size_t)layer * D * DFF; const float* Wfd = a->in[I_WFD] + (size_t)layer * DFF * D;
    const float* gmix = a->in[I_NMG] + layer * D; const float* gffn = a->in[I_NFG] + layer * D;
    bf16_t* WIN_T = (bf16_t*)(a->ws + OFF_WIN); bf16_t* WBR_T = (bf16_t*)(a->ws + OFF_WBR); bf16_t* WOUT_T = (bf16_t*)(a->ws + OFF_WOUT);
    bf16_t* WUP_T = (bf16_t*)(a->ws + OFF_WUP); bf16_t* WDN_T = (bf16_t*)(a->ws + OFF_WDN);
    constexpr int I_IN = (D / 64) * (NIN / 32), I_BR = 4 * (256 / 64) * (D / 32), I_OUT = (D / 64) * (D / 32), I_UP = (D / 64) * (DFF / 32), I_DN = (DFF / 64) * (D / 32);
    constexpr int NITEMS = I_IN + I_BR + I_OUT + I_UP + I_DN;
    for (int it = gw + (part ? I_IN : 0); it < (part ? NITEMS : I_IN); it += NGW) {
        int r = it;
        if (r < I_IN) { const int nblk = NIN / 32, kb = r / nblk, nb = r % nblk, n0 = nb * 32;
            if (n0 >= C_Z && n0 < C_AQ) zfold_item(Win, wup, WIN_T, kb * 64, n0 - C_Z, scr, lane, gmix);
            else if (n0 < NHB) transpose_item(Win, DIN_SRC, D, WIN_T, kb * 64, n0 < C_Z ? n0 : n0 - 224, n0, scr, lane, gmix);
            else transpose_item(Win, DIN_SRC, D, WIN_T, kb * 64, 0, n0, scr, lane, gmix, gate_src_col(n0 - NHB + (lane & 31)));
            continue; } r -= I_IN;
        if (r < I_BR) { const int br = r / (I_BR / 4), q = r % (I_BR / 4), nblk = D / 32, kb = q / nblk, nb = q % nblk;
            transpose_item(Wbr + (size_t)br * 256 * D, D, D  , WBR_T, br * 256 + kb * 64, nb * 32, nb * 32, scr, lane, nullptr, -1, kb * 64); continue; } r -= I_BR;
        if (r < I_OUT) { const int nblk = D / 32, kb = r / nblk, nb = r % nblk; transpose_item(Wout, D, D, WOUT_T, kb * 64, nb * 32, nb * 32, scr, lane); continue; } r -= I_OUT;
        if (r < I_UP) { const int nblk = DFF / 32, kb = r / nblk, nb = r % nblk; transpose_item(Wfu, DFF, D, WUP_T, kb * 64, nb * 32, nb * 32, scr, lane, gffn); continue; } r -= I_UP;
        { const int nblk = D / 32, kb = r / nblk, nb = r % nblk; transpose_item(Wfd, D, DFF, WDN_T, kb * 64, nb * 32, nb * 32, scr, lane); }
    }
    if (part) return;
    { bf16_t* PWT = (bf16_t*)(a->ws + OFF_PWT); const float* pw = a->in[I_PW] + (size_t)layer * 4 * 64 * 64;
      for (int e = blockIdx.x * NTHREADS + tid; e < 4 * 64 * 64; e += gridDim.x * NTHREADS) { const int g = e >> 12, ee = (e >> 6) & 63, c = e & 63; PWT[e] = (bf16_t)f2bf(pw[(g * 64 + c) * 64 + ee]); } }
    if (layer == 0) { float* rope = (float*)(a->ws + OFF_ROPE);
        for (int e = blockIdx.x * NTHREADS + tid; e < SEQ * 8; e += gridDim.x * NTHREADS) { float c, s; rope_entry(e >> 3, e & 7, c, s); rope[2 * e] = c; rope[2 * e + 1] = s; } }
}

DEVI void phase_x_to_bf16(const float* x, bf16_t* xb, float* part) {
    const int tid = launder_tid(), lane = tid & 63, wave = rfl(tid >> 6);
    const int gw = blockIdx.x * NWAVES + wave, NGW = gridDim.x * NWAVES;
    for (int m = gw; m < M; m += NGW) {
        const f32x4* xr = (const f32x4*)(x + (size_t)m * D) + lane; f32x4 v[4]; float s = 0.f;
#pragma unroll
        for (int j = 0; j < 4; ++j) { v[j] = xr[64 * j]; s += (v[j].x * v[j].x + v[j].y * v[j].y) + (v[j].z * v[j].z + v[j].w * v[j].w); }
        s = wave_sum(s);
        u32x2* o8 = (u32x2*)(xb + (size_t)m * D) + lane;
#pragma unroll
        for (int j = 0; j < 4; ++j) { u32x2 w; w.x = pk2(v[j].x, v[j].y); w.y = pk2(v[j].z, v[j].w); o8[64 * j] = w; }
        if (lane < 16) part[(size_t)m * 16 + lane] = lane == 0 ? s : 0.f;
    }
}
DEVI void phase_final_norm(const bf16_t* xb, const float* g, float* out) {
    const int tid = launder_tid(), lane = tid & 63, wave = rfl(tid >> 6);
    const int gw = blockIdx.x * NWAVES + wave, NGW = gridDim.x * NWAVES;
    f32x4 gv[4];
#pragma unroll
    for (int j = 0; j < 4; ++j) gv[j] = *(const f32x4*)(g + 8 * lane + 512 * (j >> 1) + 4 * (j & 1));
    for (int m = gw; m < M; m += NGW) {
        const u32x4* xr = (const u32x4*)(xb + (size_t)m * D) + lane; f32x4 v[4]; float s = 0.f;
#pragma unroll
        for (int h = 0; h < 2; ++h) { const u32x4 w = xr[64 * h]; v[2 * h] = (f32x4){bflo(w.x), bfhi(w.x), bflo(w.y), bfhi(w.y)}; v[2 * h + 1] = (f32x4){bflo(w.z), bfhi(w.z), bflo(w.w), bfhi(w.w)}; }
#pragma unroll
        for (int j = 0; j < 4; ++j) s += (v[j].x * v[j].x + v[j].y * v[j].y) + (v[j].z * v[j].z + v[j].w * v[j].w);
        const float rstd = rsqf_(wave_sum(s) * (1.f / D) + EPS);
        f32x4* o = (f32x4*)(out + (size_t)m * D) + 2 * lane;
#pragma unroll
        for (int j = 0; j < 4; ++j) o[128 * (j >> 1) + (j & 1)] = v[j] * rstd * gv[j];
    }
}
struct ConvLd { u32x4 av[6], gv[6]; };
DEVI void conv_load(KArgs a, int item, ConvLd& L) {
    const int tid = launder_tid(); const int b = item / (SEQ / 64), t0 = (item % (SEQ / 64)) * 64;
    const bf16_t* HB = (const bf16_t*)(a->ws + OFF_HB);
#pragma unroll
    for (int e_ = 0; e_ < 6; ++e_) { const int e = tid + NTHREADS * e_, ec = e < 94 * 32 ? e : 94 * 32 - 1; const int r = ec >> 5, c8 = ec & 31, t = t0 - 15 + r; const int tc = t < 0 ? 0 : (t >= SEQ ? SEQ - 1 : t);
        const bf16_t* hp = HB + (size_t)(b * SEQ + tc) * NHB + c8 * 8; L.av[e_] = *(const u32x4*)(hp + C_GLUA); L.gv[e_] = *(const u32x4*)(hp + C_GLUG); }
}
template <class Hook> DEVI void conv_compute(KArgs a, unsigned char* lds, int layer, int item, const ConvLd& L, Hook&& hook) {
    const int tid = launder_tid(), lane = tid & 63, wave = rfl(tid >> 6), c = tid & 255, hf = tid >> 8;
    const int b = item / (SEQ / 64), t0 = (item % (SEQ / 64)) * 64;
    bf16_t* Y = (bf16_t*)(a->ws + OFF_Y);
    float* u = (float*)lds;
#pragma unroll
    for (int e_ = 0; e_ < 6; ++e_) { const int e = tid + NTHREADS * e_, ec = e < 94 * 32 ? e : 94 * 32 - 1; const int r = ec >> 5, c8 = ec & 31, t = t0 - 15 + r; const bool inr = t >= 0 && t < SEQ;
        const u32x4 av = L.av[e_], gv = L.gv[e_];
        f32x4 o0 = (f32x4){bflo(av.x) * sigmoidf_(bflo(gv.x)), bfhi(av.x) * sigmoidf_(bfhi(gv.x)), bflo(av.y) * sigmoidf_(bflo(gv.y)), bfhi(av.y) * sigmoidf_(bfhi(gv.y))};
        f32x4 o1 = (f32x4){bflo(av.z) * sigmoidf_(bflo(gv.z)), bfhi(av.z) * sigmoidf_(bfhi(gv.z)), bflo(av.w) * sigmoidf_(bflo(gv.w)), bfhi(av.w) * sigmoidf_(bfhi(gv.w))};
        if (!inr) { o0 = (f32x4){0.f, 0.f, 0.f, 0.f}; o1 = o0; }
        if (e < 94 * 32) { *(f32x4*)(u + r * 256 + c8 * 8) = o0; *(f32x4*)(u + r * 256 + c8 * 8 + 4) = o1; } }
    hook();
    float w[31];
    const float* cw = a->in[I_CW] + (size_t)layer * 31 * 256;
#pragma unroll
    for (int k = 0; k < 31; ++k) w[k] = cw[k * 256 + c];
    const float bias = a->in[I_CB][layer * 256 + c];
    lds_barrier();
    { float acc[32];
#pragma unroll
      for (int i = 0; i < 32; ++i) acc[i] = bias;
      const float* up = u + hf * 32 * 256 + c;
#pragma unroll
      for (int r = 0; r < 62; ++r) { const float v = up[r * 256];
#pragma unroll
          for (int i = 0; i < 32; ++i) if (r - i >= 0 && r - i <= 30) acc[i] += v * w[r - i]; }
      lds_barrier();
#pragma unroll
      for (int i = 0; i < 32; ++i) u[(hf * 32 + i) * 256 + c] = acc[i]; }
    lds_barrier();
    const f32x4 lg = *(const f32x4*)(a->in[I_CLG] + layer * 256 + 4 * lane), lb = *(const f32x4*)(a->in[I_CLB] + layer * 256 + 4 * lane);
#pragma unroll
    for (int bt = 0; bt < 2; ++bt) { f32x4 v[4]; float s[4];
#pragma unroll
      for (int i = 0; i < 4; ++i) { v[i] = *(const f32x4*)(u + (wave * 8 + bt * 4 + i) * 256 + 4 * lane); s[i] = (v[i].x + v[i].y) + (v[i].z + v[i].w); }
#pragma unroll
      for (int o = 1; o < 64; o <<= 1) {
#pragma unroll
          for (int i = 0; i < 4; ++i) s[i] += __shfl_xor(s[i], o); }
#pragma unroll
      for (int i = 0; i < 4; ++i) { v[i] = v[i] - s[i] * (1.f / 256); s[i] = (v[i].x * v[i].x + v[i].y * v[i].y) + (v[i].z * v[i].z + v[i].w * v[i].w); }
#pragma unroll
      for (int o = 1; o < 64; o <<= 1) {
#pragma unroll
          for (int i = 0; i < 4; ++i) s[i] += __shfl_xor(s[i], o); }
#pragma unroll
      for (int i = 0; i < 4; ++i) { const float rstd = rsqf_(s[i] * (1.f / 256) + EPS); const f32x4 ww = v[i] * rstd * lg + lb;
          u32x2 o; o.x = pk2(siluf_(ww.x), siluf_(ww.y)); o.y = pk2(siluf_(ww.z), siluf_(ww.w));
          *(u32x2*)(Y + (size_t)(b * SEQ + t0 + wave * 8 + bt * 4 + i) * D + 0 + 4 * lane) = o; } }
    lds_barrier();
}
constexpr int PD_LD = 264;
struct PoolLd { u32x4 v[5]; };
DEVI void pool_load(KArgs a, int item, PoolLd& L) {
    const int tid = launder_tid(); const int b = item / (SEQ / 64), t0 = (item % (SEQ / 64)) * 64;
    const bf16_t* HB = (const bf16_t*)(a->ws + OFF_HB);
#pragma unroll
    for (int e_ = 0; e_ < 5; ++e_) { const int e = tid + NTHREADS * e_, r = e >> 5, c8 = e & 31, t = t0 - 8 + r; const int tc = t < 0 ? 0 : (t >= SEQ ? SEQ - 1 : t);
        L.v[e_] = *(const u32x4*)(HB + (size_t)(b * SEQ + tc) * NHB + C_PIN + c8 * 8); }
}
template <class Hook> DEVI void pool_compute(KArgs a, unsigned char* lds, int layer, int item, const PoolLd& L, Hook&& hook) {
    const int tid = launder_tid(), lane = tid & 63, wave = rfl(tid >> 6), c = tid & 255, hf = tid >> 8;
    const int b = item / (SEQ / 64), t0 = (item % (SEQ / 64)) * 64;
    bf16_t* Y = (bf16_t*)(a->ws + OFF_Y);
    float* u = (float*)lds; bf16_t* ds = (bf16_t*)(u + 80 * 256);
#pragma unroll
    for (int e_ = 0; e_ < 5; ++e_) { const int e = tid + NTHREADS * e_, r = e >> 5, c8 = e & 31, t = t0 - 8 + r; const bool inr = t >= 0 && t < SEQ; const u32x4 v = L.v[e_];
        f32x4 o0 = (f32x4){bflo(v.x), bfhi(v.x), bflo(v.y), bfhi(v.y)}, o1 = (f32x4){bflo(v.z), bfhi(v.z), bflo(v.w), bfhi(v.w)};
        if (!inr) { o0 = (f32x4){0.f, 0.f, 0.f, 0.f}; o1 = o0; }
        *(f32x4*)(u + r * 256 + c8 * 8) = o0; *(f32x4*)(u + r * 256 + c8 * 8 + 4) = o1; }
    hook();
    lds_barrier();
    { const int gg = c >> 6;
      float uu[48];
      const float* up = u + (hf * 32) * 256 + c;
#pragma unroll
      for (int r = 0; r < 48; ++r) uu[r] = up[r * 256];
      float sm[32];
#pragma unroll
      for (int i = 0; i < 32; ++i) sm[i] = uu[8 + i - 1] + uu[8 + i];
      if (gg >= 1) {
#pragma unroll
          for (int i = 0; i < 32; ++i) sm[i] += uu[8 + i - 2] + uu[8 + i + 1]; }
      if (gg >= 2) {
#pragma unroll
          for (int i = 0; i < 32; ++i) sm[i] += (uu[8 + i - 4] + uu[8 + i - 3]) + (uu[8 + i + 2] + uu[8 + i + 3]); }
      if (gg >= 3) {
#pragma unroll
          for (int i = 0; i < 32; ++i) sm[i] += ((uu[8 + i - 8] + uu[8 + i - 7]) + (uu[8 + i - 6] + uu[8 + i - 5])) + ((uu[8 + i + 4] + uu[8 + i + 5]) + (uu[8 + i + 6] + uu[8 + i + 7])); }
      const int hw = 1 << gg;
#pragma unroll
      for (int i = 0; i < 32; ++i) { const int tt = hf * 32 + i, t = t0 + tt; const int lo = (t - hw) < 0 ? 0 : (t - hw), hi = (t + hw) > SEQ ? SEQ : (t + hw);
          ds[tt * PD_LD + c] = (bf16_t)f2bf(sm[i] / (float)(hi - lo) - uu[8 + i]); } }
    lds_barrier();
    { const int g = wave >> 1, et = wave & 1, r32 = lane & 31, hi = lane >> 5; const bf16_t* PWT = (const bf16_t*)(a->ws + OFF_PWT);
      f32x16 acc0 = {}, acc1 = {};
#pragma unroll
      for (int ks = 0; ks < 4; ++ks) { const bf16x8 af = *(const bf16x8*)(PWT + (size_t)(g * 64 + et * 32 + r32) * 64 + ks * 16 + hi * 8);
          acc0 = mfma32(af, *(const bf16x8*)(ds + r32 * PD_LD + g * 64 + ks * 16 + hi * 8), acc0); acc1 = mfma32(af, *(const bf16x8*)(ds + (32 + r32) * PD_LD + g * 64 + ks * 16 + hi * 8), acc1); }
      const float* psp = a->in[I_PS] + layer * 256 + g * 64 + et * 32 + 4 * hi; bf16_t* yp = Y + (size_t)(b * SEQ + t0 + r32) * D + 768 + g * 64 + et * 32 + 4 * hi;
#pragma unroll
      for (int g4 = 0; g4 < 4; ++g4) { const f32x4 ps = *(const f32x4*)(psp + 8 * g4); u32x2 w0, w1;
          w0.x = pk2(acc0[4 * g4] * ps[0], acc0[4 * g4 + 1] * ps[1]); w0.y = pk2(acc0[4 * g4 + 2] * ps[2], acc0[4 * g4 + 3] * ps[3]); *(u32x2*)(yp + 8 * g4) = w0;
          w1.x = pk2(acc1[4 * g4] * ps[0], acc1[4 * g4 + 1] * ps[1]); w1.y = pk2(acc1[4 * g4 + 2] * ps[2], acc1[4 * g4 + 3] * ps[3]); *(u32x2*)(yp + (size_t)32 * D + 8 * g4) = w1; } }
    lds_barrier();
}
DEVI int crow(int r, int hi) { return (r & 3) + 8 * (r >> 2) + 4 * hi; }
constexpr int KS_LD = 72, VT_LD = 388;
template <class Hook> DEVI void attn_item(KArgs a, unsigned char* lds, int layer, int item, Hook&& hook) {
    const int tid = launder_tid(), lane = tid & 63, wave = rfl(tid >> 6);
    const int b = item / (2 * NAB), kv = (item / NAB) & 1, n = item % NAB;
    const bf16_t* HB = (const bf16_t*)(a->ws + OFF_HB); bf16_t* Y = (bf16_t*)(a->ws + OFF_Y); const float* rope = (const float*)(a->ws + OFF_ROPE);
    bf16_t* Ks = (bf16_t*)lds; bf16_t* Vt = Ks + 384 * KS_LD;
    const int kbase = n * 128 - 128;
    { u32x4 kw[6], vw[6];
#pragma unroll
      for (int e_ = 0; e_ < 6; ++e_) { const int e = tid + NTHREADS * e_, wr = e >> 3, c8 = e & 7, kpos = kbase + wr; const int kc = kpos < 0 ? 0 : (kpos >= SEQ ? SEQ - 1 : kpos);
          const bf16_t* hp = HB + (size_t)(b * SEQ + kc) * NHB; kw[e_] = *(const u32x4*)(hp + C_AK + kv * 64 + c8 * 8); vw[e_] = *(const u32x4*)(hp + C_AV + kv * 64 + c8 * 8); }
      const int rw = tid < 384 ? tid : 383, rpos = kbase + rw, rc = rpos < 0 ? 0 : (rpos >= SEQ ? SEQ - 1 : rpos);
      const bf16_t* rhp = HB + (size_t)(b * SEQ + rc) * NHB + C_AK + kv * 64; const u32x4 x1 = *(const u32x4*)rhp, x2 = *(const u32x4*)(rhp + 8);
      const float* rp = rope + (size_t)rc * 16; const f32x4 r0 = *(const f32x4*)(rp), r1 = *(const f32x4*)(rp + 4), r2 = *(const f32x4*)(rp + 8), r3 = *(const f32x4*)(rp + 12);
#pragma unroll
      for (int e_ = 0; e_ < 6; ++e_) { const int e = tid + NTHREADS * e_, wr = e >> 3, c8 = e & 7, kpos = kbase + wr; const bool inr = kpos >= 0 && kpos < SEQ;
          if (!inr) { kw[e_] = (u32x4){0u, 0u, 0u, 0u}; vw[e_] = kw[e_]; }
          if (c8 >= 2) *(u32x4*)(Ks + wr * KS_LD + c8 * 8) = kw[e_];
#pragma unroll
          for (int j = 0; j < 4; ++j) { Vt[(c8 * 8 + 2 * j) * VT_LD + wr] = (bf16_t)(vw[e_][j] & 0xffffu); Vt[(c8 * 8 + 2 * j + 1) * VT_LD + wr] = (bf16_t)(vw[e_][j] >> 16); } }
      if (tid < 384) { const bool inr = rpos >= 0 && rpos < SEQ; const float rr[16] = {r0[0], r0[1], r0[2], r0[3], r1[0], r1[1], r1[2], r1[3], r2[0], r2[1], r2[2], r2[3], r3[0], r3[1], r3[2], r3[3]};
          float o1[8], o2[8];
#pragma unroll
          for (int j = 0; j < 4; ++j) { const float a0 = bflo(x1[j]), a1 = bfhi(x1[j]), b0 = bflo(x2[j]), b1 = bfhi(x2[j]);
              o1[2 * j] = a0 * rr[4 * j] - b0 * rr[4 * j + 1]; o1[2 * j + 1] = a1 * rr[4 * j + 2] - b1 * rr[4 * j + 3];
              o2[2 * j] = b0 * rr[4 * j] + a0 * rr[4 * j + 1]; o2[2 * j + 1] = b1 * rr[4 * j + 2] + a1 * rr[4 * j + 3]; }
          u32x4 w1 = (u32x4){pk2(o1[0], o1[1]), pk2(o1[2], o1[3]), pk2(o1[4], o1[5]), pk2(o1[6], o1[7])}, w2 = (u32x4){pk2(o2[0], o2[1]), pk2(o2[2], o2[3]), pk2(o2[4], o2[5]), pk2(o2[6], o2[7])};
          if (!inr) { w1 = (u32x4){0u, 0u, 0u, 0u}; w2 = w1; }
          *(u32x4*)(Ks + rw * KS_LD) = w1; *(u32x4*)(Ks + rw * KS_LD + 8) = w2; } }
    const int g = wave >> 2, hq = kv * 2 + g, q0l = (wave & 3) * 32, ql = lane & 31, hi = lane >> 5, qpos = n * 128 + q0l + ql;
    bf16x8 qf[4];
    { const bf16_t* qp = HB + (size_t)(b * SEQ + qpos) * NHB + C_AQ + hq * 64 + hi * 8; const float* rp = rope + (size_t)qpos * 16; const float sg = hi ? 1.f : -1.f;
#pragma unroll
      for (int ds = 0; ds < 4; ++ds) { const u32x4 w = *(const u32x4*)(qp + ds * 16); float v[8];
#pragma unroll
          for (int j = 0; j < 4; ++j) { v[2 * j] = bflo(w[j]); v[2 * j + 1] = bfhi(w[j]); }
          if (ds == 0) {
#pragma unroll
              for (int j = 0; j < 8; ++j) { const float p = __shfl_xor(v[j], 32); v[j] = v[j] * rp[2 * j] + sg * p * rp[2 * j + 1]; } }
          constexpr float QS = 0.125f * LOG2E;
          u32x4 o = (u32x4){pk2(v[0] * QS, v[1] * QS), pk2(v[2] * QS, v[3] * QS), pk2(v[4] * QS, v[5] * QS), pk2(v[6] * QS, v[7] * QS)};
          qf[ds] = __builtin_bit_cast(bf16x8, o); } }
    lds_barrier();
    hook();
    float m2 = a->in[I_SINK][layer * 4 + hq] * LOG2E, l_own = hi ? 0.f : 1.f;
    f32x16 o0 = {}, o1 = {};
    for (int kt = 0; kt < 9; ++kt) {
        const int wb = q0l + 32 * kt, kpos0 = kbase + wb;
        if (kpos0 < 0 || kpos0 >= SEQ) continue;
        f32x16 s = {};
#pragma unroll
        for (int ds = 0; ds < 4; ++ds) { const bf16x8 kf = *(const bf16x8*)(Ks + (wb + ql) * KS_LD + ds * 16 + hi * 8); s = mfma32(kf, qf[ds], s); }
        if (kt == 0) {
#pragma unroll
            for (int r = 0; r < 16; ++r) if (crow(r, hi) < ql) s[r] = -INFINITY; }
        if (kt == 8) {
#pragma unroll
            for (int r = 0; r < 16; ++r) if (crow(r, hi) > ql) s[r] = -INFINITY; }
        float mt = fmaxf(s[0], s[1]);
#pragma unroll
        for (int r = 2; r < 16; ++r) mt = fmaxf(mt, s[r]);
        mt = fmaxf(mt, __shfl_xor(mt, 32));
        const float mn = fmaxf(m2, mt), alpha = ex2(m2 - mn); const bool grew = mn > m2; m2 = mn;
        float ps = 0.f;
#pragma unroll
        for (int r = 0; r < 16; ++r) { s[r] = ex2(s[r] - mn); ps += s[r]; }
        l_own = l_own * alpha + ps;
        if (wave_any(grew)) {
#pragma unroll
            for (int r = 0; r < 16; ++r) { o0[r] *= alpha; o1[r] *= alpha; } }
        bf16x8 pb[2];
#pragma unroll
        for (int sI = 0; sI < 2; ++sI) { u32x4 w = (u32x4){pk2(s[8 * sI + 0], s[8 * sI + 1]), pk2(s[8 * sI + 2], s[8 * sI + 3]), pk2(s[8 * sI + 4], s[8 * sI + 5]), pk2(s[8 * sI + 6], s[8 * sI + 7])}; pb[sI] = __builtin_bit_cast(bf16x8, w); }
#pragma unroll
        for (int sI = 0; sI < 2; ++sI) {
            const bf16_t* v0 = Vt + (size_t)ql * VT_LD + wb + 16 * sI + 4 * hi;
            const s16x4 a0 = *(const s16x4*)(v0), a1 = *(const s16x4*)(v0 + 8), c0 = *(const s16x4*)(v0 + 32 * VT_LD), c1 = *(const s16x4*)(v0 + 32 * VT_LD + 8);
            o0 = mfma32((bf16x8){a0[0], a0[1], a0[2], a0[3], a1[0], a1[1], a1[2], a1[3]}, pb[sI], o0);
            o1 = mfma32((bf16x8){c0[0], c0[1], c0[2], c0[3], c1[0], c1[1], c1[2], c1[3]}, pb[sI], o1); }
    }
    const float linv = 1.0f / (l_own + __shfl_xor(l_own, 32));
    bf16_t* yp = Y + (size_t)(b * SEQ + qpos) * D + 512 + hq * 64 + 4 * hi;
#pragma unroll
    for (int g4 = 0; g4 < 4; ++g4) {
        u32x2 w0, w1; w0.x = pk2(o0[4 * g4] * linv, o0[4 * g4 + 1] * linv); w0.y = pk2(o0[4 * g4 + 2] * linv, o0[4 * g4 + 3] * linv);
        w1.x = pk2(o1[4 * g4] * linv, o1[4 * g4 + 1] * linv); w1.y = pk2(o1[4 * g4 + 2] * linv, o1[4 * g4 + 3] * linv);
        *(u32x2*)(yp + 8 * g4) = w0; *(u32x2*)(yp + 32 + 8 * g4) = w1; }
    lds_barrier();
}
DEVI void gla_ld16(const bf16_t* p, unsigned (&r)[16]) {
#pragma unroll
    for (int jj = 0; jj < 16; ++jj) r[jj] = p[(size_t)jj * NHB];
}
DEVI void gla_prep(const unsigned (&zraw)[16], float bu, int t, float* tot4  , float (&bcum)[16], float& total) {
    const int d = t & 31, dir = (t >> 5) & 1, seg = t >> 6;
    float lg[16];
#pragma unroll
    for (int jj = 0; jj < 16; ++jj) lg[jj] = logsigf_(bf2f(zraw[jj]) + bu) * (1.f / 16.f);
    float acc = 0.f;
    if (dir == 0) {
#pragma unroll
        for (int jj = 0; jj < 16; ++jj) { acc += lg[jj]; bcum[jj] = acc; } }
    else {
#pragma unroll
        for (int jj = 15; jj >= 0; --jj) { acc += lg[jj]; bcum[jj] = acc; } }
    tot4[seg * 64 + dir * 32 + d] = acc;
    lds_barrier();
    const float t0 = tot4[dir * 32 + d], t1 = tot4[64 + dir * 32 + d], t2 = tot4[128 + dir * 32 + d], t3 = tot4[192 + dir * 32 + d];
    total = (t0 + t1) + (t2 + t3);
    float off;
    if (dir == 0) off = (seg > 0 ? t0 : 0.f) + (seg > 1 ? t1 : 0.f) + (seg > 2 ? t2 : 0.f);
    else off = (seg < 3 ? t3 : 0.f) + (seg < 2 ? t2 : 0.f) + (seg < 1 ? t1 : 0.f);
#pragma unroll
    for (int jj = 0; jj < 16; ++jj) bcum[jj] += off;
}
constexpr int GVT_LD = 72, GQ_LD = 40;
DEVI void gla_load_v(const bf16_t* hrow0, int h, int t, u32x4 (&vw)[2]) {
#pragma unroll
    for (int e8_ = 0; e8_ < 2; ++e8_) { const int e8 = t + 256 * e8_, j = e8 >> 3, c8 = e8 & 7; vw[e8_] = *(const u32x4*)(hrow0 + (size_t)j * NHB + C_GV + h * 64 + c8 * 8); }
}
DEVI void gla_stage_vt(const u32x4 (&vw)[2], int t, bf16_t* Vt) {
#pragma unroll
    for (int e8_ = 0; e8_ < 2; ++e8_) { const int e8 = t + 256 * e8_, j = e8 >> 3, c8 = e8 & 7;
#pragma unroll
        for (int q = 0; q < 4; ++q) { Vt[(c8 * 8 + 2 * q) * GVT_LD + j] = (bf16_t)(vw[e8_][q] & 0xffffu); Vt[(c8 * 8 + 2 * q + 1) * GVT_LD + j] = (bf16_t)(vw[e8_][q] >> 16); } }
}
constexpr int GX_HALF = 9216 + 9216 + 1024;
struct GxLd { unsigned z[16], k[16]; u32x4 vw[2]; float bu; };
DEVI void gla_x_load(KArgs a, int layer, int pair, GxLd& L) {
    const int tid = launder_tid(), wave = rfl(tid >> 6), hf = wave >> 2, t = tid & 255;
    constexpr int N_GX = BATCH * NCH * 4;
    const int item = pair * 2 + hf; const int it_ = item < N_GX ? item : 0;
    const int h = it_ & 3, c = (it_ >> 2) % NCH, b = it_ / (4 * NCH);
    const bf16_t* hrow0 = (const bf16_t*)(a->ws + OFF_HB) + (size_t)(b * SEQ + c * 64) * NHB;
    const int d = t & 31, dir = (t >> 5) & 1, seg = t >> 6; const bf16_t* rp = hrow0 + (size_t)(seg * 16) * NHB + h * 32 + d;
    gla_ld16(rp + C_Z + dir * 128, L.z); gla_ld16(rp + C_GK, L.k); gla_load_v(hrow0, h, t, L.vw);
    L.bu = a->in[I_BUP][(size_t)layer * 256 + dir * 128 + h * 32 + d];
}
DEVI void gla_x_compute(KArgs a, unsigned char* lds, int layer, int pair, const GxLd& L) {
    const int tid = launder_tid(), lane = tid & 63, wave = rfl(tid >> 6), hf = wave >> 2, t = tid & 255, w4 = wave & 3;
    constexpr int N_GX = BATCH * NCH * 4;
    const int item = pair * 2 + hf; const bool act = item < N_GX; const int it_ = act ? item : 0;
    const int h = it_ & 3, c = (it_ >> 2) % NCH, b = it_ / (4 * NCH);
    unsigned char* base = lds + hf * GX_HALF;
    bf16_t* Kht = (bf16_t*)base; bf16_t* Vt = (bf16_t*)(base + 9216); float* tot4 = (float*)(base + 18432);
    float bc[16], total;
    gla_stage_vt(L.vw, t, Vt);
    gla_prep(L.z, L.bu, t, tot4, bc, total);
    { const int d = t & 31, dir = (t >> 5) & 1, seg = t >> 6;
      unsigned w[8];
#pragma unroll
      for (int q = 0; q < 8; ++q) { const float k0 = bf2f(L.k[2 * q]), k1 = bf2f(L.k[2 * q + 1]);
          w[q] = pk2(k0 * ex2((total - bc[2 * q]) * LOG2E), k1 * ex2((total - bc[2 * q + 1]) * LOG2E)); }
      u32x4* dst = (u32x4*)(Kht + (dir * 32 + d) * GVT_LD + seg * 16); dst[0] = (u32x4){w[0], w[1], w[2], w[3]}; dst[1] = (u32x4){w[4], w[5], w[6], w[7]};
      if (seg == 0 && act) ((float*)(a->ws + OFF_GD))[((size_t)((b * 4 + h) * 2 + dir) * NCH + c) * 32 + d] = ex2(total * LOG2E); }
    lds_barrier();
    { const int et = w4 & 1, dir = w4 >> 1, r32 = lane & 31, hi = lane >> 5; f32x16 u = {};
#pragma unroll
      for (int ks = 0; ks < 4; ++ks) { const bf16x8 af = *(const bf16x8*)(Vt + (et * 32 + r32) * GVT_LD + ks * 16 + hi * 8), bfr = *(const bf16x8*)(Kht + (dir * 32 + r32) * GVT_LD + ks * 16 + hi * 8); u = mfma32(af, bfr, u); }
      if (act) { float* gu = (float*)(a->ws + OFF_GU) + ((size_t)((b * 4 + h) * 2 + dir) * NCH + c) * 2048;
#pragma unroll
          for (int r = 0; r < 16; ++r) gu[(et * 32 + crow(r, hi)) * 32 + r32] = u[r]; } }
    lds_barrier();
}
DEVI void gla_scan(KArgs a) {
    float* GU = (float*)(a->ws + OFF_GU); const float* GD = (const float*)(a->ws + OFF_GD);
    constexpr int TOTAL = BATCH * 4 * 2 * 2048, UNR = (NCH % 16 == 0) ? 16 : 4;
    const int tid = launder_tid(); if (tid >= 128) return;
    for (int eid = blockIdx.x * 128 + tid; eid < TOTAL; eid += gridDim.x * 128) {
        const int seq = eid >> 11, de = eid & 2047, d = de & 31, dir = seq & 1; float S = 0.f;
        for (int s0 = 0; s0 < NCH; s0 += UNR) { float u[UNR], dc[UNR];
#pragma unroll
            for (int k = 0; k < UNR; ++k) { const int c = dir ? NCH - 1 - (s0 + k) : s0 + k; u[k] = GU[((size_t)seq * NCH + c) * 2048 + de]; dc[k] = GD[((size_t)seq * NCH + c) * 32 + d]; }
#pragma unroll
            for (int k = 0; k < UNR; ++k) { const int c = dir ? NCH - 1 - (s0 + k) : s0 + k; GU[((size_t)seq * NCH + c) * 2048 + de] = S; S = dc[k] * S + u[k]; } }
    }
}
constexpr int GZ_HALF = 10240 + 10240 + 9216 + 10240 + 1024 + 512;
struct GzLd { unsigned z[16], q[16], k[16]; u32x4 vw[2]; f32x4 s[4]; float bu; };
DEVI void gla_z_load(KArgs a, int layer, int pair, GzLd& L) {
    const int tid = launder_tid(), wave = rfl(tid >> 6), hf = wave >> 2, t = tid & 255;
    constexpr int N_GZ = BATCH * NCH * 4;
    const int item = pair * 2 + hf; const int it_ = item < N_GZ ? item : 0;
    const int h = it_ & 3, c = (it_ >> 2) % NCH, b = it_ / (4 * NCH);
    const bf16_t* hrow0 = (const bf16_t*)(a->ws + OFF_HB) + (size_t)(b * SEQ + c * 64) * NHB;
    const int d = t & 31, dir = (t >> 5) & 1, seg = t >> 6; const bf16_t* rp = hrow0 + (size_t)(seg * 16) * NHB + h * 32 + d;
    gla_ld16(rp + C_Z + dir * 128, L.z); gla_ld16(rp + C_GQ, L.q); gla_ld16(rp + C_GK, L.k); gla_load_v(hrow0, h, t, L.vw);
    L.bu = a->in[I_BUP][(size_t)layer * 256 + dir * 128 + h * 32 + d];
    const float* GU = (const float*)(a->ws + OFF_GU);
#pragma unroll
    for (int e4_ = 0; e4_ < 4; ++e4_) { const int e4 = t + 256 * e4_, dr = e4 >> 9, ed = (e4 & 511) * 4; L.s[e4_] = *(const f32x4*)(GU + ((size_t)((b * 4 + h) * 2 + dr) * NCH + c) * 2048 + ed); }
}
DEVI void gla_z_compute(KArgs a, unsigned char* lds, int layer, int pair, const GzLd& L) {
    const int tid = launder_tid(), lane = tid & 63, wave = rfl(tid >> 6), hf = wave >> 2, t = tid & 255, w4 = wave & 3;
    constexpr int N_GZ = BATCH * NCH * 4;
    const int item = pair * 2 + hf; const bool act = item < N_GZ; const int it_ = act ? item : 0;
    const int h = it_ & 3, c = (it_ >> 2) % NCH, b = it_ / (4 * NCH);
    const bf16_t* hrow0 = (const bf16_t*)(a->ws + OFF_HB) + (size_t)(b * SEQ + c * 64) * NHB;
    unsigned char* base = lds + hf * GZ_HALF;
    bf16_t* Qs = (bf16_t*)base; bf16_t* Ks = (bf16_t*)(base + 10240); bf16_t* Vt = (bf16_t*)(base + 20480); bf16_t* St = (bf16_t*)(base + 29696);
    float* tot4 = (float*)(base + 39936); float* rsum = (float*)(base + 40960);
    float bc[16], total;
    gla_stage_vt(L.vw, t, Vt);
#pragma unroll
    for (int e4_ = 0; e4_ < 4; ++e4_) { const int e4 = t + 256 * e4_, dir = e4 >> 9, ed = (e4 & 511) * 4, e = ed >> 5, d0 = ed & 31;
        u32x2 w; w.x = pk2(L.s[e4_][0], L.s[e4_][1]); w.y = pk2(L.s[e4_][2], L.s[e4_][3]); *(u32x2*)(St + (dir * 64 + e) * GQ_LD + d0) = w; }
    gla_prep(L.z, L.bu, t, tot4, bc, total);
    { const int d = t & 31, dir = (t >> 5) & 1, seg = t >> 6;
#pragma unroll
      for (int jj = 0; jj < 16; ++jj) { const float q = bf2f(L.q[jj]) * 0.17677669529663687f, k = bf2f(L.k[jj]); const float bb = bc[jj] * LOG2E;
          Qs[(dir * 64 + seg * 16 + jj) * GQ_LD + d] = (bf16_t)f2bf(q * ex2(bb)); Ks[(dir * 64 + seg * 16 + jj) * GQ_LD + d] = (bf16_t)f2bf(k * ex2(-bb)); } }
    lds_barrier();
    const int itl = w4 & 1, et = w4 >> 1, r32 = lane & 31, hi = lane >> 5;
    bf16x8 qf[2][2];
#pragma unroll
    for (int dir = 0; dir < 2; ++dir)
#pragma unroll
        for (int ks = 0; ks < 2; ++ks) qf[dir][ks] = *(const bf16x8*)(Qs + (dir * 64 + itl * 32 + r32) * GQ_LD + ks * 16 + hi * 8);
    f32x16 o = {};
#pragma unroll
    for (int jt = 0; jt < 2; ++jt) {
        f32x16 xa = {};
        if (jt == itl) { f32x16 xf = {}, xb = {};
#pragma unroll
            for (int ks = 0; ks < 2; ++ks) { xf = mfma32(*(const bf16x8*)(Ks + (jt * 32 + r32) * GQ_LD + ks * 16 + hi * 8), qf[0][ks], xf);
                                             xb = mfma32(*(const bf16x8*)(Ks + (64 + jt * 32 + r32) * GQ_LD + ks * 16 + hi * 8), qf[1][ks], xb); }
#pragma unroll
            for (int r = 0; r < 16; ++r) { const int jl = crow(r, hi); xa[r] = (jl <= r32 ? xf[r] : 0.f) + (jl >= r32 ? xb[r] : 0.f); } }
        else { const int dir = jt < itl ? 0 : 1;
#pragma unroll
            for (int ks = 0; ks < 2; ++ks) xa = mfma32(*(const bf16x8*)(Ks + (dir * 64 + jt * 32 + r32) * GQ_LD + ks * 16 + hi * 8), qf[dir][ks], xa); }
#pragma unroll
        for (int s = 0; s < 2; ++s) { const u32x4 w = (u32x4){pk2(xa[8 * s + 0], xa[8 * s + 1]), pk2(xa[8 * s + 2], xa[8 * s + 3]), pk2(xa[8 * s + 4], xa[8 * s + 5]), pk2(xa[8 * s + 6], xa[8 * s + 7])};
            const bf16_t* vp = Vt + (et * 32 + r32) * GVT_LD + jt * 32 + 16 * s + 4 * hi; const s16x4 a0 = *(const s16x4*)vp, a1 = *(const s16x4*)(vp + 8);
            o = mfma32((bf16x8){a0[0], a0[1], a0[2], a0[3], a1[0], a1[1], a1[2], a1[3]}, __builtin_bit_cast(bf16x8, w), o); } }
#pragma unroll
    for (int dir = 0; dir < 2; ++dir)
#pragma unroll
        for (int ks = 0; ks < 2; ++ks) o = mfma32(*(const bf16x8*)(St + (dir * 64 + et * 32 + r32) * GQ_LD + ks * 16 + hi * 8), qf[dir][ks], o);
    float ss = 0.f;
#pragma unroll
    for (int r = 0; r < 16; ++r) ss += o[r] * o[r];
    ss += __shfl_xor(ss, 32);
    if (hi == 0) rsum[et * 64 + itl * 32 + r32] = ss;
    lds_barrier();
    if (act) { const int il = itl * 32 + r32; const float rstd = rsqf_((rsum[il] + rsum[64 + il]) * (1.f / 64.f) + EPS);
        const bf16_t* grp = hrow0 + (size_t)il * NHB + C_GR + h * 64 + et * 32 + 4 * hi; const float* ngp = a->in[I_GNG] + layer * 256 + h * 64 + et * 32 + 4 * hi;
        bf16_t* yp = (bf16_t*)(a->ws + OFF_Y) + (size_t)(b * SEQ + c * 64 + il) * D + 256 + h * 64 + et * 32 + 4 * hi;
#pragma unroll
        for (int g4 = 0; g4 < 4; ++g4) { const u32x2 gw = *(const u32x2*)(grp + 8 * g4); const f32x4 ng = *(const f32x4*)(ngp + 8 * g4);
            u32x2 w; w.x = pk2(o[4 * g4] * rstd * ng[0] * siluf_(bflo(gw.x)), o[4 * g4 + 1] * rstd * ng[1] * siluf_(bfhi(gw.x)));
            w.y = pk2(o[4 * g4 + 2] * rstd * ng[2] * siluf_(bflo(gw.y)), o[4 * g4 + 3] * rstd * ng[3] * siluf_(bfhi(gw.y)));
            *(u32x2*)(yp + 8 * g4) = w; } }
    lds_barrier();
}
DEVI void phase_mix1(KArgs a, unsigned char* lds, int layer) {
    constexpr int N_RND = BATCH * 2 * NAB, N_GXP = BATCH * NCH * 4 / 2;
    static_assert(BATCH * (SEQ / 64) == N_RND && N_GXP == 2 * N_RND, "one conv tile, one pool tile and two GLA pairs per attention block");
    for (int r = blockIdx.x; r < N_RND; r += gridDim.x) {
        ConvLd lc; PoolLd lp; GxLd lx0, lx1;
        attn_item(a, lds, layer, r, [&] { conv_load(a, r, lc); });
        conv_compute(a, lds, layer, r, lc, [&] { pool_load(a, r, lp); });
        pool_compute(a, lds, layer, r, lp, [&] { gla_x_load(a, layer, r, lx0); });
        gla_x_load(a, layer, r + N_RND, lx1);
        gla_x_compute(a, lds, layer, r, lx0); gla_x_compute(a, lds, layer, r + N_RND, lx1); }
}
DEVI void phase_mix3(KArgs a, unsigned char* lds, int layer) {
    constexpr int N_GZP = BATCH * NCH * 4 / 2;
    for (int it = blockIdx.x; it < N_GZP; it += 2 * gridDim.x) { const int it2 = it + gridDim.x; GzLd L0, L1;
        gla_z_load(a, layer, it, L0); if (it2 < N_GZP) gla_z_load(a, layer, it2, L1);
        gla_z_compute(a, lds, layer, it, L0); if (it2 < N_GZP) gla_z_compute(a, lds, layer, it2, L1); }
}

namespace pg8 {
constexpr int BM = 256, BK = 64, HALF = 128, HTB = HALF * BK * 2, STAGE_BYTES = 8 * HTB, NXCD = 8, WGM = 8;
DEVI int lds_byte(int r, int c) { const int st = (r >> 4) * 2 + (c >> 5), rr = r & 15, cc = c & 31, ob = rr * 64 + cc * 2; return st * 1024 + (ob ^ (((ob >> 9) & 1) << 5)); }
DEVI void stage_rc(int b, int& R, int& C) { const int st = b / 1024, sb = b % 1024, swz = sb ^ (((sb >> 9) & 1) << 5); R = (st >> 1) * 16 + swz / 64; C = (st & 1) * 32 + (swz % 64) / 2; }
DEVI int perm32(int rho) { const int n = rho >> 4, i = rho & 15; return 8 * (i >> 2) + 4 * n + (i & 3); }
typedef pg8_unit_fwd Unit;
struct Gemm { const bf16_t* A; const bf16_t* Bt; };
struct StaticOrder {
    int nM, nN, nwg, G, c;
    DEVM void init(int Mr, int N, int G_, int c_) { nM = Mr / BM; nN = N / BM; nwg = nM * nN; G = G_; c = c_; }
    DEVM bool tile(long L, Unit& u) const {
        if (L >= nwg) return false;
        int wgid = (int)L; { const int q = nwg / NXCD, r = nwg % NXCD, xcd = wgid % NXCD, off = wgid / NXCD; wgid = (xcd < r ? xcd * (q + 1) : r * (q + 1) + (xcd - r) * q) + off; }
        const int nig = WGM * nN, gid = wgid / nig, fm = gid * WGM, gsz = (nM - fm) < WGM ? (nM - fm) : WGM;
        u.pm = fm + ((wgid % nig) % gsz); u.pn = (wgid % nig) / gsz; u.br = 0; return true;
    }
    typedef Unit unit_t;
    DEVM bool next(int i, Unit& u) const { u.ui = i; return tile((long)i * G + c, u); }
};
template <class Sched> DEVM void fill_rstd(const Sched& S, const float* part, float* tab) {
    const int tid = threadIdx.x; Unit u;
    if (tid < 256) for (int ui = 0; S.next(ui, u); ++ui) { const f32x4* p = (const f32x4*)(part + (size_t)(u.pm * 256 + tid) * 16); const f32x4 s = (p[0] + p[1]) + (p[2] + p[3]);
        tab[ui * 256 + tid] = rsqf_(((s.x + s.y) + (s.z + s.w)) * (1.f / D) + EPS); }
}
template <int ACT  > struct EpiBf16 {
    static constexpr bool PERM = true, HAS_MID = false, HAS_INIT = false;
    bf16_t* O; int ldc; float* tab; const float* part;
    template <class Sched> DEVM void pre(const Sched& S) const { fill_rstd(S, part, tab); }
    DEVM void operator()(const f32x4 (&acc)[2][2][4][2], const Unit& u, int wr, int wc, int fr, int fq) const {
        const int row0 = u.pm * BM + wr * 64 + fr, col0 = u.pn * BM + wc * 32 + 8 * fq;
#pragma unroll
        for (int ai = 0; ai < 2; ++ai)
#pragma unroll
            for (int m = 0; m < 4; ++m) { bf16_t* rowp = O + (size_t)(row0 + ai * HALF + m * 16) * ldc + col0; const float rs = tab[u.ui * 256 + ai * HALF + wr * 64 + m * 16 + fr];
#pragma unroll
                for (int bj = 0; bj < 2; ++bj) { f32x4 v0 = acc[ai][bj][m][0] * rs, v1 = acc[ai][bj][m][1] * rs;
                    if (ACT == 1) {
#pragma unroll
                        for (int q = 0; q < 4; ++q) { v0[q] = sigmoidf_(v0[q]); v1[q] = sigmoidf_(v1[q]); } }
                    if (ACT == 2) {
#pragma unroll
                        for (int q = 0; q < 4; ++q) { const float r0 = fmaxf(v0[q], 0.f), r1 = fmaxf(v1[q], 0.f); v0[q] = r0 * r0; v1[q] = r1 * r1; } }
                    u32x4 w; w.x = pk2(v0[0], v0[1]); w.y = pk2(v0[2], v0[3]); w.z = pk2(v1[0], v1[1]); w.w = pk2(v1[2], v1[3]);
                    *(u32x4*)(rowp + bj * HALF) = w; } }
    }
};
struct EpiGate {
    static constexpr bool PERM = true, HAS_MID = false, HAS_INIT = false;
    bf16_t* R; float* tab; const float* part;
    template <class Sched> DEVM void pre(const Sched& S) const { fill_rstd(S, part, tab); }
    DEVM void operator()(const f32x4 (&acc)[2][2][4][2], const Unit& u, int wr, int wc, int fr, int fq) const {
        const int row0 = u.pm * BM + wr * 64 + fr, d0 = u.pn * 64 + wc * 16 + 4 * fq;
#pragma unroll
        for (int ai = 0; ai < 2; ++ai)
#pragma unroll
            for (int m = 0; m < 4; ++m) { bf16_t* rowp = R + (size_t)(row0 + ai * HALF + m * 16) * NGATE + d0; const float rs = tab[u.ui * 256 + ai * HALF + wr * 64 + m * 16 + fr] * LOG2E;
                float r[4][4];
#pragma unroll
                for (int q = 0; q < 4; ++q) { float den[4];
#pragma unroll
                    for (int b = 0; b < 4; ++b) den[b] = 1.0f + ex2(-acc[ai][b >> 1][m][b & 1][q] * rs);
                    const float i0 = rcpf_(den[0]), i1 = rcpf_(den[1]), i2 = rcpf_(den[2]), i3 = rcpf_(den[3]);
                    r[0][q] = den[1] * i0; r[1][q] = den[2] * i1; r[2][q] = den[3] * i2; r[3][q] = i3; }
#pragma unroll
                for (int b = 0; b < 4; ++b) { u32x2 w; w.x = pk2(r[b][0], r[b][1]); w.y = pk2(r[b][2], r[b][3]); *(u32x2*)(rowp + b * D) = w; } }
    }
};
struct EpiMerge {
    static constexpr bool PERM = true, HAS_MID = true, HAS_INIT = false;
    bf16_t* O; const bf16_t* R;
    template <class Sched> DEVM void pre(const Sched&) const {}
    DEVM void scale(f32x4 (&acc)[2][2][4][2], const Unit& u, int b, int wr, int wc, int fr, int fq) const {
        const int row0 = u.pm * BM + wr * 64 + fr, col0 = u.pn * BM + wc * 32 + 8 * fq;
#pragma unroll
        for (int ai = 0; ai < 2; ++ai)
#pragma unroll
            for (int m = 0; m < 4; ++m) { const unsigned go = ((unsigned)(row0 + ai * HALF + m * 16) * NGATE + b * D + col0) * 2u;
#pragma unroll
                for (int bj = 0; bj < 2; ++bj) { const u32x4 gw = *(const u32x4*)((const char*)R + go + bj * HALF * 2);
                    acc[ai][bj][m][0] *= (f32x4){bflo(gw.x), bfhi(gw.x), bflo(gw.y), bfhi(gw.y)}; acc[ai][bj][m][1] *= (f32x4){bflo(gw.z), bfhi(gw.z), bflo(gw.w), bfhi(gw.w)}; }
#ifndef CPU_EMU
                if (m == 3) asm volatile("" ::: "memory");
#endif
            }
    }
    DEVM void mid(f32x4 (&acc)[2][2][4][2], const Unit& u, int b, int wr, int wc, int fr, int fq) const { scale(acc, u, b, wr, wc, fr, fq); }
    DEVM void operator()(f32x4 (&acc)[2][2][4][2], const Unit& u, int wr, int wc, int fr, int fq) const {
        scale(acc, u, 3, wr, wc, fr, fq);
        const int row0 = u.pm * BM + wr * 64 + fr, col0 = u.pn * BM + wc * 32 + 8 * fq;
#pragma unroll
        for (int ai = 0; ai < 2; ++ai)
#pragma unroll
            for (int m = 0; m < 4; ++m) { bf16_t* rowp = O + (size_t)(row0 + ai * HALF + m * 16) * D + col0;
#pragma unroll
                for (int bj = 0; bj < 2; ++bj) { const f32x4 v0 = acc[ai][bj][m][0], v1 = acc[ai][bj][m][1];
                    u32x4 w; w.x = pk2(v0[0], v0[1]); w.y = pk2(v0[2], v0[3]); w.z = pk2(v1[0], v1[1]); w.w = pk2(v1[2], v1[3]); *(u32x4*)(rowp + bj * HALF) = w; } }
    }
};
struct EpiResNorm {
    static constexpr bool PERM = true, HAS_MID = false, HAS_INIT = true;
    const bf16_t* base; bf16_t* xb; float* part;
    template <class Sched> DEVM void pre(const Sched&) const {}
    DEVM void init(f32x4 (&acc)[2][2][4][2], const Unit& u, int wr, int wc, int fr, int fq) const {
        const int row0 = u.pm * BM + wr * 64 + fr, col0 = u.pn * BM + wc * 32 + 8 * fq;
#pragma unroll
        for (int ai = 0; ai < 2; ++ai)
#pragma unroll
            for (int m = 0; m < 4; ++m) { const unsigned off = ((unsigned)(row0 + ai * HALF + m * 16) * D + col0) * 2u;
#pragma unroll
                for (int bj = 0; bj < 2; ++bj) { const u32x4 bw = *(const u32x4*)((const char*)base + off + bj * HALF * 2);
                    acc[ai][bj][m][0] = (f32x4){bflo(bw.x), bfhi(bw.x), bflo(bw.y), bfhi(bw.y)}; acc[ai][bj][m][1] = (f32x4){bflo(bw.z), bfhi(bw.z), bflo(bw.w), bfhi(bw.w)}; } }
    }
    DEVM void operator()(const f32x4 (&acc)[2][2][4][2], const Unit& u, int wr, int wc, int fr, int fq) const {
        const int row0 = u.pm * BM + wr * 64 + fr, col0 = u.pn * BM + wc * 32 + 8 * fq;
#pragma unroll
        for (int ai = 0; ai < 2; ++ai)
#pragma unroll
            for (int m = 0; m < 4; ++m) { const unsigned row = (unsigned)(row0 + ai * HALF + m * 16), off = (row * D + col0) * 2u; float ss = 0.f;
#pragma unroll
                for (int bj = 0; bj < 2; ++bj) { const f32x4 v0 = acc[ai][bj][m][0], v1 = acc[ai][bj][m][1];
                    u32x4 w; w.x = pk2(v0[0], v0[1]); w.y = pk2(v0[2], v0[3]); w.z = pk2(v1[0], v1[1]); w.w = pk2(v1[2], v1[3]);
                    *(u32x4*)((char*)xb + off + bj * HALF * 2) = w;
                    const float x0 = bflo(w.x), x1 = bfhi(w.x), x2 = bflo(w.y), x3 = bfhi(w.y), x4 = bflo(w.z), x5 = bfhi(w.z), x6 = bflo(w.w), x7 = bfhi(w.w);
                    ss += ((x0 * x0 + x1 * x1) + (x2 * x2 + x3 * x3)) + ((x4 * x4 + x5 * x5) + (x6 * x6 + x7 * x7)); }
                ss += __shfl_xor(ss, 16); ss += __shfl_xor(ss, 32);
                if (fq == 0) part[(size_t)row * 16 + u.pn * 4 + wc] = ss; }
    }
};
#ifndef CPU_EMU
#define PG8_LAS __attribute__((address_space(3)))
template <class Epi, class Sched, int KDIM, bool ALIGN_EPI = true>
__device__ __forceinline__ void gemm_phase(PG8_LAS unsigned char* lds, const Gemm g, const Sched& S, const Epi& E) {
    int tid_ = threadIdx.x; asm volatile("" : "+v"(tid_));
    const int tid = tid_, wid = __builtin_amdgcn_readfirstlane(tid >> 6), lane = tid & 63, wr = wid >> 2, wc = wid & 3, fr = lane & 15, fq = lane >> 4;
    constexpr int nt = KDIM / BK;
    unsigned voffA[2], voffB[2];
#pragma unroll
    for (int i = 0; i < 2; ++i) { int R, C; stage_rc(tid * 16 + i * 8192, R, C); const int Rb = Epi::PERM ? ((R & ~31) + perm32(R & 31)) : R;
        voffA[i] = (unsigned)(R * KDIM + C) * 2u; voffB[i] = (unsigned)(Rb * KDIM + C) * 2u; }
    constexpr size_t kstep = (size_t)(BK * 2);
    constexpr size_t hstepA = (size_t)HALF * KDIM * 2, hstepB = hstepA;
    constexpr size_t tstepA = 2 * hstepA, tstepB = 2 * hstepB;
    const unsigned ldsw = (unsigned)wid * 1024u;
    const int aoff = lds_byte(wr * 64 + fr, fq * 8), boff = lds_byte(wc * 32 + fr, fq * 8);
#define PG8_SA(b, h) (((b) * 2 + (h)) * HTB)
#define PG8_SB(b, h) ((4 + (b) * 2 + (h)) * HTB)
#define PG8_STAGE(bufoff, gbase, voff) do { _Pragma("unroll") for (int _i = 0; _i < 2; ++_i) \
        __builtin_amdgcn_global_load_lds((const unsigned*)((const char*)(gbase) + (voff)[_i]), (PG8_LAS unsigned*)(lds + (bufoff) + ldsw + _i * 8192), 16, 0, 0); } while (0)
#define PG8_LDA(dst, b, h) do { _Pragma("unroll") for (int m = 0; m < 4; ++m) _Pragma("unroll") for (int k = 0; k < 2; ++k) dst[m][k] = *(const PG8_LAS bf16x8*)(lds + PG8_SA(b, h) + aoff + m * 2048 + k * 1024); } while (0)
#define PG8_LDB(dst, b, h) do { _Pragma("unroll") for (int n = 0; n < 2; ++n) _Pragma("unroll") for (int k = 0; k < 2; ++k) dst[n][k] = *(const PG8_LAS bf16x8*)(lds + PG8_SB(b, h) + boff + n * 2048 + k * 1024); } while (0)
#define PG8_MMA(ai, bj, At, Bt) do { __builtin_amdgcn_s_setprio(1); _Pragma("unroll") for (int m = 0; m < 4; ++m) _Pragma("unroll") for (int n = 0; n < 2; ++n) _Pragma("unroll") for (int k = 0; k < 2; ++k) \
        acc[ai][bj][m][n] = __builtin_amdgcn_mfma_f32_16x16x32_bf16(Bt[n][k], At[m][k], acc[ai][bj][m][n], 0, 0, 0); __builtin_amdgcn_s_setprio(0); } while (0)
#define PG8_WAIT_V(n) asm volatile("s_waitcnt vmcnt(" #n ")" ::: "memory")
#define PG8_WAIT_L(n) asm volatile("s_waitcnt lgkmcnt(" #n ")" ::: "memory")
#define PG8_BAR __builtin_amdgcn_s_barrier()
#define PG8_SCHED __builtin_amdgcn_sched_barrier(0)
#define PG8_ABASE(u) ((const char*)g.A + (size_t)(u).pm * tstepA)
#define PG8_BBASE(u) ((const char*)g.Bt + (size_t)(u).pn * tstepB)
    Unit cur, nxt; int ui = 0;
    if (!S.next(0, cur)) return;
    f32x4 acc[2][2][4][2];
#pragma unroll
    for (int a = 0; a < 2; ++a)
#pragma unroll
        for (int b = 0; b < 2; ++b)
#pragma unroll
            for (int m = 0; m < 4; ++m)
#pragma unroll
                for (int n = 0; n < 2; ++n) acc[a][b][m][n] = (f32x4){0.f, 0.f, 0.f, 0.f};
    if constexpr (Epi::HAS_INIT) E.init(acc, cur, wr, wc, fr, fq);
    bf16x8 At[4][2], B0[2][2], B1[2][2];
    const char* cA = PG8_ABASE(cur); const char* cB = PG8_BBASE(cur);
    PG8_STAGE(PG8_SB(0, 0), cB, voffB); PG8_STAGE(PG8_SB(0, 1), cB + hstepB, voffB); PG8_STAGE(PG8_SA(0, 0), cA, voffA); PG8_STAGE(PG8_SA(0, 1), cA + hstepA, voffA);
    E.pre(S);
    if (wr == 1) PG8_BAR;
    PG8_WAIT_V(2); PG8_BAR;
    PG8_STAGE(PG8_SB(1, 0), cB + kstep, voffB); PG8_STAGE(PG8_SA(1, 0), cA + kstep, voffA); PG8_STAGE(PG8_SB(1, 1), cB + hstepB + kstep, voffB);
    PG8_WAIT_V(6); PG8_BAR;
    for (;;) {
        const bool has_next = S.next(ui + 1, nxt);
        const char* nA = has_next ? PG8_ABASE(nxt) : cA; const char* nB = has_next ? PG8_BBASE(nxt) : cB;
#pragma nounroll
        for (int t = 0; t < nt; t += 2) {
            const bool last = (t == nt - 2);
            const char* a1 = cA + (size_t)(t + 1) * kstep;
            const char* a2 = last ? nA : cA + (size_t)(t + 2) * kstep; const char* b2 = last ? nB : cB + (size_t)(t + 2) * kstep;
            const char* a3 = a2 + kstep; const char* b3 = b2 + kstep;
            PG8_LDB(B0, 0, 0); PG8_LDB(B1, 0, 1); PG8_SCHED; PG8_LDA(At, 0, 0); PG8_STAGE(PG8_SA(1, 1), a1 + hstepA, voffA);
            PG8_WAIT_V(8); PG8_WAIT_L(0); PG8_BAR; PG8_MMA(0, 0, At, B0); PG8_MMA(0, 1, At, B1); PG8_BAR; PG8_SCHED;
            PG8_LDA(At, 0, 1); PG8_STAGE(PG8_SB(0, 0), b2, voffB); PG8_STAGE(PG8_SB(0, 1), b2 + hstepB, voffB); PG8_STAGE(PG8_SA(0, 0), a2, voffA);
            PG8_WAIT_V(8); PG8_WAIT_L(0); PG8_BAR; PG8_MMA(1, 0, At, B0); PG8_MMA(1, 1, At, B1); PG8_BAR; PG8_SCHED;
            PG8_LDB(B0, 1, 0); PG8_LDB(B1, 1, 1); PG8_SCHED; PG8_LDA(At, 1, 0); PG8_STAGE(PG8_SA(0, 1), a2 + hstepA, voffA);
            PG8_WAIT_V(8); PG8_WAIT_L(0); PG8_BAR; PG8_MMA(0, 0, At, B0); PG8_MMA(0, 1, At, B1); PG8_BAR; PG8_SCHED;
            PG8_LDA(At, 1, 1); PG8_STAGE(PG8_SB(1, 0), b3, voffB); PG8_STAGE(PG8_SB(1, 1), b3 + hstepB, voffB); PG8_STAGE(PG8_SA(1, 0), a3, voffA);
            PG8_WAIT_V(8); PG8_WAIT_L(0); PG8_BAR; PG8_MMA(1, 0, At, B0); PG8_MMA(1, 1, At, B1); PG8_BAR; PG8_SCHED;
            if constexpr (Epi::HAS_MID) { if (((t + 2) & 3) == 0 && !last) { E.mid(acc, cur, ((t + 2) >> 2) - 1, wr, wc, fr, fq); PG8_SCHED; } }
        }
        if constexpr (ALIGN_EPI) { if (wr == 0) PG8_BAR; }
        E(acc, cur, wr, wc, fr, fq);
        if (!has_next) break;
#pragma unroll
        for (int a = 0; a < 2; ++a)
#pragma unroll
            for (int b = 0; b < 2; ++b)
#pragma unroll
                for (int m = 0; m < 4; ++m)
#pragma unroll
                    for (int n = 0; n < 2; ++n) acc[a][b][m][n] = (f32x4){0.f, 0.f, 0.f, 0.f};
        cur = nxt; cA = nA; cB = nB; ++ui;
        if constexpr (Epi::HAS_INIT) E.init(acc, cur, wr, wc, fr, fq);
        if constexpr (ALIGN_EPI) { if (wr == 1) PG8_BAR; }
    }
    PG8_WAIT_V(0);
    if constexpr (!ALIGN_EPI) { if (wr == 0) PG8_BAR; }
    PG8_BAR;
#undef PG8_SA
#undef PG8_SB
#undef PG8_STAGE
#undef PG8_LDA
#undef PG8_LDB
#undef PG8_MMA
#undef PG8_WAIT_V
#undef PG8_WAIT_L
#undef PG8_BAR
#undef PG8_SCHED
#undef PG8_ABASE
#undef PG8_BBASE
}
#endif
}

#ifndef CPU_EMU
#define LAS __attribute__((address_space(3)))
#define XB_TMO      128
#define XB_XCNT(j)  (256  + 64 * (j))
#define XB_XSUB(j)  (1280 + 64 * (j))
#define XB_XGEN(j)  (2304 + 64 * (j))
#define XB_TOP      3328
#define XB_TOPGEN   3392
#define XCD_BAR_WORDS 3456
#define XB_SPIN_CAP (1u << 20)
__device__ __forceinline__ unsigned xb_ld(unsigned* p)              { return __hip_atomic_load(p, __ATOMIC_RELAXED, __HIP_MEMORY_SCOPE_AGENT); }
__device__ __forceinline__ unsigned xb_add(unsigned* p, unsigned v) { return __hip_atomic_fetch_add(p, v, __ATOMIC_RELAXED, __HIP_MEMORY_SCOPE_AGENT); }
__device__ __forceinline__ unsigned xb_xcc_id() { return (unsigned)__builtin_amdgcn_s_getreg((3 << 11) | 20) & 0xFu; }
#define XB_SPIN(cond, bar) do { unsigned _sp = 0; while (cond) { __builtin_amdgcn_s_sleep(1); \
    if ((++_sp & 255u) == 0u) { if (xb_ld(&(bar)[XB_TMO])) break; if (_sp > XB_SPIN_CAP) { atomicAdd(&(bar)[XB_TMO], 1u); break; } } } } while (0)
struct XcdBarrier { unsigned* bar; unsigned x; volatile LAS unsigned* st; };
__device__ __forceinline__ XcdBarrier xcd_barrier_post(unsigned* bar, volatile LAS unsigned* st) {
    XcdBarrier b; b.bar = bar; b.x = xb_xcc_id(); b.st = st;
    if (threadIdx.x == 0) (void)xb_add(&bar[XB_XCNT(b.x)], 1u);
    return b;
}
__device__ __forceinline__ void xcd_barrier_complete(unsigned* bar, unsigned x, unsigned& nloc, unsigned& nx) {
    const unsigned G = gridDim.x * gridDim.y * gridDim.z;
    unsigned sum, cnt, mine, sp = 0u;
    for (;;) {
        sum = 0u; cnt = 0u; mine = 0u;
#pragma unroll
        for (unsigned j = 0; j < 16; ++j) { const unsigned c = xb_ld(&bar[XB_XCNT(j)]); sum += c; cnt += (c > 0u) ? 1u : 0u; mine = (j == x) ? c : mine; }
        if (sum == G) break;
        __builtin_amdgcn_s_sleep(1);
        if ((++sp & 255u) == 0u) { if (xb_ld(&bar[XB_TMO])) break; if (sp > XB_SPIN_CAP) { atomicAdd(&bar[XB_TMO], 1u); break; } }
    }
    nloc = mine > 0u ? mine : 1u; nx = cnt > 0u ? cnt : 1u;
}
__device__ __forceinline__ void xcd_barrier(const XcdBarrier& b) {
    asm volatile("s_waitcnt vmcnt(0)" ::: "memory");
    __syncthreads();
    if (threadIdx.x == 0) {
        unsigned* bar = b.bar; asm volatile("" : "+s"(bar));
        __builtin_amdgcn_s_waitcnt(0);
        unsigned nloc = b.st[0], nx = b.st[1];
        if (nloc == 0u) { xcd_barrier_complete(bar, b.x, nloc, nx); b.st[0] = nloc; b.st[1] = nx; }
        const unsigned old = xb_add(&bar[XB_XSUB(b.x)], 1u);
        const unsigned gen = old / nloc;
        if (old + 1u == (gen + 1u) * nloc) {
            __builtin_amdgcn_fence(__ATOMIC_RELEASE, "agent");
            asm volatile("s_waitcnt vmcnt(0)" ::: "memory");
            const unsigned og = xb_add(&bar[XB_TOP], 1u);
            const unsigned tg = og / nx;
            if (og + 1u == (tg + 1u) * nx) xb_add(&bar[XB_TOPGEN], 1u);
            else XB_SPIN(xb_ld(&bar[XB_TOPGEN]) == tg, bar);
            xb_add(&bar[XB_XGEN(b.x)], 1u);
            __builtin_amdgcn_fence(__ATOMIC_ACQUIRE, "agent");
            asm volatile("s_waitcnt vmcnt(0)" ::: "memory");
        } else {
            XB_SPIN(xb_ld(&bar[XB_XGEN(b.x)]) == gen, bar);
            __builtin_amdgcn_fence(__ATOMIC_ACQUIRE, "agent");
            asm volatile("s_waitcnt vmcnt(0)" ::: "memory");
        }
    }
    __syncthreads();
}
constexpr int LDS_BYTES = 147456;
constexpr int RTAB_OFF = 131072 + 1024;
constexpr int LDSCTL_OFF = 131072 + 320;
__global__ void __launch_bounds__(NTHREADS, 2) mega_fwd(Args a_) {
    extern __shared__ __attribute__((aligned(16))) unsigned char lds[];
    __attribute__((address_space(3))) unsigned char* lds3 = (__attribute__((address_space(3))) unsigned char*)lds;
    const int G = gridDim.x, bid = blockIdx.x;
    const int lo = a_.ph_lo, hi = a_.ph_hi;
    volatile LAS unsigned* MISC = (volatile LAS unsigned*)(lds3 + LDSCTL_OFF);
    if (threadIdx.x < 16) MISC[threadIdx.x] = 0u;
    __syncthreads();
    XcdBarrier bar; { KArgs a = kargs(); unsigned* bw = (unsigned*)(a->ws + OFF_CTL) + 4096; bar.bar = bw; bar.x = 0; bar.st = nullptr;
        if (hi - lo > 1) bar = xcd_barrier_post(bw, MISC + 8); }
    unsigned long long tp0 = 0, tp1 = 0;
#define SEAM(p) do { if (lo <= (p) && (p) + 1 < hi) for (int br_ = 0; br_ < BAR_REPS; ++br_) xcd_barrier(bar); if (TIME_PH >= 0) { if ((p) + 1 == TIME_PH) tp0 = __builtin_amdgcn_s_memrealtime(); if ((p) == TIME_PH) tp1 = __builtin_amdgcn_s_memrealtime(); } } while (0)
#define IN_PH(p) ((((PH_MASK) >> ((p) % PH_PER_LAYER + ((p) == PH_FINAL ? PH_PER_LAYER : 0))) & 1) && lo <= (p) && (p) < hi)
#define REPS(k) for (int rep_ = 0; rep_ < (REP_KIND == (k) ? 2 : 1); ++rep_)
#define WSP(T, off) ((T*)(a->ws + (off)))
    float* rtab = (float*)(lds + RTAB_OFF);
#define LAYER_PHASES(layer) { constexpr int pb = (layer) * PH_PER_LAYER; \
        if ((layer) == 0) { if (IN_PH(pb + PH_WCONV)) { KArgs a = kargs(); phase_wconv(a, lds, 0, 0, bid, G); phase_x_to_bf16(a->in[I_X], WSP(bf16_t, OFF_XN), WSP(float, OFF_PART)); } \
            SEAM(pb + PH_WCONV); }        \
        REPS(PH_GEMM_IN) if (IN_PH(pb + PH_GEMM_IN)) { KArgs a = kargs(); pg8::Gemm g{WSP(bf16_t, OFF_XN), WSP(bf16_t, OFF_WIN)}; pg8::StaticOrder S; S.init(M, NHB, G, bid); pg8::EpiBf16<0> E{WSP(bf16_t, OFF_HB), NHB, rtab, WSP(float, OFF_PART)}; \
            pg8::gemm_phase<pg8::EpiBf16<0>, pg8::StaticOrder, D>(lds3, g, S, E); \
            { constexpr int NU = (M / 256) * (NHB / 256); const int rem = NU % G; if (rem == 0) phase_wconv(kargs(), lds, layer, 1, bid, G); else if (bid >= rem) phase_wconv(kargs(), lds, layer, 1, bid - rem, G - rem); } } \
        SEAM(pb + PH_GEMM_IN); \
        REPS(PH_MIX1) if (IN_PH(pb + PH_MIX1)) phase_mix1(kargs(), lds, layer); \
        SEAM(pb + PH_MIX1); \
        if (IN_PH(pb + PH_MIX2)) gla_scan(kargs()); \
        SEAM(pb + PH_MIX2); \
        REPS(PH_MIX3) if (IN_PH(pb + PH_MIX3)) phase_mix3(kargs(), lds, layer); \
        SEAM(pb + PH_MIX3); \
        REPS(PH_GEMM_G) if (IN_PH(pb + PH_GEMM_G)) { KArgs a = kargs(); pg8::Gemm g{WSP(bf16_t, OFF_XN), WSP(bf16_t, OFF_WIN) + (size_t)NHB * D}; pg8::StaticOrder S; S.init(M, NGATE, G, bid); pg8::EpiGate E{WSP(bf16_t, OFF_G), rtab, WSP(float, OFF_PART)}; \
            pg8::gemm_phase<pg8::EpiGate, pg8::StaticOrder, D>(lds3, g, S, E); } \
        SEAM(pb + PH_GEMM_G); \
        REPS(PH_GEMM_M) if (IN_PH(pb + PH_GEMM_M)) { KArgs a = kargs(); pg8::Gemm g{WSP(bf16_t, OFF_Y), WSP(bf16_t, OFF_WBR)}; pg8::StaticOrder S; S.init(M, D, G, bid); pg8::EpiMerge E{(bf16_t*)a->out  , WSP(bf16_t, OFF_G)}; \
            pg8::gemm_phase<pg8::EpiMerge, pg8::StaticOrder, D>(lds3, g, S, E); } \
        SEAM(pb + PH_GEMM_M); \
        for (int rep_ = 0; rep_ < ((REP_KIND == PH_GEMM_O && layer == 0) ? 3 : 1); ++rep_) if (IN_PH(pb + PH_GEMM_O)) { KArgs a = kargs(); pg8::Gemm g{(const bf16_t*)a->out, WSP(bf16_t, OFF_WOUT)}; pg8::StaticOrder S; S.init(M, D, G, bid); \
            pg8::EpiResNorm E{WSP(bf16_t, OFF_XN), WSP(bf16_t, OFF_Y), WSP(float, OFF_PART)}; \
            pg8::gemm_phase<pg8::EpiResNorm, pg8::StaticOrder, D>(lds3, g, S, E); } \
        SEAM(pb + PH_GEMM_O); \
        REPS(PH_GEMM_U) if (IN_PH(pb + PH_GEMM_U)) { KArgs a = kargs(); pg8::Gemm g{WSP(bf16_t, OFF_Y), WSP(bf16_t, OFF_WUP)}; pg8::StaticOrder S; S.init(M, DFF, G, bid); pg8::EpiBf16<2> E{WSP(bf16_t, OFF_UP), DFF, rtab, WSP(float, OFF_PART)}; \
            pg8::gemm_phase<pg8::EpiBf16<2>, pg8::StaticOrder, D>(lds3, g, S, E); } \
        SEAM(pb + PH_GEMM_U); \
        if (IN_PH(pb + PH_GEMM_D)) { KArgs a = kargs(); if ((layer) + 1 < NLAYER) { phase_wconv(a, lds, (layer) + 1, 0, bid, G); __syncthreads();   } \
            pg8::Gemm g{WSP(bf16_t, OFF_UP), WSP(bf16_t, OFF_WDN)}; pg8::StaticOrder S; S.init(M, D, G, bid); \
            pg8::EpiResNorm E{WSP(bf16_t, OFF_Y), WSP(bf16_t, OFF_XN), WSP(float, OFF_PART)}; \
            pg8::gemm_phase<pg8::EpiResNorm, pg8::StaticOrder, DFF>(lds3, g, S, E); } \
        SEAM(pb + PH_GEMM_D); \
    }
    LAYER_PHASES(0)
    LAYER_PHASES(1)
#undef LAYER_PHASES
    if (IN_PH(PH_FINAL)) { KArgs a = kargs(); phase_final_norm(WSP(bf16_t, OFF_XN), a->in[I_FNG], a->out); }
    if (TIME_SEC >= 0 && blockIdx.x == 0) { KArgs a = kargs(); __syncthreads(); const unsigned long long acc_ = __hip_atomic_load((unsigned long long*)(a->ws + OFF_CTL + 32768), __ATOMIC_RELAXED, __HIP_MEMORY_SCOPE_AGENT);
        const unsigned long long te = __builtin_amdgcn_s_memrealtime(), span = acc_ * 32ull; while (__builtin_amdgcn_s_memrealtime() - te < span) __builtin_amdgcn_s_sleep(8); }
    if (TIME_PH >= 0 && blockIdx.x == 0) { if (TIME_PH == PH_FINAL) tp1 = __builtin_amdgcn_s_memrealtime(); if (TIME_PH == 0) tp0 = tp1 - 1;
        const unsigned long long te = __builtin_amdgcn_s_memrealtime(), span = (tp1 - tp0) * 8ull; while (__builtin_amdgcn_s_memrealtime() - te < span) __builtin_amdgcn_s_sleep(8); }
#undef IN_PH
#undef REPS
#undef WSP
#undef SEAM
}

extern "C" void kernel_launch(void* const* d_in, const int* in_sizes, int n_in, void* d_out, int out_size, void* d_ws, size_t ws_size, hipStream_t stream) {
    static int grid = 0;
    if (grid == 0) {
        if (n_in != N_INPUTS || out_size != M * D || ws_size < WS_END) { fprintf(stderr, "kernel_launch: unexpected shapes (n_in %d out %d ws %zu)\n", n_in, out_size, ws_size); grid = -1; return; }
        int dev = 0, cus = 0;
        if (hipGetDevice(&dev) != hipSuccess || hipDeviceGetAttribute(&cus, hipDeviceAttributeMultiprocessorCount, dev) != hipSuccess) { grid = -1; return; }
        if (hipFuncSetAttribute((const void*)mega_fwd, hipFuncAttributeMaxDynamicSharedMemorySize, LDS_BYTES) != hipSuccess) { fprintf(stderr, "kernel_launch: hipFuncSetAttribute failed\n"); grid = -1; return; }
        grid = cus;
    }
    if (grid < 0) return;
    Args a{};
    for (int i = 0; i < N_INPUTS; ++i) a.in[i] = (const float*)d_in[i];
    a.out = (float*)d_out; a.ws = (unsigned char*)d_ws;
#if N_LAUNCH_MODE == 0
    for (int ph = 0; ph < N_PHASES; ++ph) { a.ph_lo = ph; a.ph_hi = ph + 1; hipLaunchKernelGGL(mega_fwd, dim3(grid), dim3(NTHREADS), LDS_BYTES, stream, a); }
#else
    if (hipMemsetAsync((char*)d_ws + OFF_CTL, 0, 65536, stream) != hipSuccess) { fprintf(stderr, "kernel_launch: memset failed\n"); return; }
    a.ph_lo = 0; a.ph_hi = N_PHASES;
    hipLaunchKernelGGL(mega_fwd, dim3(grid), dim3(NTHREADS), LDS_BYTES, stream, a);
#endif
}
#endif
```

```cpp
#ifndef CPU_EMU
#include <hip/hip_runtime.h>
#include <cstdio>
#include <cstdint>
#endif
#ifndef SEQ_T
#define SEQ_T 8192
#endif
#ifndef PH_MASK
#define PH_MASK 0xffff
#endif
#ifndef TIME_PH
#define TIME_PH -1
#endif
#ifndef TIME_SEC
#define TIME_SEC -1
#endif
#ifndef BAR_REPS
#define BAR_REPS 1
#endif
#ifndef REP_ITEM
#define REP_ITEM -1
#endif
#ifndef REP_KIND
#define REP_KIND -1
#endif
#ifndef N_LAUNCH_MODE
#define N_LAUNCH_MODE 1
#endif

typedef unsigned short bf16_t;
typedef short bf16x8 __attribute__((ext_vector_type(8)));
typedef short s16x4 __attribute__((ext_vector_type(4)));
typedef float f32x4 __attribute__((ext_vector_type(4)));
typedef float f32x16 __attribute__((ext_vector_type(16)));
typedef unsigned u32x4 __attribute__((ext_vector_type(4)));
typedef unsigned u32x2 __attribute__((ext_vector_type(2)));
#ifdef CPU_EMU
#define DEVI static inline
#define DEVM inline
DEVI float ex2(float x) { return exp2f(x); }
DEVI float lg2(float x) { return log2f(x); }
DEVI float rcpf_(float x) { return 1.0f / x; }
DEVI float rsqf_(float x) { return 1.0f / sqrtf(x); }
DEVI f32x16 mfma32(bf16x8 a, bf16x8 b, f32x16 c) { return emu_mfma32(a, b, c); }
DEVI void wave_sync() { emu_wave->bar.wait(); }
DEVI void lds_barrier() { __syncthreads(); }
DEVI bool wave_any(bool p) { unsigned v = p ? 1u : 0u; for (int o = 1; o < 64; o <<= 1) v |= __shfl_xor(v, o); return v != 0u; }
DEVI int rfl(int x) { return x; }
#else
#define DEVI __device__ __forceinline__
#define DEVM __device__ __forceinline__
DEVI float ex2(float x) { return __builtin_amdgcn_exp2f(x); }
DEVI float lg2(float x) { return __builtin_amdgcn_logf(x); }
DEVI float rcpf_(float x) { return __builtin_amdgcn_rcpf(x); }
DEVI float rsqf_(float x) { return __builtin_amdgcn_rsqf(x); }
DEVI f32x16 mfma32(bf16x8 a, bf16x8 b, f32x16 c) { return __builtin_amdgcn_mfma_f32_32x32x16_bf16(a, b, c, 0, 0, 0); }
DEVI void wave_sync() { asm volatile("s_waitcnt lgkmcnt(0)" ::: "memory"); }
DEVI void lds_barrier() { asm volatile("s_waitcnt lgkmcnt(0)\n\ts_barrier" ::: "memory"); }
DEVI bool wave_any(bool p) { return __builtin_amdgcn_ballot_w64(p) != 0ull; }
DEVI int rfl(int x) { return __builtin_amdgcn_readfirstlane(x); }
#endif
#ifdef CPU_EMU
DEVI int launder_tid() { return (int)threadIdx.x; }
#else
DEVI int launder_tid() { int t = threadIdx.x; asm volatile("" : "+v"(t)); return t; }
#endif
#ifdef CPU_EMU
DEVI unsigned f2bf(float f) { unsigned u = __builtin_bit_cast(unsigned, f); return (u + 0x7fffu + ((u >> 16) & 1u)) >> 16; }
DEVI unsigned pk2(float lo, float hi) { return f2bf(lo) | (f2bf(hi) << 16); }
#else
typedef __bf16 bf16x2_hw __attribute__((ext_vector_type(2))); typedef float f32x2_hw __attribute__((ext_vector_type(2)));
DEVI unsigned pk2(float lo, float hi) { const f32x2_hw v = {lo, hi}; return __builtin_bit_cast(unsigned, __builtin_convertvector(v, bf16x2_hw)); }
DEVI unsigned f2bf(float f) { return pk2(f, 0.f) & 0xffffu; }
#endif
DEVI float bf2f(unsigned h) { return __builtin_bit_cast(float, h << 16); }
DEVI float bflo(unsigned w) { return __builtin_bit_cast(float, w << 16); }
DEVI float bfhi(unsigned w) { return __builtin_bit_cast(float, w & 0xffff0000u); }
struct pg8_unit_fwd { int pm, pn, br, ui; };
constexpr float LOG2E = 1.4426950408889634f, LN2 = 0.6931471805599453f;
DEVI float sigmoidf_(float x) { return rcpf_(1.0f + ex2(-x * LOG2E)); }
DEVI float siluf_(float x) { return x * sigmoidf_(x); }
DEVI float logsigf_(float z) { const float a = fabsf(z); return fminf(z, 0.f) - LN2 * lg2(1.0f + ex2(-a * LOG2E)); }
DEVI float wave_sum(float v) {
#pragma unroll
    for (int o = 1; o < 64; o <<= 1) v += __shfl_xor(v, o);
    return v;
}

constexpr int BATCH = 2, SEQ = SEQ_T, M = BATCH * SEQ, D = 1024, DFF = 4096, NLAYER = 2;
constexpr int DIN_SRC = 6176;
constexpr int NHB = 2304, NGATE = 4096, NIN = NHB + NGATE;
constexpr int C_GLUA = 0, C_GLUG = 256, C_GQ = 512, C_GK = 640, C_GV = 768, C_GR = 1024, C_Z = 1280, C_AQ = 1536, C_AK = 1792, C_AV = 1920, C_PIN = 2048;
constexpr int SRC_GLR = 1280;
constexpr int NCH = SEQ / 64;
constexpr int NAB = SEQ / 128;
constexpr float EPS = 1e-6f;
constexpr int NTHREADS = 512, NWAVES = 8;
enum { I_X = 0, I_NMG, I_WIN, I_CW, I_CB, I_CLG, I_CLB, I_WUP, I_BUP, I_GNG, I_SINK, I_PW, I_PS, I_WBR, I_WOUT, I_NFG, I_WFU, I_WFD, I_FNG, N_INPUTS };
constexpr size_t al256(size_t x) { return (x + 255) & ~(size_t)255; }
constexpr size_t OFF_CTL = 0, CTL_BYTES = 1u << 20;
constexpr size_t SZ_WIN = (size_t)NIN * D * 2, SZ_WBR = (size_t)4 * D * 256 * 2, SZ_WOUT = (size_t)D * D * 2, SZ_WUP = (size_t)DFF * D * 2, SZ_WDN = (size_t)D * DFF * 2;
constexpr size_t OFF_WIN = OFF_CTL + CTL_BYTES, OFF_WBR = OFF_WIN + SZ_WIN, OFF_WOUT = OFF_WBR + SZ_WBR, OFF_WUP = OFF_WOUT + SZ_WOUT, OFF_WDN = OFF_WUP + SZ_WUP;
constexpr size_t OFF_ROPE = OFF_WDN + SZ_WDN, SZ_ROPE = al256((size_t)SEQ * 8 * 8);
constexpr size_t OFF_PWT = OFF_ROPE + SZ_ROPE, SZ_PWT = 4 * 64 * 64 * 2;
constexpr size_t OFF_PART = OFF_PWT + SZ_PWT, SZ_PART = al256((size_t)M * 16 * 4);
constexpr size_t OFF_XN = OFF_PART + SZ_PART, SZ_ACT = al256((size_t)M * D * 2);
constexpr size_t OFF_Y = OFF_XN + SZ_ACT;
constexpr size_t OFF_BIG = OFF_Y + SZ_ACT;
constexpr size_t OFF_HB = OFF_BIG, SZ_HB = al256((size_t)M * NHB * 2);
constexpr size_t OFF_GU = OFF_HB + SZ_HB, SZ_GU = al256((size_t)BATCH * 4 * 2 * NCH * 2048 * 4);
constexpr size_t OFF_GD = OFF_GU + SZ_GU, SZ_GD = al256((size_t)BATCH * 4 * 2 * NCH * 32 * 4);
constexpr size_t OFF_G = OFF_BIG, SZ_G = al256((size_t)M * NGATE * 2);
constexpr size_t OFF_UP = OFF_BIG;
constexpr size_t WS_END = OFF_BIG + (SZ_G > SZ_HB + SZ_GU + SZ_GD ? SZ_G : SZ_HB + SZ_GU + SZ_GD);
static_assert(WS_END <= 268435456, "workspace map exceeds 256 MiB");

struct Args { const float* in[N_INPUTS]; float* out; unsigned char* ws; int ph_lo, ph_hi; };
#ifdef CPU_EMU
#define TSEC(a, id, sgn) do {} while (0)
typedef const Args* KArgs;
#else
typedef const Args __attribute__((address_space(4)))* KArgs;
#ifndef CPU_EMU
#define TSEC(a, id, sgn) do { if (TIME_SEC == (id) && blockIdx.x == 0 && threadIdx.x == 0) { const unsigned long long t_ = __builtin_amdgcn_s_memrealtime(); \
    __hip_atomic_fetch_add((unsigned long long*)((a)->ws + OFF_CTL + 32768), (sgn) > 0 ? t_ : (0ull - t_), __ATOMIC_RELAXED, __HIP_MEMORY_SCOPE_AGENT); } } while (0)
#endif
DEVI KArgs kargs() { KArgs p = (KArgs)__builtin_amdgcn_kernarg_segment_ptr(); asm volatile("" : "+s"(p)); return p; }
#endif

enum { PH_WCONV = 0, PH_GEMM_IN, PH_MIX1, PH_MIX2, PH_MIX3, PH_GEMM_G, PH_GEMM_M, PH_GEMM_O, PH_GEMM_U, PH_GEMM_D, PH_PER_LAYER };
constexpr int PH_FINAL = NLAYER * PH_PER_LAYER, N_PHASES = PH_FINAL + 1;

DEVI void transpose_item(const float* W, int ldw, int K, bf16_t* WT, int k0, int src_n0, int dst_n0, float* scr, int lane, const float* ksc = nullptr  , int src_col = -1, int ksrc0 = -1) {
    const int sc_ = src_col >= 0 ? src_col : src_n0 + (lane & 31), ks_ = ksrc0 >= 0 ? ksrc0 : k0;
    { float tv[32]; const float* wp = W + (size_t)(ks_ + (lane >> 5)) * ldw + sc_;
#pragma unroll
      for (int i = 0; i < 32; ++i) tv[i] = wp[(size_t)(2 * i) * ldw];
#pragma unroll
      for (int i = 0; i < 32; ++i) scr[(2 * i + (lane >> 5)) * 33 + (lane & 31)] = tv[i]; }
    const int c = lane & 7;
    f32x4 g0 = (f32x4){1.f, 1.f, 1.f, 1.f}, g1 = g0; if (ksc) { g0 = *(const f32x4*)(ksc + k0 + 8 * c); g1 = *(const f32x4*)(ksc + k0 + 8 * c + 4); }
    wave_sync();
#pragma unroll
    for (int j = 0; j < 4; ++j) { const int n = (lane >> 3) + 8 * j; const float* s = scr + (8 * c) * 33 + n;
        u32x4 o; o.x = pk2(s[0 * 33] * g0[0], s[1 * 33] * g0[1]); o.y = pk2(s[2 * 33] * g0[2], s[3 * 33] * g0[3]); o.z = pk2(s[4 * 33] * g1[0], s[5 * 33] * g1[1]); o.w = pk2(s[6 * 33] * g1[2], s[7 * 33] * g1[3]);
        *(u32x4*)(WT + (size_t)(dst_n0 + n) * K + k0 + 8 * c) = o; }
    wave_sync();
}
DEVI void zfold_item(const float* Win, const float* wup, bf16_t* WT, int k0, int zc0  , float* scr, int lane, const float* ksc) {
    const int s = zc0 >> 7, kc = (zc0 & 127) + (lane & 31);
    float wu[16];
#pragma unroll
    for (int r = 0; r < 16; ++r) wu[r] = wup[(s * 16 + r) * 128 + kc];
    for (int i = 0; i < 32; ++i) { const int kk = 2 * i + (lane >> 5); const float* g = Win + (size_t)(k0 + kk) * DIN_SRC + SRC_GLR + s * 16; float a = 0.f;
#pragma unroll
        for (int r = 0; r < 16; ++r) a += g[r] * wu[r];
        scr[kk * 33 + (lane & 31)] = a; }
    const int c = lane & 7;
    const f32x4 g0 = *(const f32x4*)(ksc + k0 + 8 * c), g1 = *(const f32x4*)(ksc + k0 + 8 * c + 4);
    wave_sync();
#pragma unroll
    for (int j = 0; j < 4; ++j) { const int n = (lane >> 3) + 8 * j; const float* sp = scr + (8 * c) * 33 + n;
        u32x4 o; o.x = pk2(sp[0 * 33] * g0[0], sp[1 * 33] * g0[1]); o.y = pk2(sp[2 * 33] * g0[2], sp[3 * 33] * g0[3]); o.z = pk2(sp[4 * 33] * g1[0], sp[5 * 33] * g1[1]); o.w = pk2(sp[6 * 33] * g1[2], sp[7 * 33] * g1[3]);
        *(u32x4*)(WT + (size_t)(C_Z + zc0 + n) * D + k0 + 8 * c) = o; }
    wave_sync();
}
DEVI void rope_entry(int pos, int i, float& c, float& s) {
    const double inv[8] = {1.0, 0.19392274474868576, 0.03760603093086393, 0.007292664737217109, 0.001414213562373095, 0.0002742481756762073, 5.318295896944988e-05, 1.031338537721246e-05};
    double iv = inv[0];
#pragma unroll
    for (int k = 1; k < 8; ++k) iv = (i == k) ? inv[k] : iv;
    double rev = (double)pos * iv * 0.15915494309189535; rev -= __builtin_rint(rev);
    double q4 = rev * 4.0; const double qn = __builtin_rint(q4); const double t = (q4 - qn) * 1.5707963267948966;
    const double t2 = t * t;
    double sp = t * (1.0 + t2 * (-1.0 / 6 + t2 * (1.0 / 120 + t2 * (-1.0 / 5040 + t2 * (1.0 / 362880 + t2 * (-1.0 / 39916800 + t2 * (1.0 / 6227020800.0)))))));
    double cp = 1.0 + t2 * (-0.5 + t2 * (1.0 / 24 + t2 * (-1.0 / 720 + t2 * (1.0 / 40320 + t2 * (-1.0 / 3628800 + t2 * (1.0 / 479001600.0))))));
    const int qi = ((int)qn) & 3;
    const double cs = (qi == 0) ? cp : (qi == 1) ? -sp : (qi == 2) ? -cp : sp;
    const double sn = (qi == 0) ? sp : (qi == 1) ? cp : (qi == 2) ? -sp : -cp;
    c = (float)cs; s = (float)sn;
}
DEVI int gate_src_col(int cp) { const int pn = cp >> 8, cl = cp & 255, bj = cl >> 7, wc = (cl >> 5) & 3, fq = (cl >> 3) & 3, np = (cl >> 2) & 1, q = cl & 3;
    return 2080 + (2 * bj + np) * D + 64 * pn + 16 * wc + 4 * fq + q; }
DEVI void phase_wconv(KArgs a, unsigned char* lds, int layer, int part, int wg, int nwg) {
    const int tid = launder_tid(), lane = tid & 63, wave = rfl(tid >> 6);
    float* scr = (float*)(lds + wave * 8448);
    const int gw = wg * NWAVES + wave, NGW = nwg * NWAVES;
    const float* Win = a->in[I_WIN] + (size_t)layer * D * DIN_SRC; const float* wup = a->in[I_WUP] + (size_t)layer * 2 * 16 * 128;
    const float* Wbr = a->in[I_WBR] + (size_t)layer * 4 * 256 * D; const float* Wout = a->in[I_WOUT] + (size_t)layer * D * D;
    const float* Wfu = a->in[I_WFU] + (size_t)layer * D * DFF; const float* Wfd = a->in[I_WFD] + (size_t)layer * DFF * D;
    const float* gmix = a->in[I_NMG] + layer * D; const float* gffn = a->in[I_NFG] + layer * D;
    bf16_t* WIN_T = (bf16_t*)(a->ws + OFF_WIN); bf16_t* WBR_T = (bf16_t*)(a->ws + OFF_WBR); bf16_t* WOUT_T = (bf16_t*)(a->ws + OFF_WOUT);
    bf16_t* WUP_T = (bf16_t*)(a->ws + OFF_WUP); bf16_t* WDN_T = (bf16_t*)(a->ws + OFF_WDN);
    constexpr int I_IN = (D / 64) * (NIN / 32), I_BR = 4 * (256 / 64) * (D / 32), I_OUT = (D / 64) * (D / 32), I_UP = (D / 64) * (DFF / 32), I_DN = (DFF / 64) * (D / 32);
    constexpr int NITEMS = I_IN + I_BR + I_OUT + I_UP + I_DN;
    for (int it = gw + (part ? I_IN : 0); it < (part ? NITEMS : I_IN); it += NGW) {
        int r = it;
        if (r < I_IN) { const int nblk = NIN / 32, kb = r / nblk, nb = r % nblk, n0 = nb * 32;
            if (n0 >= C_Z && n0 < C_AQ) zfold_item(Win, wup, WIN_T, kb * 64, n0 - C_Z, scr, lane, gmix);
            else if (n0 < NHB) transpose_item(Win, DIN_SRC, D, WIN_T, kb * 64, n0 < C_Z ? n0 : n0 - 224, n0, scr, lane, gmix);
            else transpose_item(Win, DIN_SRC, D, WIN_T, kb * 64, 0, n0, scr, lane, gmix, gate_src_col(n0 - NHB + (lane & 31)));
            continue; } r -= I_IN;
        if (r < I_BR) { const int br = r / (I_BR / 4), q = r % (I_BR / 4), nblk = D / 32, kb = q / nblk, nb = q % nblk;
            transpose_item(Wbr + (size_t)br * 256 * D, D, D  , WBR_T, br * 256 + kb * 64, nb * 32, nb * 32, scr, lane, nullptr, -1, kb * 64); continue; } r -= I_BR;
        if (r < I_OUT) { const int nblk = D / 32, kb = r / nblk, nb = r % nblk; transpose_item(Wout, D, D, WOUT_T, kb * 64, nb * 32, nb * 32, scr, lane); continue; } r -= I_OUT;
        if (r < I_UP) { const int nblk = DFF / 32, kb = r / nblk, nb = r % nblk; transpose_item(Wfu, DFF, D, WUP_T, kb * 64, nb * 32, nb * 32, scr, lane, gffn); continue; } r -= I_UP;
        { const int nblk = D / 32, kb = r / nblk, nb = r % nblk; transpose_item(Wfd, D, DFF, WDN_T, kb * 64, nb * 32, nb * 32, scr, lane); }
    }
    if (part) return;
    { bf16_t* PWT = (bf16_t*)(a->ws + OFF_PWT); const float* pw = a->in[I_PW] + (size_t)layer * 4 * 64 * 64;
      for (int e = blockIdx.x * NTHREADS + tid; e < 4 * 64 * 64; e += gridDim.x * NTHREADS) { const int g = e >> 12, ee = (e >> 6) & 63, c = e & 63; PWT[e] = (bf16_t)f2bf(pw[(g * 64 + c) * 64 + ee]); } }
    if (layer == 0) { float* rope = (float*)(a->ws + OFF_ROPE);
        for (int e = blockIdx.x * NTHREADS + tid; e < SEQ * 8; e += gridDim.x * NTHREADS) { float c, s; rope_entry(e >> 3, e & 7, c, s); rope[2 * e] = c; rope[2 * e + 1] = s; } }
}

DEVI void phase_x_to_bf16(const float* x, bf16_t* xb, float* part) {
    const int tid = launder_tid(), lane = tid & 63, wave = rfl(tid >> 6);
    const int gw = blockIdx.x * NWAVES + wave, NGW = gridDim.x * NWAVES;
    for (int m = gw; m < M; m += NGW) {
        const f32x4* xr = (const f32x4*)(x + (size_t)m * D) + lane; f32x4 v[4]; float s = 0.f;
#pragma unroll
        for (int j = 0; j < 4; ++j) { v[j] = xr[64 * j]; s += (v[j].x * v[j].x + v[j].y * v[j].y) + (v[j].z * v[j].z + v[j].w * v[j].w); }
        s = wave_sum(s);
        u32x2* o8 = (u32x2*)(xb + (size_t)m * D) + lane;
#pragma unroll
        for (int j = 0; j < 4; ++j) { u32x2 w; w.x = pk2(v[j].x, v[j].y); w.y = pk2(v[j].z, v[j].w); o8[64 * j] = w; }
        if (lane < 16) part[(size_t)m * 16 + lane] = lane == 0 ? s : 0.f;
    }
}
DEVI void phase_final_norm(const bf16_t* xb, const float* g, float* out) {
    const int tid = launder_tid(), lane = tid & 63, wave = rfl(tid >> 6);
    const int gw = blockIdx.x * NWAVES + wave, NGW = gridDim.x * NWAVES;
    f32x4 gv[4];
#pragma unroll
    for (int j = 0; j < 4; ++j) gv[j] = *(const f32x4*)(g + 8 * lane + 512 * (j >> 1) + 4 * (j & 1));
    for (int m = gw; m < M; m += NGW) {
        const u32x4* xr = (const u32x4*)(xb + (size_t)m * D) + lane; f32x4 v[4]; float s = 0.f;
#pragma unroll
        for (int h = 0; h < 2; ++h) { const u32x4 w = xr[64 * h]; v[2 * h] = (f32x4){bflo(w.x), bfhi(w.x), bflo(w.y), bfhi(w.y)}; v[2 * h + 1] = (f32x4){bflo(w.z), bfhi(w.z), bflo(w.w), bfhi(w.w)}; }
#pragma unroll
        for (int j = 0; j < 4; ++j) s += (v[j].x * v[j].x + v[j].y * v[j].y) + (v[j].z * v[j].z + v[j].w * v[j].w);
        const float rstd = rsqf_(wave_sum(s) * (1.f / D) + EPS);
        f32x4* o = (f32x4*)(out + (size_t)m * D) + 2 * lane;
#pragma unroll
        for (int j = 0; j < 4; ++j) o[128 * (j >> 1) + (j & 1)] = v[j] * rstd * gv[j];
    }
}
struct ConvLd { u32x4 av[6], gv[6]; };
DEVI void conv_load(KArgs a, int item, ConvLd& L) {
    const int tid = launder_tid(); const int b = item / (SEQ / 64), t0 = (item % (SEQ / 64)) * 64;
    const bf16_t* HB = (const bf16_t*)(a->ws + OFF_HB);
#pragma unroll
    for (int e_ = 0; e_ < 6; ++e_) { const int e = tid + NTHREADS * e_, ec = e < 94 * 32 ? e : 94 * 32 - 1; const int r = ec >> 5, c8 = ec & 31, t = t0 - 15 + r; const int tc = t < 0 ? 0 : (t >= SEQ ? SEQ - 1 : t);
        const bf16_t* hp = HB + (size_t)(b * SEQ + tc) * NHB + c8 * 8; L.av[e_] = *(const u32x4*)(hp + C_GLUA); L.gv[e_] = *(const u32x4*)(hp + C_GLUG); }
}
template <class Hook> DEVI void conv_compute(KArgs a, unsigned char* lds, int layer, int item, const ConvLd& L, Hook&& hook) {
    const int tid = launder_tid(), lane = tid & 63, wave = rfl(tid >> 6), c = tid & 255, hf = tid >> 8;
    const int b = item / (SEQ / 64), t0 = (item % (SEQ / 64)) * 64;
    bf16_t* Y = (bf16_t*)(a->ws + OFF_Y);
    float* u = (float*)lds;
#pragma unroll
    for (int e_ = 0; e_ < 6; ++e_) { const int e = tid + NTHREADS * e_, ec = e < 94 * 32 ? e : 94 * 32 - 1; const int r = ec >> 5, c8 = ec & 31, t = t0 - 15 + r; const bool inr = t >= 0 && t < SEQ;
        const u32x4 av = L.av[e_], gv = L.gv[e_];
        f32x4 o0 = (f32x4){bflo(av.x) * sigmoidf_(bflo(gv.x)), bfhi(av.x) * sigmoidf_(bfhi(gv.x)), bflo(av.y) * sigmoidf_(bflo(gv.y)), bfhi(av.y) * sigmoidf_(bfhi(gv.y))};
        f32x4 o1 = (f32x4){bflo(av.z) * sigmoidf_(bflo(gv.z)), bfhi(av.z) * sigmoidf_(bfhi(gv.z)), bflo(av.w) * sigmoidf_(bflo(gv.w)), bfhi(av.w) * sigmoidf_(bfhi(gv.w))};
        if (!inr) { o0 = (f32x4){0.f, 0.f, 0.f, 0.f}; o1 = o0; }
        if (e < 94 * 32) { *(f32x4*)(u + r * 256 + c8 * 8) = o0; *(f32x4*)(u + r * 256 + c8 * 8 + 4) = o1; } }
    hook();
    float w[31];
    const float* cw = a->in[I_CW] + (size_t)layer * 31 * 256;
#pragma unroll
    for (int k = 0; k < 31; ++k) w[k] = cw[k * 256 + c];
    const float bias = a->in[I_CB][layer * 256 + c];
    lds_barrier();
    { float acc[32];
#pragma unroll
      for (int i = 0; i < 32; ++i) acc[i] = bias;
      const float* up = u + hf * 32 * 256 + c;
#pragma unroll
      for (int r = 0; r < 62; ++r) { const float v = up[r * 256];
#pragma unroll
          for (int i = 0; i < 32; ++i) if (r - i >= 0 && r - i <= 30) acc[i] += v * w[r - i]; }
      lds_barrier();
#pragma unroll
      for (int i = 0; i < 32; ++i) u[(hf * 32 + i) * 256 + c] = acc[i]; }
    lds_barrier();
    const f32x4 lg = *(const f32x4*)(a->in[I_CLG] + layer * 256 + 4 * lane), lb = *(const f32x4*)(a->in[I_CLB] + layer * 256 + 4 * lane);
#pragma unroll
    for (int bt = 0; bt < 2; ++bt) { f32x4 v[4]; float s[4];
#pragma unroll
      for (int i = 0; i < 4; ++i) { v[i] = *(const f32x4*)(u + (wave * 8 + bt * 4 + i) * 256 + 4 * lane); s[i] = (v[i].x + v[i].y) + (v[i].z + v[i].w); }
#pragma unroll
      for (int o = 1; o < 64; o <<= 1) {
#pragma unroll
          for (int i = 0; i < 4; ++i) s[i] += __shfl_xor(s[i], o); }
#pragma unroll
      for (int i = 0; i < 4; ++i) { v[i] = v[i] - s[i] * (1.f / 256); s[i] = (v[i].x * v[i].x + v[i].y * v[i].y) + (v[i].z * v[i].z + v[i].w * v[i].w); }
#pragma unroll
      for (int o = 1; o < 64; o <<= 1) {
#pragma unroll
          for (int i = 0; i < 4; ++i) s[i] += __shfl_xor(s[i], o); }
#pragma unroll
      for (int i = 0; i < 4; ++i) { const float rstd = rsqf_(s[i] * (1.f / 256) + EPS); const f32x4 ww = v[i] * rstd * lg + lb;
          u32x2 o; o.x = pk2(siluf_(ww.x), siluf_(ww.y)); o.y = pk2(siluf_(ww.z), siluf_(ww.w));
          *(u32x2*)(Y + (size_t)(b * SEQ + t0 + wave * 8 + bt * 4 + i) * D + 0 + 4 * lane) = o; } }
    lds_barrier();
}
constexpr int PD_LD = 264;
struct PoolLd { u32x4 v[5]; };
DEVI void pool_load(KArgs a, int item, PoolLd& L) {
    const int tid = launder_tid(); const int b = item / (SEQ / 64), t0 = (item % (SEQ / 64)) * 64;
    const bf16_t* HB = (const bf16_t*)(a->ws + OFF_HB);
#pragma unroll
    for (int e_ = 0; e_ < 5; ++e_) { const int e = tid + NTHREADS * e_, r = e >> 5, c8 = e & 31, t = t0 - 8 + r; const int tc = t < 0 ? 0 : (t >= SEQ ? SEQ - 1 : t);
        L.v[e_] = *(const u32x4*)(HB + (size_t)(b * SEQ + tc) * NHB + C_PIN + c8 * 8); }
}
template <class Hook> DEVI void pool_compute(KArgs a, unsigned char* lds, int layer, int item, const PoolLd& L, Hook&& hook) {
    const int tid = launder_tid(), lane = tid & 63, wave = rfl(tid >> 6), c = tid & 255, hf = tid >> 8;
    const int b = item / (SEQ / 64), t0 = (item % (SEQ / 64)) * 64;
    bf16_t* Y = (bf16_t*)(a->ws + OFF_Y);
    float* u = (float*)lds; bf16_t* ds = (bf16_t*)(u + 80 * 256);
#pragma unroll
    for (int e_ = 0; e_ < 5; ++e_) { const int e = tid + NTHREADS * e_, r = e >> 5, c8 = e & 31, t = t0 - 8 + r; const bool inr = t >= 0 && t < SEQ; const u32x4 v = L.v[e_];
        f32x4 o0 = (f32x4){bflo(v.x), bfhi(v.x), bflo(v.y), bfhi(v.y)}, o1 = (f32x4){bflo(v.z), bfhi(v.z), bflo(v.w), bfhi(v.w)};
        if (!inr) { o0 = (f32x4){0.f, 0.f, 0.f, 0.f}; o1 = o0; }
        *(f32x4*)(u + r * 256 + c8 * 8) = o0; *(f32x4*)(u + r * 256 + c8 * 8 + 4) = o1; }
    hook();
    lds_barrier();
    { const int gg = c >> 6;
      float uu[48];
      const float* up = u + (hf * 32) * 256 + c;
#pragma unroll
      for (int r = 0; r < 48; ++r) uu[r] = up[r * 256];
      float sm[32];
#pragma unroll
      for (int i = 0; i < 32; ++i) sm[i] = uu[8 + i - 1] + uu[8 + i];
      if (gg >= 1) {
#pragma unroll
          for (int i = 0; i < 32; ++i) sm[i] += uu[8 + i - 2] + uu[8 + i + 1]; }
      if (gg >= 2) {
#pragma unroll
          for (int i = 0; i < 32; ++i) sm[i] += (uu[8 + i - 4] + uu[8 + i - 3]) + (uu[8 + i + 2] + uu[8 + i + 3]); }
      if (gg >= 3) {
#pragma unroll
          for (int i = 0; i < 32; ++i) sm[i] += ((uu[8 + i - 8] + uu[8 + i - 7]) + (uu[8 + i - 6] + uu[8 + i - 5])) + ((uu[8 + i + 4] + uu[8 + i + 5]) + (uu[8 + i + 6] + uu[8 + i + 7])); }
      const int hw = 1 << gg;
#pragma unroll
      for (int i = 0; i < 32; ++i) { const int tt = hf * 32 + i, t = t0 + tt; const int lo = (t - hw) < 0 ? 0 : (t - hw), hi = (t + hw) > SEQ ? SEQ : (t + hw);
          ds[tt * PD_LD + c] = (bf16_t)f2bf(sm[i] / (float)(hi - lo) - uu[8 + i]); } }
    lds_barrier();
    { const int g = wave >> 1, et = wave & 1, r32 = lane & 31, hi = lane >> 5; const bf16_t* PWT = (const bf16_t*)(a->ws + OFF_PWT);
      f32x16 acc0 = {}, acc1 = {};
#pragma unroll
      for (int ks = 0; ks < 4; ++ks) { const bf16x8 af = *(const bf16x8*)(PWT + (size_t)(g * 64 + et * 32 + r32) * 64 + ks * 16 + hi * 8);
          acc0 = mfma32(af, *(const bf16x8*)(ds + r32 * PD_LD + g * 64 + ks * 16 + hi * 8), acc0); acc1 = mfma32(af, *(const bf16x8*)(ds + (32 + r32) * PD_LD + g * 64 + ks * 16 + hi * 8), acc1); }
      const float* psp = a->in[I_PS] + layer * 256 + g * 64 + et * 32 + 4 * hi; bf16_t* yp = Y + (size_t)(b * SEQ + t0 + r32) * D + 768 + g * 64 + et * 32 + 4 * hi;
#pragma unroll
      for (int g4 = 0; g4 < 4; ++g4) { const f32x4 ps = *(const f32x4*)(psp + 8 * g4); u32x2 w0, w1;
          w0.x = pk2(acc0[4 * g4] * ps[0], acc0[4 * g4 + 1] * ps[1]); w0.y = pk2(acc0[4 * g4 + 2] * ps[2], acc0[4 * g4 + 3] * ps[3]); *(u32x2*)(yp + 8 * g4) = w0;
          w1.x = pk2(acc1[4 * g4] * ps[0], acc1[4 * g4 + 1] * ps[1]); w1.y = pk2(acc1[4 * g4 + 2] * ps[2], acc1[4 * g4 + 3] * ps[3]); *(u32x2*)(yp + (size_t)32 * D + 8 * g4) = w1; } }
    lds_barrier();
}
DEVI int crow(int r, int hi) { return (r & 3) + 8 * (r >> 2) + 4 * hi; }
constexpr int KS_LD = 72, VT_LD = 388;
template <class Hook> DEVI void attn_item(KArgs a, unsigned char* lds, int layer, int item, Hook&& hook) {
    const int tid = launder_tid(), lane = tid & 63, wave = rfl(tid >> 6);
    const int b = item / (2 * NAB), kv = (item / NAB) & 1, n = item % NAB;
    const bf16_t* HB = (const bf16_t*)(a->ws + OFF_HB); bf16_t* Y = (bf16_t*)(a->ws + OFF_Y); const float* rope = (const float*)(a->ws + OFF_ROPE);
    bf16_t* Ks = (bf16_t*)lds; bf16_t* Vt = Ks + 384 * KS_LD;
    const int kbase = n * 128 - 128;
    { u32x4 kw[6], vw[6];
#pragma unroll
      for (int e_ = 0; e_ < 6; ++e_) { const int e = tid + NTHREADS * e_, wr = e >> 3, c8 = e & 7, kpos = kbase + wr; const int kc = kpos < 0 ? 0 : (kpos >= SEQ ? SEQ - 1 : kpos);
          const bf16_t* hp = HB + (size_t)(b * SEQ + kc) * NHB; kw[e_] = *(const u32x4*)(hp + C_AK + kv * 64 + c8 * 8); vw[e_] = *(const u32x4*)(hp + C_AV + kv * 64 + c8 * 8); }
      const int rw = tid < 384 ? tid : 383, rpos = kbase + rw, rc = rpos < 0 ? 0 : (rpos >= SEQ ? SEQ - 1 : rpos);
      const bf16_t* rhp = HB + (size_t)(b * SEQ + rc) * NHB + C_AK + kv * 64; const u32x4 x1 = *(const u32x4*)rhp, x2 = *(const u32x4*)(rhp + 8);
      const float* rp = rope + (size_t)rc * 16; const f32x4 r0 = *(const f32x4*)(rp), r1 = *(const f32x4*)(rp + 4), r2 = *(const f32x4*)(rp + 8), r3 = *(const f32x4*)(rp + 12);
#pragma unroll
      for (int e_ = 0; e_ < 6; ++e_) { const int e = tid + NTHREADS * e_, wr = e >> 3, c8 = e & 7, kpos = kbase + wr; const bool inr = kpos >= 0 && kpos < SEQ;
          if (!inr) { kw[e_] = (u32x4){0u, 0u, 0u, 0u}; vw[e_] = kw[e_]; }
          if (c8 >= 2) *(u32x4*)(Ks + wr * KS_LD + c8 * 8) = kw[e_];
#pragma unroll
          for (int j = 0; j < 4; ++j) { Vt[(c8 * 8 + 2 * j) * VT_LD + wr] = (bf16_t)(vw[e_][j] & 0xffffu); Vt[(c8 * 8 + 2 * j + 1) * VT_LD + wr] = (bf16_t)(vw[e_][j] >> 16); } }
      if (tid < 384) { const bool inr = rpos >= 0 && rpos < SEQ; const float rr[16] = {r0[0], r0[1], r0[2], r0[3], r1[0], r1[1], r1[2], r1[3], r2[0], r2[1], r2[2], r2[3], r3[0], r3[1], r3[2], r3[3]};
          float o1[8], o2[8];
#pragma unroll
          for (int j = 0; j < 4; ++j) { const float a0 = bflo(x1[j]), a1 = bfhi(x1[j]), b0 = bflo(x2[j]), b1 = bfhi(x2[j]);
              o1[2 * j] = a0 * rr[4 * j] - b0 * rr[4 * j + 1]; o1[2 * j + 1] = a1 * rr[4 * j + 2] - b1 * rr[4 * j + 3];
              o2[2 * j] = b0 * rr[4 * j] + a0 * rr[4 * j + 1]; o2[2 * j + 1] = b1 * rr[4 * j + 2] + a1 * rr[4 * j + 3]; }
          u32x4 w1 = (u32x4){pk2(o1[0], o1[1]), pk2(o1[2], o1[3]), pk2(o1[4], o1[5]), pk2(o1[6], o1[7])}, w2 = (u32x4){pk2(o2[0], o2[1]), pk2(o2[2], o2[3]), pk2(o2[4], o2[5]), pk2(o2[6], o2[7])};
          if (!inr) { w1 = (u32x4){0u, 0u, 0u, 0u}; w2 = w1; }
          *(u32x4*)(Ks + rw * KS_LD) = w1; *(u32x4*)(Ks + rw * KS_LD + 8) = w2; } }
    const int g = wave >> 2, hq = kv * 2 + g, q0l = (wave & 3) * 32, ql = lane & 31, hi = lane >> 5, qpos = n * 128 + q0l + ql;
    bf16x8 qf[4];
    { const bf16_t* qp = HB + (size_t)(b * SEQ + qpos) * NHB + C_AQ + hq * 64 + hi * 8; const float* rp = rope + (size_t)qpos * 16; const float sg = hi ? 1.f : -1.f;
#pragma unroll
      for (int ds = 0; ds < 4; ++ds) { const u32x4 w = *(const u32x4*)(qp + ds * 16); float v[8];
#pragma unroll
          for (int j = 0; j < 4; ++j) { v[2 * j] = bflo(w[j]); v[2 * j + 1] = bfhi(w[j]); }
          if (ds == 0) {
#pragma unroll
              for (int j = 0; j < 8; ++j) { const float p = __shfl_xor(v[j], 32); v[j] = v[j] * rp[2 * j] + sg * p * rp[2 * j + 1]; } }
          constexpr float QS = 0.125f * LOG2E;
          u32x4 o = (u32x4){pk2(v[0] * QS, v[1] * QS), pk2(v[2] * QS, v[3] * QS), pk2(v[4] * QS, v[5] * QS), pk2(v[6] * QS, v[7] * QS)};
          qf[ds] = __builtin_bit_cast(bf16x8, o); } }
    lds_barrier();
    hook();
    float m2 = a->in[I_SINK][layer * 4 + hq] * LOG2E, l_own = hi ? 0.f : 1.f;
    f32x16 o0 = {}, o1 = {};
    for (int kt = 0; kt < 9; ++kt) {
        const int wb = q0l + 32 * kt, kpos0 = kbase + wb;
        if (kpos0 < 0 || kpos0 >= SEQ) continue;
        f32x16 s = {};
#pragma unroll
        for (int ds = 0; ds < 4; ++ds) { const bf16x8 kf = *(const bf16x8*)(Ks + (wb + ql) * KS_LD + ds * 16 + hi * 8); s = mfma32(kf, qf[ds], s); }
        if (kt == 0) {
#pragma unroll
            for (int r = 0; r < 16; ++r) if (crow(r, hi) < ql) s[r] = -INFINITY; }
        if (kt == 8) {
#pragma unroll
            for (int r = 0; r < 16; ++r) if (crow(r, hi) > ql) s[r] = -INFINITY; }
        float mt = fmaxf(s[0], s[1]);
#pragma unroll
        for (int r = 2; r < 16; ++r) mt = fmaxf(mt, s[r]);
        mt = fmaxf(mt, __shfl_xor(mt, 32));
        const float mn = fmaxf(m2, mt), alpha = ex2(m2 - mn); const bool grew = mn > m2; m2 = mn;
        float ps = 0.f;
#pragma unroll
        for (int r = 0; r < 16; ++r) { s[r] = ex2(s[r] - mn); ps += s[r]; }
        l_own = l_own * alpha + ps;
        if (wave_any(grew)) {
#pragma unroll
            for (int r = 0; r < 16; ++r) { o0[r] *= alpha; o1[r] *= alpha; } }
        bf16x8 pb[2];
#pragma unroll
        for (int sI = 0; sI < 2; ++sI) { u32x4 w = (u32x4){pk2(s[8 * sI + 0], s[8 * sI + 1]), pk2(s[8 * sI + 2], s[8 * sI + 3]), pk2(s[8 * sI + 4], s[8 * sI + 5]), pk2(s[8 * sI + 6], s[8 * sI + 7])}; pb[sI] = __builtin_bit_cast(bf16x8, w); }
#pragma unroll
        for (int sI = 0; sI < 2; ++sI) {
            const bf16_t* v0 = Vt + (size_t)ql * VT_LD + wb + 16 * sI + 4 * hi;
            const s16x4 a0 = *(const s16x4*)(v0), a1 = *(const s16x4*)(v0 + 8), c0 = *(const s16x4*)(v0 + 32 * VT_LD), c1 = *(const s16x4*)(v0 + 32 * VT_LD + 8);
            o0 = mfma32((bf16x8){a0[0], a0[1], a0[2], a0[3], a1[0], a1[1], a1[2], a1[3]}, pb[sI], o0);
            o1 = mfma32((bf16x8){c0[0], c0[1], c0[2], c0[3], c1[0], c1[1], c1[2], c1[3]}, pb[sI], o1); }
    }
    const float linv = 1.0f / (l_own + __shfl_xor(l_own, 32));
    bf16_t* yp = Y + (size_t)(b * SEQ + qpos) * D + 512 + hq * 64 + 4 * hi;
#pragma unroll
    for (int g4 = 0; g4 < 4; ++g4) {
        u32x2 w0, w1; w0.x = pk2(o0[4 * g4] * linv, o0[4 * g4 + 1] * linv); w0.y = pk2(o0[4 * g4 + 2] * linv, o0[4 * g4 + 3] * linv);
        w1.x = pk2(o1[4 * g4] * linv, o1[4 * g4 + 1] * linv); w1.y = pk2(o1[4 * g4 + 2] * linv, o1[4 * g4 + 3] * linv);
        *(u32x2*)(yp + 8 * g4) = w0; *(u32x2*)(yp + 32 + 8 * g4) = w1; }
    lds_barrier();
}
DEVI void gla_ld16(const bf16_t* p, unsigned (&r)[16]) {
#pragma unroll
    for (int jj = 0; jj < 16; ++jj) r[jj] = p[(size_t)jj * NHB];
}
DEVI void gla_prep(const unsigned (&zraw)[16], float bu, int t, float* tot4  , float (&bcum)[16], float& total) {
    const int d = t & 31, dir = (t >> 5) & 1, seg = t >> 6;
    float lg[16];
#pragma unroll
    for (int jj = 0; jj < 16; ++jj) lg[jj] = logsigf_(bf2f(zraw[jj]) + bu) * (1.f / 16.f);
    float acc = 0.f;
    if (dir == 0) {
#pragma unroll
        for (int jj = 0; jj < 16; ++jj) { acc += lg[jj]; bcum[jj] = acc; } }
    else {
#pragma unroll
        for (int jj = 15; jj >= 0; --jj) { acc += lg[jj]; bcum[jj] = acc; } }
    tot4[seg * 64 + dir * 32 + d] = acc;
    lds_barrier();
    const float t0 = tot4[dir * 32 + d], t1 = tot4[64 + dir * 32 + d], t2 = tot4[128 + dir * 32 + d], t3 = tot4[192 + dir * 32 + d];
    total = (t0 + t1) + (t2 + t3);
    float off;
    if (dir == 0) off = (seg > 0 ? t0 : 0.f) + (seg > 1 ? t1 : 0.f) + (seg > 2 ? t2 : 0.f);
    else off = (seg < 3 ? t3 : 0.f) + (seg < 2 ? t2 : 0.f) + (seg < 1 ? t1 : 0.f);
#pragma unroll
    for (int jj = 0; jj < 16; ++jj) bcum[jj] += off;
}
constexpr int GVT_LD = 72, GQ_LD = 40;
DEVI void gla_load_v(const bf16_t* hrow0, int h, int t, u32x4 (&vw)[2]) {
#pragma unroll
    for (int e8_ = 0; e8_ < 2; ++e8_) { const int e8 = t + 256 * e8_, j = e8 >> 3, c8 = e8 & 7; vw[e8_] = *(const u32x4*)(hrow0 + (size_t)j * NHB + C_GV + h * 64 + c8 * 8); }
}
DEVI void gla_stage_vt(const u32x4 (&vw)[2], int t, bf16_t* Vt) {
#pragma unroll
    for (int e8_ = 0; e8_ < 2; ++e8_) { const int e8 = t + 256 * e8_, j = e8 >> 3, c8 = e8 & 7;
#pragma unroll
        for (int q = 0; q < 4; ++q) { Vt[(c8 * 8 + 2 * q) * GVT_LD + j] = (bf16_t)(vw[e8_][q] & 0xffffu); Vt[(c8 * 8 + 2 * q + 1) * GVT_LD + j] = (bf16_t)(vw[e8_][q] >> 16); } }
}
constexpr int GX_HALF = 9216 + 9216 + 1024;
struct GxLd { unsigned z[16], k[16]; u32x4 vw[2]; float bu; };
DEVI void gla_x_load(KArgs a, int layer, int pair, GxLd& L) {
    const int tid = launder_tid(), wave = rfl(tid >> 6), hf = wave >> 2, t = tid & 255;
    constexpr int N_GX = BATCH * NCH * 4;
    const int item = pair * 2 + hf; const int it_ = item < N_GX ? item : 0;
    const int h = it_ & 3, c = (it_ >> 2) % NCH, b = it_ / (4 * NCH);
    const bf16_t* hrow0 = (const bf16_t*)(a->ws + OFF_HB) + (size_t)(b * SEQ + c * 64) * NHB;
    const int d = t & 31, dir = (t >> 5) & 1, seg = t >> 6; const bf16_t* rp = hrow0 + (size_t)(seg * 16) * NHB + h * 32 + d;
    gla_ld16(rp + C_Z + dir * 128, L.z); gla_ld16(rp + C_GK, L.k); gla_load_v(hrow0, h, t, L.vw);
    L.bu = a->in[I_BUP][(size_t)layer * 256 + dir * 128 + h * 32 + d];
}
DEVI void gla_x_compute(KArgs a, unsigned char* lds, int layer, int pair, const GxLd& L) {
    const int tid = launder_tid(), lane = tid & 63, wave = rfl(tid >> 6), hf = wave >> 2, t = tid & 255, w4 = wave & 3;
    constexpr int N_GX = BATCH * NCH * 4;
    const int item = pair * 2 + hf; const bool act = item < N_GX; const int it_ = act ? item : 0;
    const int h = it_ & 3, c = (it_ >> 2) % NCH, b = it_ / (4 * NCH);
    unsigned char* base = lds + hf * GX_HALF;
    bf16_t* Kht = (bf16_t*)base; bf16_t* Vt = (bf16_t*)(base + 9216); float* tot4 = (float*)(base + 18432);
    float bc[16], total;
    gla_stage_vt(L.vw, t, Vt);
    gla_prep(L.z, L.bu, t, tot4, bc, total);
    { const int d = t & 31, dir = (t >> 5) & 1, seg = t >> 6;
      unsigned w[8];
#pragma unroll
      for (int q = 0; q < 8; ++q) { const float k0 = bf2f(L.k[2 * q]), k1 = bf2f(L.k[2 * q + 1]);
          w[q] = pk2(k0 * ex2((total - bc[2 * q]) * LOG2E), k1 * ex2((total - bc[2 * q + 1]) * LOG2E)); }
      u32x4* dst = (u32x4*)(Kht + (dir * 32 + d) * GVT_LD + seg * 16); dst[0] = (u32x4){w[0], w[1], w[2], w[3]}; dst[1] = (u32x4){w[4], w[5], w[6], w[7]};
      if (seg == 0 && act) ((float*)(a->ws + OFF_GD))[((size_t)((b * 4 + h) * 2 + dir) * NCH + c) * 32 + d] = ex2(total * LOG2E); }
    lds_barrier();
    { const int et = w4 & 1, dir = w4 >> 1, r32 = lane & 31, hi = lane >> 5; f32x16 u = {};
#pragma unroll
      for (int ks = 0; ks < 4; ++ks) { const bf16x8 af = *(const bf16x8*)(Vt + (et * 32 + r32) * GVT_LD + ks * 16 + hi * 8), bfr = *(const bf16x8*)(Kht + (dir * 32 + r32) * GVT_LD + ks * 16 + hi * 8); u = mfma32(af, bfr, u); }
      if (act) { float* gu = (float*)(a->ws + OFF_GU) + ((size_t)((b * 4 + h) * 2 + dir) * NCH + c) * 2048;
#pragma unroll
          for (int r = 0; r < 16; ++r) gu[(et * 32 + crow(r, hi)) * 32 + r32] = u[r]; } }
    lds_barrier();
}
DEVI void gla_scan(KArgs a, unsigned char* lds) {
    float* GU = (float*)(a->ws + OFF_GU); const float* GD = (const float*)(a->ws + OFF_GD);
    constexpr int TOTAL = BATCH * 4 * 2 * 2048, NQ = NCH / 4, UNR = (NQ % 16 == 0) ? 16 : (NQ % 4 == 0 ? 4 : 1);
    static_assert(NCH % 4 == 0, "chunks per sequence divisible by 4");
    const int tid = launder_tid(), sg = tid >> 7, ce = tid & 127;
    float* AB = (float*)lds;
    for (int e0 = blockIdx.x * 128; e0 < TOTAL; e0 += gridDim.x * 128) {
        const int eid = e0 + ce, seq = eid >> 11, de = eid & 2047, d = de & 31, dir = seq & 1;
        float S = 0.f, P = 1.f;
        for (int s0 = sg * NQ; s0 < (sg + 1) * NQ; s0 += UNR) { float u[UNR], dc[UNR];
#pragma unroll
            for (int k = 0; k < UNR; ++k) { const int c = dir ? NCH - 1 - (s0 + k) : s0 + k; u[k] = GU[((size_t)seq * NCH + c) * 2048 + de]; dc[k] = GD[((size_t)seq * NCH + c) * 32 + d]; }
#pragma unroll
            for (int k = 0; k < UNR; ++k) { const int c = dir ? NCH - 1 - (s0 + k) : s0 + k; GU[((size_t)seq * NCH + c) * 2048 + de] = S; S = dc[k] * S + u[k]; P *= dc[k]; } }
        AB[sg * 128 + ce] = P; AB[512 + sg * 128 + ce] = S;
        lds_barrier();
        float C = 0.f;
        for (int q = 0; q < sg; ++q) C = AB[q * 128 + ce] * C + AB[512 + q * 128 + ce];
        lds_barrier();
        if (sg > 0) { float Pc = 1.f;
            for (int s0 = sg * NQ; s0 < (sg + 1) * NQ; s0 += UNR) { float l[UNR], dc[UNR];
#pragma unroll
                for (int k = 0; k < UNR; ++k) { const int c = dir ? NCH - 1 - (s0 + k) : s0 + k; l[k] = GU[((size_t)seq * NCH + c) * 2048 + de]; dc[k] = GD[((size_t)seq * NCH + c) * 32 + d]; }
#pragma unroll
                for (int k = 0; k < UNR; ++k) { const int c = dir ? NCH - 1 - (s0 + k) : s0 + k; GU[((size_t)seq * NCH + c) * 2048 + de] = l[k] + Pc * C; Pc *= dc[k]; } } }
    }
}
constexpr int GZ_HALF = 10240 + 10240 + 9216 + 10240 + 1024 + 512;
struct GzLd { unsigned z[16], q[16], k[16]; u32x4 vw[2]; f32x4 s[4]; float bu; };
DEVI void gla_z_load(KArgs a, int layer, int pair, GzLd& L) {
    const int tid = launder_tid(), wave = rfl(tid >> 6), hf = wave >> 2, t = tid & 255;
    constexpr int N_GZ = BATCH * NCH * 4;
    const int item = pair * 2 + hf; const int it_ = item < N_GZ ? item : 0;
    const int h = it_ & 3, c = (it_ >> 2) % NCH, b = it_ / (4 * NCH);
    const bf16_t* hrow0 = (const bf16_t*)(a->ws + OFF_HB) + (size_t)(b * SEQ + c * 64) * NHB;
    const int d = t & 31, dir = (t >> 5) & 1, seg = t >> 6; const bf16_t* rp = hrow0 + (size_t)(seg * 16) * NHB + h * 32 + d;
    gla_ld16(rp + C_Z + dir * 128, L.z); gla_ld16(rp + C_GQ, L.q); gla_ld16(rp + C_GK, L.k); gla_load_v(hrow0, h, t, L.vw);
    L.bu = a->in[I_BUP][(size_t)layer * 256 + dir * 128 + h * 32 + d];
    const float* GU = (const float*)(a->ws + OFF_GU);
#pragma unroll
    for (int e4_ = 0; e4_ < 4; ++e4_) { const int e4 = t + 256 * e4_, dr = e4 >> 9, ed = (e4 & 511) * 4; L.s[e4_] = *(const f32x4*)(GU + ((size_t)((b * 4 + h) * 2 + dr) * NCH + c) * 2048 + ed); }
}
DEVI void gla_z_compute(KArgs a, unsigned char* lds, int layer, int pair, const GzLd& L) {
    const int tid = launder_tid(), lane = tid & 63, wave = rfl(tid >> 6), hf = wave >> 2, t = tid & 255, w4 = wave & 3;
    constexpr int N_GZ = BATCH * NCH * 4;
    const int item = pair * 2 + hf; const bool act = item < N_GZ; const int it_ = act ? item : 0;
    const int h = it_ & 3, c = (it_ >> 2) % NCH, b = it_ / (4 * NCH);
    const bf16_t* hrow0 = (const bf16_t*)(a->ws + OFF_HB) + (size_t)(b * SEQ + c * 64) * NHB;
    unsigned char* base = lds + hf * GZ_HALF;
    bf16_t* Qs = (bf16_t*)base; bf16_t* Ks = (bf16_t*)(base + 10240); bf16_t* Vt = (bf16_t*)(base + 20480); bf16_t* St = (bf16_t*)(base + 29696);
    float* tot4 = (float*)(base + 39936); float* rsum = (float*)(base + 40960);
    float bc[16], total;
    gla_stage_vt(L.vw, t, Vt);
#pragma unroll
    for (int e4_ = 0; e4_ < 4; ++e4_) { const int e4 = t + 256 * e4_, dir = e4 >> 9, ed = (e4 & 511) * 4, e = ed >> 5, d0 = ed & 31;
        u32x2 w; w.x = pk2(L.s[e4_][0], L.s[e4_][1]); w.y = pk2(L.s[e4_][2], L.s[e4_][3]); *(u32x2*)(St + (dir * 64 + e) * GQ_LD + d0) = w; }
    gla_prep(L.z, L.bu, t, tot4, bc, total);
    { const int d = t & 31, dir = (t >> 5) & 1, seg = t >> 6;
#pragma unroll
      for (int jj = 0; jj < 16; ++jj) { const float q = bf2f(L.q[jj]) * 0.17677669529663687f, k = bf2f(L.k[jj]); const float bb = bc[jj] * LOG2E;
          Qs[(dir * 64 + seg * 16 + jj) * GQ_LD + d] = (bf16_t)f2bf(q * ex2(bb)); Ks[(dir * 64 + seg * 16 + jj) * GQ_LD + d] = (bf16_t)f2bf(k * ex2(-bb)); } }
    lds_barrier();
    const int itl = w4 & 1, et = w4 >> 1, r32 = lane & 31, hi = lane >> 5;
    bf16x8 qf[2][2];
#pragma unroll
    for (int dir = 0; dir < 2; ++dir)
#pragma unroll
        for (int ks = 0; ks < 2; ++ks) qf[dir][ks] = *(const bf16x8*)(Qs + (dir * 64 + itl * 32 + r32) * GQ_LD + ks * 16 + hi * 8);
    f32x16 o = {};
#pragma unroll
    for (int jt = 0; jt < 2; ++jt) {
        f32x16 xa = {};
        if (jt == itl) { f32x16 xf = {}, xb = {};
#pragma unroll
            for (int ks = 0; ks < 2; ++ks) { xf = mfma32(*(const bf16x8*)(Ks + (jt * 32 + r32) * GQ_LD + ks * 16 + hi * 8), qf[0][ks], xf);
                                             xb = mfma32(*(const bf16x8*)(Ks + (64 + jt * 32 + r32) * GQ_LD + ks * 16 + hi * 8), qf[1][ks], xb); }
#pragma unroll
            for (int r = 0; r < 16; ++r) { const int jl = crow(r, hi); xa[r] = (jl <= r32 ? xf[r] : 0.f) + (jl >= r32 ? xb[r] : 0.f); } }
        else { const int dir = jt < itl ? 0 : 1;
#pragma unroll
            for (int ks = 0; ks < 2; ++ks) xa = mfma32(*(const bf16x8*)(Ks + (dir * 64 + jt * 32 + r32) * GQ_LD + ks * 16 + hi * 8), qf[dir][ks], xa); }
#pragma unroll
        for (int s = 0; s < 2; ++s) { const u32x4 w = (u32x4){pk2(xa[8 * s + 0], xa[8 * s + 1]), pk2(xa[8 * s + 2], xa[8 * s + 3]), pk2(xa[8 * s + 4], xa[8 * s + 5]), pk2(xa[8 * s + 6], xa[8 * s + 7])};
            const bf16_t* vp = Vt + (et * 32 + r32) * GVT_LD + jt * 32 + 16 * s + 4 * hi; const s16x4 a0 = *(const s16x4*)vp, a1 = *(const s16x4*)(vp + 8);
            o = mfma32((bf16x8){a0[0], a0[1], a0[2], a0[3], a1[0], a1[1], a1[2], a1[3]}, __builtin_bit_cast(bf16x8, w), o); } }
#pragma unroll
    for (int dir = 0; dir < 2; ++dir)
#pragma unroll
        for (int ks = 0; ks < 2; ++ks) o = mfma32(*(const bf16x8*)(St + (dir * 64 + et * 32 + r32) * GQ_LD + ks * 16 + hi * 8), qf[dir][ks], o);
    float ss = 0.f;
#pragma unroll
    for (int r = 0; r < 16; ++r) ss += o[r] * o[r];
    ss += __shfl_xor(ss, 32);
    if (hi == 0) rsum[et * 64 + itl * 32 + r32] = ss;
    lds_barrier();
    if (act) { const int il = itl * 32 + r32; const float rstd = rsqf_((rsum[il] + rsum[64 + il]) * (1.f / 64.f) + EPS);
        const bf16_t* grp = hrow0 + (size_t)il * NHB + C_GR + h * 64 + et * 32 + 4 * hi; const float* ngp = a->in[I_GNG] + layer * 256 + h * 64 + et * 32 + 4 * hi;
        bf16_t* yp = (bf16_t*)(a->ws + OFF_Y) + (size_t)(b * SEQ + c * 64 + il) * D + 256 + h * 64 + et * 32 + 4 * hi;
#pragma unroll
        for (int g4 = 0; g4 < 4; ++g4) { const u32x2 gw = *(const u32x2*)(grp + 8 * g4); const f32x4 ng = *(const f32x4*)(ngp + 8 * g4);
            u32x2 w; w.x = pk2(o[4 * g4] * rstd * ng[0] * siluf_(bflo(gw.x)), o[4 * g4 + 1] * rstd * ng[1] * siluf_(bfhi(gw.x)));
            w.y = pk2(o[4 * g4 + 2] * rstd * ng[2] * siluf_(bflo(gw.y)), o[4 * g4 + 3] * rstd * ng[3] * siluf_(bfhi(gw.y)));
            *(u32x2*)(yp + 8 * g4) = w; } }
    lds_barrier();
}
DEVI void phase_mix1(KArgs a, unsigned char* lds, int layer) {
    constexpr int N_RND = BATCH * 2 * NAB, N_GXP = BATCH * NCH * 4 / 2;
    static_assert(BATCH * (SEQ / 64) == N_RND && N_GXP == 2 * N_RND, "one conv tile, one pool tile and two GLA pairs per attention block");
    for (int r = blockIdx.x; r < N_RND; r += gridDim.x) {
        ConvLd lc; PoolLd lp; GxLd lx0, lx1;
        attn_item(a, lds, layer, r, [&] { conv_load(a, r, lc); });
        conv_compute(a, lds, layer, r, lc, [&] { pool_load(a, r, lp); });
        pool_compute(a, lds, layer, r, lp, [&] { gla_x_load(a, layer, r, lx0); });
        gla_x_load(a, layer, r + N_RND, lx1);
        gla_x_compute(a, lds, layer, r, lx0); gla_x_compute(a, lds, layer, r + N_RND, lx1); }
}
DEVI void phase_mix3(KArgs a, unsigned char* lds, int layer) {
    constexpr int N_GZP = BATCH * NCH * 4 / 2;
    for (int it = blockIdx.x; it < N_GZP; it += 2 * gridDim.x) { const int it2 = it + gridDim.x; GzLd L0, L1;
        gla_z_load(a, layer, it, L0); if (it2 < N_GZP) gla_z_load(a, layer, it2, L1);
        gla_z_compute(a, lds, layer, it, L0); if (it2 < N_GZP) gla_z_compute(a, lds, layer, it2, L1); }
}

namespace pg8 {
constexpr int BM = 256, BK = 64, HALF = 128, HTB = HALF * BK * 2, STAGE_BYTES = 8 * HTB, NXCD = 8, WGM = 8;
DEVI int lds_byte(int r, int c) { const int st = (r >> 4) * 2 + (c >> 5), rr = r & 15, cc = c & 31, ob = rr * 64 + cc * 2; return st * 1024 + (ob ^ (((ob >> 9) & 1) << 5)); }
DEVI void stage_rc(int b, int& R, int& C) { const int st = b / 1024, sb = b % 1024, swz = sb ^ (((sb >> 9) & 1) << 5); R = (st >> 1) * 16 + swz / 64; C = (st & 1) * 32 + (swz % 64) / 2; }
DEVI int perm32(int rho) { const int n = rho >> 4, i = rho & 15; return 8 * (i >> 2) + 4 * n + (i & 3); }
typedef pg8_unit_fwd Unit;
struct Gemm { const bf16_t* A; const bf16_t* Bt; };
struct StaticOrder {
    int nM, nN, nwg, G, c;
    DEVM void init(int Mr, int N, int G_, int c_) { nM = Mr / BM; nN = N / BM; nwg = nM * nN; G = G_; c = c_; }
    DEVM bool tile(long L, Unit& u) const {
        if (L >= nwg) return false;
        int wgid = (int)L; { const int q = nwg / NXCD, r = nwg % NXCD, xcd = wgid % NXCD, off = wgid / NXCD; wgid = (xcd < r ? xcd * (q + 1) : r * (q + 1) + (xcd - r) * q) + off; }
        const int nig = WGM * nN, gid = wgid / nig, fm = gid * WGM, gsz = (nM - fm) < WGM ? (nM - fm) : WGM;
        u.pm = fm + ((wgid % nig) % gsz); u.pn = (wgid % nig) / gsz; u.br = 0; return true;
    }
    typedef Unit unit_t;
    DEVM bool next(int i, Unit& u) const { u.ui = i; return tile((long)i * G + c, u); }
};
template <class Sched> DEVM void fill_rstd(const Sched& S, const float* part, float* tab) {
    const int tid = threadIdx.x; Unit u;
    if (tid < 256) for (int ui = 0; S.next(ui, u); ++ui) { const f32x4* p = (const f32x4*)(part + (size_t)(u.pm * 256 + tid) * 16); const f32x4 s = (p[0] + p[1]) + (p[2] + p[3]);
        tab[ui * 256 + tid] = rsqf_(((s.x + s.y) + (s.z + s.w)) * (1.f / D) + EPS); }
}
template <int ACT  > struct EpiBf16 {
    static constexpr bool PERM = true, HAS_MID = false, HAS_INIT = false;
    bf16_t* O; int ldc; float* tab; const float* part;
    template <class Sched> DEVM void pre(const Sched& S) const { fill_rstd(S, part, tab); }
    DEVM void operator()(const f32x4 (&acc)[2][2][4][2], const Unit& u, int wr, int wc, int fr, int fq) const {
        const int row0 = u.pm * BM + wr * 64 + fr, col0 = u.pn * BM + wc * 32 + 8 * fq;
#pragma unroll
        for (int ai = 0; ai < 2; ++ai)
#pragma unroll
            for (int m = 0; m < 4; ++m) { bf16_t* rowp = O + (size_t)(row0 + ai * HALF + m * 16) * ldc + col0; const float rs = tab[u.ui * 256 + ai * HALF + wr * 64 + m * 16 + fr];
#pragma unroll
                for (int bj = 0; bj < 2; ++bj) { f32x4 v0 = acc[ai][bj][m][0] * rs, v1 = acc[ai][bj][m][1] * rs;
                    if (ACT == 1) {
#pragma unroll
                        for (int q = 0; q < 4; ++q) { v0[q] = sigmoidf_(v0[q]); v1[q] = sigmoidf_(v1[q]); } }
                    if (ACT == 2) {
#pragma unroll
                        for (int q = 0; q < 4; ++q) { const float r0 = fmaxf(v0[q], 0.f), r1 = fmaxf(v1[q], 0.f); v0[q] = r0 * r0; v1[q] = r1 * r1; } }
                    u32x4 w; w.x = pk2(v0[0], v0[1]); w.y = pk2(v0[2], v0[3]); w.z = pk2(v1[0], v1[1]); w.w = pk2(v1[2], v1[3]);
                    *(u32x4*)(rowp + bj * HALF) = w; } }
    }
};
struct EpiGate {
    static constexpr bool PERM = true, HAS_MID = false, HAS_INIT = false;
    bf16_t* R; float* tab; const float* part;
    template <class Sched> DEVM void pre(const Sched& S) const { fill_rstd(S, part, tab); }
    DEVM void operator()(const f32x4 (&acc)[2][2][4][2], const Unit& u, int wr, int wc, int fr, int fq) const {
        const int row0 = u.pm * BM + wr * 64 + fr, d0 = u.pn * 64 + wc * 16 + 4 * fq;
#pragma unroll
        for (int ai = 0; ai < 2; ++ai)
#pragma unroll
            for (int m = 0; m < 4; ++m) { bf16_t* rowp = R + (size_t)(row0 + ai * HALF + m * 16) * NGATE + d0; const float rs = tab[u.ui * 256 + ai * HALF + wr * 64 + m * 16 + fr] * LOG2E;
                float r[4][4];
#pragma unroll
                for (int q = 0; q < 4; ++q) { float den[4];
#pragma unroll
                    for (int b = 0; b < 4; ++b) den[b] = 1.0f + ex2(-acc[ai][b >> 1][m][b & 1][q] * rs);
                    const float i0 = rcpf_(den[0]), i1 = rcpf_(den[1]), i2 = rcpf_(den[2]), i3 = rcpf_(den[3]);
                    r[0][q] = den[1] * i0; r[1][q] = den[2] * i1; r[2][q] = den[3] * i2; r[3][q] = i3; }
#pragma unroll
                for (int b = 0; b < 4; ++b) { u32x2 w; w.x = pk2(r[b][0], r[b][1]); w.y = pk2(r[b][2], r[b][3]); *(u32x2*)(rowp + b * D) = w; } }
    }
};
struct EpiMerge {
    static constexpr bool PERM = true, HAS_MID = true, HAS_INIT = false;
    bf16_t* O; const bf16_t* R;
    template <class Sched> DEVM void pre(const Sched&) const {}
    DEVM void scale(f32x4 (&acc)[2][2][4][2], const Unit& u, int b, int wr, int wc, int fr, int fq) const {
        const int row0 = u.pm * BM + wr * 64 + fr, col0 = u.pn * BM + wc * 32 + 8 * fq;
#pragma unroll
        for (int ai = 0; ai < 2; ++ai)
#pragma unroll
            for (int m = 0; m < 4; ++m) { const unsigned go = ((unsigned)(row0 + ai * HALF + m * 16) * NGATE + b * D + col0) * 2u;
#pragma unroll
                for (int bj = 0; bj < 2; ++bj) { const u32x4 gw = *(const u32x4*)((const char*)R + go + bj * HALF * 2);
                    acc[ai][bj][m][0] *= (f32x4){bflo(gw.x), bfhi(gw.x), bflo(gw.y), bfhi(gw.y)}; acc[ai][bj][m][1] *= (f32x4){bflo(gw.z), bfhi(gw.z), bflo(gw.w), bfhi(gw.w)}; }
#ifndef CPU_EMU
                if (m == 3) asm volatile("" ::: "memory");
#endif
            }
    }
    DEVM void mid(f32x4 (&acc)[2][2][4][2], const Unit& u, int b, int wr, int wc, int fr, int fq) const { scale(acc, u, b, wr, wc, fr, fq); }
    DEVM void operator()(f32x4 (&acc)[2][2][4][2], const Unit& u, int wr, int wc, int fr, int fq) const {
        scale(acc, u, 3, wr, wc, fr, fq);
        const int row0 = u.pm * BM + wr * 64 + fr, col0 = u.pn * BM + wc * 32 + 8 * fq;
#pragma unroll
        for (int ai = 0; ai < 2; ++ai)
#pragma unroll
            for (int m = 0; m < 4; ++m) { bf16_t* rowp = O + (size_t)(row0 + ai * HALF + m * 16) * D + col0;
#pragma unroll
                for (int bj = 0; bj < 2; ++bj) { const f32x4 v0 = acc[ai][bj][m][0], v1 = acc[ai][bj][m][1];
                    u32x4 w; w.x = pk2(v0[0], v0[1]); w.y = pk2(v0[2], v0[3]); w.z = pk2(v1[0], v1[1]); w.w = pk2(v1[2], v1[3]); *(u32x4*)(rowp + bj * HALF) = w; } }
    }
};
struct EpiResNorm {
    static constexpr bool PERM = true, HAS_MID = false, HAS_INIT = true;
    const bf16_t* base; bf16_t* xb; float* part;
    template <class Sched> DEVM void pre(const Sched&) const {}
    DEVM void init(f32x4 (&acc)[2][2][4][2], const Unit& u, int wr, int wc, int fr, int fq) const {
        const int row0 = u.pm * BM + wr * 64 + fr, col0 = u.pn * BM + wc * 32 + 8 * fq;
#pragma unroll
        for (int ai = 0; ai < 2; ++ai)
#pragma unroll
            for (int m = 0; m < 4; ++m) { const unsigned off = ((unsigned)(row0 + ai * HALF + m * 16) * D + col0) * 2u;
#pragma unroll
                for (int bj = 0; bj < 2; ++bj) { const u32x4 bw = *(const u32x4*)((const char*)base + off + bj * HALF * 2);
                    acc[ai][bj][m][0] = (f32x4){bflo(bw.x), bfhi(bw.x), bflo(bw.y), bfhi(bw.y)}; acc[ai][bj][m][1] = (f32x4){bflo(bw.z), bfhi(bw.z), bflo(bw.w), bfhi(bw.w)}; } }
    }
    DEVM void operator()(const f32x4 (&acc)[2][2][4][2], const Unit& u, int wr, int wc, int fr, int fq) const {
        const int row0 = u.pm * BM + wr * 64 + fr, col0 = u.pn * BM + wc * 32 + 8 * fq;
#pragma unroll
        for (int ai = 0; ai < 2; ++ai)
#pragma unroll
            for (int m = 0; m < 4; ++m) { const unsigned row = (unsigned)(row0 + ai * HALF + m * 16), off = (row * D + col0) * 2u; float ss = 0.f;
#pragma unroll
                for (int bj = 0; bj < 2; ++bj) { const f32x4 v0 = acc[ai][bj][m][0], v1 = acc[ai][bj][m][1];
                    u32x4 w; w.x = pk2(v0[0], v0[1]); w.y = pk2(v0[2], v0[3]); w.z = pk2(v1[0], v1[1]); w.w = pk2(v1[2], v1[3]);
                    *(u32x4*)((char*)xb + off + bj * HALF * 2) = w;
                    const float x0 = bflo(w.x), x1 = bfhi(w.x), x2 = bflo(w.y), x3 = bfhi(w.y), x4 = bflo(w.z), x5 = bfhi(w.z), x6 = bflo(w.w), x7 = bfhi(w.w);
                    ss += ((x0 * x0 + x1 * x1) + (x2 * x2 + x3 * x3)) + ((x4 * x4 + x5 * x5) + (x6 * x6 + x7 * x7)); }
                ss += __shfl_xor(ss, 16); ss += __shfl_xor(ss, 32);
                if (fq == 0) part[(size_t)row * 16 + u.pn * 4 + wc] = ss; }
    }
};
#ifndef CPU_EMU
#define PG8_LAS __attribute__((address_space(3)))
template <class Epi, class Sched, int KDIM, bool ALIGN_EPI = true>
__device__ __forceinline__ void gemm_phase(PG8_LAS unsigned char* lds, const Gemm g, const Sched& S, const Epi& E) {
    int tid_ = threadIdx.x; asm volatile("" : "+v"(tid_));
    const int tid = tid_, wid = __builtin_amdgcn_readfirstlane(tid >> 6), lane = tid & 63, wr = wid >> 2, wc = wid & 3, fr = lane & 15, fq = lane >> 4;
    constexpr int nt = KDIM / BK;
    unsigned voffA[2], voffB[2];
#pragma unroll
    for (int i = 0; i < 2; ++i) { int R, C; stage_rc(tid * 16 + i * 8192, R, C); const int Rb = Epi::PERM ? ((R & ~31) + perm32(R & 31)) : R;
        voffA[i] = (unsigned)(R * KDIM + C) * 2u; voffB[i] = (unsigned)(Rb * KDIM + C) * 2u; }
    constexpr size_t kstep = (size_t)(BK * 2);
    constexpr size_t hstepA = (size_t)HALF * KDIM * 2, hstepB = hstepA;
    constexpr size_t tstepA = 2 * hstepA, tstepB = 2 * hstepB;
    const unsigned ldsw = (unsigned)wid * 1024u;
    const int aoff = lds_byte(wr * 64 + fr, fq * 8), boff = lds_byte(wc * 32 + fr, fq * 8);
#define PG8_SA(b, h) (((b) * 2 + (h)) * HTB)
#define PG8_SB(b, h) ((4 + (b) * 2 + (h)) * HTB)
#define PG8_STAGE(bufoff, gbase, voff) do { _Pragma("unroll") for (int _i = 0; _i < 2; ++_i) \
        __builtin_amdgcn_global_load_lds((const unsigned*)((const char*)(gbase) + (voff)[_i]), (PG8_LAS unsigned*)(lds + (bufoff) + ldsw + _i * 8192), 16, 0, 0); } while (0)
#define PG8_LDA(dst, b, h) do { _Pragma("unroll") for (int m = 0; m < 4; ++m) _Pragma("unroll") for (int k = 0; k < 2; ++k) dst[m][k] = *(const PG8_LAS bf16x8*)(lds + PG8_SA(b, h) + aoff + m * 2048 + k * 1024); } while (0)
#define PG8_LDB(dst, b, h) do { _Pragma("unroll") for (int n = 0; n < 2; ++n) _Pragma("unroll") for (int k = 0; k < 2; ++k) dst[n][k] = *(const PG8_LAS bf16x8*)(lds + PG8_SB(b, h) + boff + n * 2048 + k * 1024); } while (0)
#define PG8_MMA(ai, bj, At, Bt) do { __builtin_amdgcn_s_setprio(1); _Pragma("unroll") for (int m = 0; m < 4; ++m) _Pragma("unroll") for (int n = 0; n < 2; ++n) _Pragma("unroll") for (int k = 0; k < 2; ++k) \
        acc[ai][bj][m][n] = __builtin_amdgcn_mfma_f32_16x16x32_bf16(Bt[n][k], At[m][k], acc[ai][bj][m][n], 0, 0, 0); __builtin_amdgcn_s_setprio(0); } while (0)
#define PG8_WAIT_V(n) asm volatile("s_waitcnt vmcnt(" #n ")" ::: "memory")
#define PG8_WAIT_L(n) asm volatile("s_waitcnt lgkmcnt(" #n ")" ::: "memory")
#define PG8_BAR __builtin_amdgcn_s_barrier()
#define PG8_SCHED __builtin_amdgcn_sched_barrier(0)
#define PG8_ABASE(u) ((const char*)g.A + (size_t)(u).pm * tstepA)
#define PG8_BBASE(u) ((const char*)g.Bt + (size_t)(u).pn * tstepB)
    Unit cur, nxt; int ui = 0;
    if (!S.next(0, cur)) return;
    f32x4 acc[2][2][4][2];
#pragma unroll
    for (int a = 0; a < 2; ++a)
#pragma unroll
        for (int b = 0; b < 2; ++b)
#pragma unroll
            for (int m = 0; m < 4; ++m)
#pragma unroll
                for (int n = 0; n < 2; ++n) acc[a][b][m][n] = (f32x4){0.f, 0.f, 0.f, 0.f};
    if constexpr (Epi::HAS_INIT) E.init(acc, cur, wr, wc, fr, fq);
    bf16x8 At[4][2], B0[2][2], B1[2][2];
    const char* cA = PG8_ABASE(cur); const char* cB = PG8_BBASE(cur);
    PG8_STAGE(PG8_SB(0, 0), cB, voffB); PG8_STAGE(PG8_SB(0, 1), cB + hstepB, voffB); PG8_STAGE(PG8_SA(0, 0), cA, voffA); PG8_STAGE(PG8_SA(0, 1), cA + hstepA, voffA);
    E.pre(S);
    if (wr == 1) PG8_BAR;
    PG8_WAIT_V(2); PG8_BAR;
    PG8_STAGE(PG8_SB(1, 0), cB + kstep, voffB); PG8_STAGE(PG8_SA(1, 0), cA + kstep, voffA); PG8_STAGE(PG8_SB(1, 1), cB + hstepB + kstep, voffB);
    PG8_WAIT_V(6); PG8_BAR;
    for (;;) {
        const bool has_next = S.next(ui + 1, nxt);
        const char* nA = has_next ? PG8_ABASE(nxt) : cA; const char* nB = has_next ? PG8_BBASE(nxt) : cB;
#pragma nounroll
        for (int t = 0; t < nt; t += 2) {
            const bool last = (t == nt - 2);
            const char* a1 = cA + (size_t)(t + 1) * kstep;
            const char* a2 = last ? nA : cA + (size_t)(t + 2) * kstep; const char* b2 = last ? nB : cB + (size_t)(t + 2) * kstep;
            const char* a3 = a2 + kstep; const char* b3 = b2 + kstep;
            PG8_LDB(B0, 0, 0); PG8_LDB(B1, 0, 1); PG8_SCHED; PG8_LDA(At, 0, 0); PG8_STAGE(PG8_SA(1, 1), a1 + hstepA, voffA);
            PG8_WAIT_V(8); PG8_WAIT_L(0); PG8_BAR; PG8_MMA(0, 0, At, B0); PG8_MMA(0, 1, At, B1); PG8_BAR; PG8_SCHED;
            PG8_LDA(At, 0, 1); PG8_STAGE(PG8_SB(0, 0), b2, voffB); PG8_STAGE(PG8_SB(0, 1), b2 + hstepB, voffB); PG8_STAGE(PG8_SA(0, 0), a2, voffA);
            PG8_WAIT_V(8); PG8_WAIT_L(0); PG8_BAR; PG8_MMA(1, 0, At, B0); PG8_MMA(1, 1, At, B1); PG8_BAR; PG8_SCHED;
            PG8_LDB(B0, 1, 0); PG8_LDB(B1, 1, 1); PG8_SCHED; PG8_LDA(At, 1, 0); PG8_STAGE(PG8_SA(0, 1), a2 + hstepA, voffA);
            PG8_WAIT_V(8); PG8_WAIT_L(0); PG8_BAR; PG8_MMA(0, 0, At, B0); PG8_MMA(0, 1, At, B1); PG8_BAR; PG8_SCHED;
            PG8_LDA(At, 1, 1); PG8_STAGE(PG8_SB(1, 0), b3, voffB); PG8_STAGE(PG8_SB(1, 1), b3 + hstepB, voffB); PG8_STAGE(PG8_SA(1, 0), a3, voffA);
            PG8_WAIT_V(8); PG8_WAIT_L(0); PG8_BAR; PG8_MMA(1, 0, At, B0); PG8_MMA(1, 1, At, B1); PG8_BAR; PG8_SCHED;
            if constexpr (Epi::HAS_MID) { if (((t + 2) & 3) == 0 && !last) { E.mid(acc, cur, ((t + 2) >> 2) - 1, wr, wc, fr, fq); PG8_SCHED; } }
        }
        if constexpr (ALIGN_EPI) { if (wr == 0) PG8_BAR; }
        E(acc, cur, wr, wc, fr, fq);
        if (!has_next) break;
#pragma unroll
        for (int a = 0; a < 2; ++a)
#pragma unroll
            for (int b = 0; b < 2; ++b)
#pragma unroll
                for (int m = 0; m < 4; ++m)
#pragma unroll
                    for (int n = 0; n < 2; ++n) acc[a][b][m][n] = (f32x4){0.f, 0.f, 0.f, 0.f};
        cur = nxt; cA = nA; cB = nB; ++ui;
        if constexpr (Epi::HAS_INIT) E.init(acc, cur, wr, wc, fr, fq);
        if constexpr (ALIGN_EPI) { if (wr == 1) PG8_BAR; }
    }
    PG8_WAIT_V(0);
    if constexpr (!ALIGN_EPI) { if (wr == 0) PG8_BAR; }
    PG8_BAR;
#undef PG8_SA
#undef PG8_SB
#undef PG8_STAGE
#undef PG8_LDA
#undef PG8_LDB
#undef PG8_MMA
#undef PG8_WAIT_V
#undef PG8_WAIT_L
#undef PG8_BAR
#undef PG8_SCHED
#undef PG8_ABASE
#undef PG8_BBASE
}
#endif
}

#ifndef CPU_EMU
#define LAS __attribute__((address_space(3)))
#define XB_TMO      128
#define XB_XCNT(j)  (256  + 64 * (j))
#define XB_XSUB(j)  (1280 + 64 * (j))
#define XB_XGEN(j)  (2304 + 64 * (j))
#define XB_TOP      3328
#define XB_TOPGEN   3392
#define XCD_BAR_WORDS 3456
#define XB_SPIN_CAP (1u << 20)
__device__ __forceinline__ unsigned xb_ld(unsigned* p)              { return __hip_atomic_load(p, __ATOMIC_RELAXED, __HIP_MEMORY_SCOPE_AGENT); }
__device__ __forceinline__ unsigned xb_add(unsigned* p, unsigned v) { return __hip_atomic_fetch_add(p, v, __ATOMIC_RELAXED, __HIP_MEMORY_SCOPE_AGENT); }
__device__ __forceinline__ unsigned xb_xcc_id() { return (unsigned)__builtin_amdgcn_s_getreg((3 << 11) | 20) & 0xFu; }
#define XB_SPIN(cond, bar) do { unsigned _sp = 0; while (cond) { __builtin_amdgcn_s_sleep(1); \
    if ((++_sp & 255u) == 0u) { if (xb_ld(&(bar)[XB_TMO])) break; if (_sp > XB_SPIN_CAP) { atomicAdd(&(bar)[XB_TMO], 1u); break; } } } } while (0)
struct XcdBarrier { unsigned* bar; unsigned x; volatile LAS unsigned* st; };
__device__ __forceinline__ XcdBarrier xcd_barrier_post(unsigned* bar, volatile LAS unsigned* st) {
    XcdBarrier b; b.bar = bar; b.x = xb_xcc_id(); b.st = st;
    if (threadIdx.x == 0) (void)xb_add(&bar[XB_XCNT(b.x)], 1u);
    return b;
}
__device__ __forceinline__ void xcd_barrier_complete(unsigned* bar, unsigned x, unsigned& nloc, unsigned& nx) {
    const unsigned G = gridDim.x * gridDim.y * gridDim.z;
    unsigned sum, cnt, mine, sp = 0u;
    for (;;) {
        sum = 0u; cnt = 0u; mine = 0u;
#pragma unroll
        for (unsigned j = 0; j < 16; ++j) { const unsigned c = xb_ld(&bar[XB_XCNT(j)]); sum += c; cnt += (c > 0u) ? 1u : 0u; mine = (j == x) ? c : mine; }
        if (sum == G) break;
        __builtin_amdgcn_s_sleep(1);
        if ((++sp & 255u) == 0u) { if (xb_ld(&bar[XB_TMO])) break; if (sp > XB_SPIN_CAP) { atomicAdd(&bar[XB_TMO], 1u); break; } }
    }
    nloc = mine > 0u ? mine : 1u; nx = cnt > 0u ? cnt : 1u;
}
__device__ __forceinline__ void xcd_barrier(const XcdBarrier& b) {
    asm volatile("s_waitcnt vmcnt(0)" ::: "memory");
    __syncthreads();
    if (threadIdx.x == 0) {
        unsigned* bar = b.bar; asm volatile("" : "+s"(bar));
        __builtin_amdgcn_s_waitcnt(0);
        unsigned nloc = b.st[0], nx = b.st[1];
        if (nloc == 0u) { xcd_barrier_complete(bar, b.x, nloc, nx); b.st[0] = nloc; b.st[1] = nx; }
        const unsigned old = xb_add(&bar[XB_XSUB(b.x)], 1u);
        const unsigned gen = old / nloc;
        if (old + 1u == (gen + 1u) * nloc) {
            __builtin_amdgcn_fence(__ATOMIC_RELEASE, "agent");
            asm volatile("s_waitcnt vmcnt(0)" ::: "memory");
            const unsigned og = xb_add(&bar[XB_TOP], 1u);
            const unsigned tg = og / nx;
            if (og + 1u == (tg + 1u) * nx) xb_add(&bar[XB_TOPGEN], 1u);
            else XB_SPIN(xb_ld(&bar[XB_TOPGEN]) == tg, bar);
            xb_add(&bar[XB_XGEN(b.x)], 1u);
            __builtin_amdgcn_fence(__ATOMIC_ACQUIRE, "agent");
            asm volatile("s_waitcnt vmcnt(0)" ::: "memory");
        } else {
            XB_SPIN(xb_ld(&bar[XB_XGEN(b.x)]) == gen, bar);
            __builtin_amdgcn_fence(__ATOMIC_ACQUIRE, "agent");
            asm volatile("s_waitcnt vmcnt(0)" ::: "memory");
        }
    }
    __syncthreads();
}
constexpr int LDS_BYTES = 147456;
constexpr int RTAB_OFF = 131072 + 1024;
constexpr int LDSCTL_OFF = 131072 + 320;
__global__ void __launch_bounds__(NTHREADS, 2) mega_fwd(Args a_) {
    extern __shared__ __attribute__((aligned(16))) unsigned char lds[];
    __attribute__((address_space(3))) unsigned char* lds3 = (__attribute__((address_space(3))) unsigned char*)lds;
    const int G = gridDim.x, bid = blockIdx.x;
    const int lo = a_.ph_lo, hi = a_.ph_hi;
    volatile LAS unsigned* MISC = (volatile LAS unsigned*)(lds3 + LDSCTL_OFF);
    if (threadIdx.x < 16) MISC[threadIdx.x] = 0u;
    __syncthreads();
    XcdBarrier bar; { KArgs a = kargs(); unsigned* bw = (unsigned*)(a->ws + OFF_CTL) + 4096; bar.bar = bw; bar.x = 0; bar.st = nullptr;
        if (hi - lo > 1) bar = xcd_barrier_post(bw, MISC + 8); }
    unsigned long long tp0 = 0, tp1 = 0;
#define SEAM(p) do { if (lo <= (p) && (p) + 1 < hi) for (int br_ = 0; br_ < BAR_REPS; ++br_) xcd_barrier(bar); if (TIME_PH >= 0) { if ((p) + 1 == TIME_PH) tp0 = __builtin_amdgcn_s_memrealtime(); if ((p) == TIME_PH) tp1 = __builtin_amdgcn_s_memrealtime(); } } while (0)
#define IN_PH(p) ((((PH_MASK) >> ((p) % PH_PER_LAYER + ((p) == PH_FINAL ? PH_PER_LAYER : 0))) & 1) && lo <= (p) && (p) < hi)
#define REPS(k) for (int rep_ = 0; rep_ < (REP_KIND == (k) ? 2 : 1); ++rep_)
#define WSP(T, off) ((T*)(a->ws + (off)))
    float* rtab = (float*)(lds + RTAB_OFF);
#define LAYER_PHASES(layer) { constexpr int pb = (layer) * PH_PER_LAYER; \
        if ((layer) == 0) { if (IN_PH(pb + PH_WCONV)) { KArgs a = kargs(); phase_wconv(a, lds, 0, 0, bid, G); phase_x_to_bf16(a->in[I_X], WSP(bf16_t, OFF_XN), WSP(float, OFF_PART)); } \
            SEAM(pb + PH_WCONV); }        \
        REPS(PH_GEMM_IN) if (IN_PH(pb + PH_GEMM_IN)) { KArgs a = kargs(); pg8::Gemm g{WSP(bf16_t, OFF_XN), WSP(bf16_t, OFF_WIN)}; pg8::StaticOrder S; S.init(M, NHB, G, bid); pg8::EpiBf16<0> E{WSP(bf16_t, OFF_HB), NHB, rtab, WSP(float, OFF_PART)}; \
            pg8::gemm_phase<pg8::EpiBf16<0>, pg8::StaticOrder, D>(lds3, g, S, E); \
            { constexpr int NU = (M / 256) * (NHB / 256); const int rem = NU % G; if (rem == 0) phase_wconv(kargs(), lds, layer, 1, bid, G); else if (bid >= rem) phase_wconv(kargs(), lds, layer, 1, bid - rem, G - rem); } } \
        SEAM(pb + PH_GEMM_IN); \
        REPS(PH_MIX1) if (IN_PH(pb + PH_MIX1)) phase_mix1(kargs(), lds, layer); \
        SEAM(pb + PH_MIX1); \
        if (IN_PH(pb + PH_MIX2)) gla_scan(kargs(), lds); \
        SEAM(pb + PH_MIX2); \
        REPS(PH_MIX3) if (IN_PH(pb + PH_MIX3)) phase_mix3(kargs(), lds, layer); \
        SEAM(pb + PH_MIX3); \
        REPS(PH_GEMM_G) if (IN_PH(pb + PH_GEMM_G)) { KArgs a = kargs(); pg8::Gemm g{WSP(bf16_t, OFF_XN), WSP(bf16_t, OFF_WIN) + (size_t)NHB * D}; pg8::StaticOrder S; S.init(M, NGATE, G, bid); pg8::EpiGate E{WSP(bf16_t, OFF_G), rtab, WSP(float, OFF_PART)}; \
            pg8::gemm_phase<pg8::EpiGate, pg8::StaticOrder, D>(lds3, g, S, E); } \
        SEAM(pb + PH_GEMM_G); \
        REPS(PH_GEMM_M) if (IN_PH(pb + PH_GEMM_M)) { KArgs a = kargs(); pg8::Gemm g{WSP(bf16_t, OFF_Y), WSP(bf16_t, OFF_WBR)}; pg8::StaticOrder S; S.init(M, D, G, bid); pg8::EpiMerge E{(bf16_t*)a->out  , WSP(bf16_t, OFF_G)}; \
            pg8::gemm_phase<pg8::EpiMerge, pg8::StaticOrder, D>(lds3, g, S, E); } \
        SEAM(pb + PH_GEMM_M); \
        for (int rep_ = 0; rep_ < ((REP_KIND == PH_GEMM_O && layer == 0) ? 3 : 1); ++rep_) if (IN_PH(pb + PH_GEMM_O)) { KArgs a = kargs(); pg8::Gemm g{(const bf16_t*)a->out, WSP(bf16_t, OFF_WOUT)}; pg8::StaticOrder S; S.init(M, D, G, bid); \
            pg8::EpiResNorm E{WSP(bf16_t, OFF_XN), WSP(bf16_t, OFF_Y), WSP(float, OFF_PART)}; \
            pg8::gemm_phase<pg8::EpiResNorm, pg8::StaticOrder, D>(lds3, g, S, E); } \
        SEAM(pb + PH_GEMM_O); \
        REPS(PH_GEMM_U) if (IN_PH(pb + PH_GEMM_U)) { KArgs a = kargs(); pg8::Gemm g{WSP(bf16_t, OFF_Y), WSP(bf16_t, OFF_WUP)}; pg8::StaticOrder S; S.init(M, DFF, G, bid); pg8::EpiBf16<2> E{WSP(bf16_t, OFF_UP), DFF, rtab, WSP(float, OFF_PART)}; \
            pg8::gemm_phase<pg8::EpiBf16<2>, pg8::StaticOrder, D>(lds3, g, S, E); } \
        SEAM(pb + PH_GEMM_U); \
        if (IN_PH(pb + PH_GEMM_D)) { KArgs a = kargs(); if ((layer) + 1 < NLAYER) { phase_wconv(a, lds, (layer) + 1, 0, bid, G); __syncthreads();   } \
            pg8::Gemm g{WSP(bf16_t, OFF_UP), WSP(bf16_t, OFF_WDN)}; pg8::StaticOrder S; S.init(M, D, G, bid); \
            pg8::EpiResNorm E{WSP(bf16_t, OFF_Y), WSP(bf16_t, OFF_XN), WSP(float, OFF_PART)}; \
            pg8::gemm_phase<pg8::EpiResNorm, pg8::StaticOrder, DFF>(lds3, g, S, E); } \
        SEAM(pb + PH_GEMM_D); \
    }
    LAYER_PHASES(0)
    LAYER_PHASES(1)
#undef LAYER_PHASES
    if (IN_PH(PH_FINAL)) { KArgs a = kargs(); phase_final_norm(WSP(bf16_t, OFF_XN), a->in[I_FNG], a->out); }
    if (TIME_SEC >= 0 && blockIdx.x == 0) { KArgs a = kargs(); __syncthreads(); const unsigned long long acc_ = __hip_atomic_load((unsigned long long*)(a->ws + OFF_CTL + 32768), __ATOMIC_RELAXED, __HIP_MEMORY_SCOPE_AGENT);
        const unsigned long long te = __builtin_amdgcn_s_memrealtime(), span = acc_ * 32ull; while (__builtin_amdgcn_s_memrealtime() - te < span) __builtin_amdgcn_s_sleep(8); }
    if (TIME_PH >= 0 && blockIdx.x == 0) { if (TIME_PH == PH_FINAL) tp1 = __builtin_amdgcn_s_memrealtime(); if (TIME_PH == 0) tp0 = tp1 - 1;
        const unsigned long long te = __builtin_amdgcn_s_memrealtime(), span = (tp1 - tp0) * 8ull; while (__builtin_amdgcn_s_memrealtime() - te < span) __builtin_amdgcn_s_sleep(8); }
#undef IN_PH
#undef REPS
#undef WSP
#undef SEAM
}

extern "C" void kernel_launch(void* const* d_in, const int* in_sizes, int n_in, void* d_out, int out_size, void* d_ws, size_t ws_size, hipStream_t stream) {
    static int grid = 0;
    if (grid == 0) {
        if (n_in != N_INPUTS || out_size != M * D || ws_size < WS_END) { fprintf(stderr, "kernel_launch: unexpected shapes (n_in %d out %d ws %zu)\n", n_in, out_size, ws_size); grid = -1; return; }
        int dev = 0, cus = 0;
        if (hipGetDevice(&dev) != hipSuccess || hipDeviceGetAttribute(&cus, hipDeviceAttributeMultiprocessorCount, dev) != hipSuccess) { grid = -1; return; }
        if (hipFuncSetAttribute((const void*)mega_fwd, hipFuncAttributeMaxDynamicSharedMemorySize, LDS_BYTES) != hipSuccess) { fprintf(stderr, "kernel_launch: hipFuncSetAttribute failed\n"); grid = -1; return; }
        grid = cus;
    }
    if (grid < 0) return;
    Args a{};
    for (int i = 0; i < N_INPUTS; ++i) a.in[i] = (const float*)d_in[i];
    a.out = (float*)d_out; a.ws = (unsigned char*)d_ws;
#if N_LAUNCH_MODE == 0
    for (int ph = 0; ph < N_PHASES; ++ph) { a.ph_lo = ph; a.ph_hi = ph + 1; hipLaunchKernelGGL(mega_fwd, dim3(grid), dim3(NTHREADS), LDS_BYTES, stream, a); }
#else
    if (hipMemsetAsync((char*)d_ws + OFF_CTL, 0, 65536, stream) != hipSuccess) { fprintf(stderr, "kernel_launch: memset failed\n"); return; }
    a.ph_lo = 0; a.ph_hi = N_PHASES;
    hipLaunchKernelGGL(mega_fwd, dim3(grid), dim3(NTHREADS), LDS_BYTES, stream, a);
#endif
}
#endif
```
